# Optimizing an MI355X kernel written in HIP

```python
import math
import jax, jax.numpy as jnp
from jax import lax
import numpy as np

D_MODEL = 1024
BATCH = 16
SEQ = 256
DEPTH = 2
DEC_BATCH = 2
DEC_SEQ = 4096
PAST_LEN = 256

GRID_W = 64
Q_BLOCK = 128
HEAD_DIM = 64
ROPE_THETA = 10000.0
A_HEADS = 4
A_KV_HEADS = 2
A_GROUP = A_HEADS // A_KV_HEADS
A_WIDTH = A_HEADS * HEAD_DIM
B_HEADS = 4
B_QK_DIM = 64
B_V_DIM = 2 * B_QK_DIM
B_WIDTH = B_HEADS * B_V_DIM
C_GROUPS = 4
C_GROUP_DIM = 64
C_WIDTH = C_GROUPS * C_GROUP_DIM
MIX_WIDTH = A_WIDTH + B_WIDTH + C_WIDTH
IN_SIZES = [A_HEADS * HEAD_DIM, A_KV_HEADS * HEAD_DIM, A_KV_HEADS * HEAD_DIM,
            B_HEADS * 2 * B_QK_DIM, B_HEADS * 2 * B_QK_DIM, B_HEADS * B_V_DIM, C_WIDTH]
IN_WIDTH = sum(IN_SIZES)
IN_SPLITS = [int(s) for s in np.cumsum(IN_SIZES)[:-1]]
FFN_DIM = 2816
N_MOD = 9
ALPHA = (2.0 * DEPTH) ** 0.25
BETA = (8.0 * DEPTH) ** -0.25
LN_EPS = 1e-5
RMS_EPS = 1e-6

kernel_name = "hybrid_diffusion_prefix_trunk_step"


def layer_norm(x, g, b):
    xf = x.astype(jnp.float32)
    mu = jnp.mean(xf, -1, keepdims=True)
    xc = xf - mu
    var = jnp.mean(xc * xc, -1, keepdims=True)
    return (xc * lax.rsqrt(var + LN_EPS) * g + b).astype(x.dtype)


def rms_norm(x, g):
    xf = x.astype(jnp.float32)
    y = xf * lax.rsqrt(jnp.mean(xf * xf, -1, keepdims=True) + RMS_EPS)
    return (y * g).astype(x.dtype)


def rope_tables(length):
    rows = length // GRID_W
    row = jnp.repeat(jnp.arange(rows), GRID_W).astype(jnp.float32)
    col = jnp.tile(jnp.arange(GRID_W), rows).astype(jnp.float32)
    half = HEAD_DIM // 2
    inv = 1.0 / (ROPE_THETA ** (jnp.arange(0, half, 2, dtype=jnp.float32) / half))
    ar = row[:, None] * inv
    ac = col[:, None] * inv
    cos = jnp.concatenate([jnp.cos(ar), jnp.cos(ar), jnp.cos(ac), jnp.cos(ac)], -1)
    sin = jnp.concatenate([jnp.sin(ar), jnp.sin(ar), jnp.sin(ac), jnp.sin(ac)], -1)
    return cos, sin


def _rot_half(y):
    q = y.shape[-1] // 2
    return jnp.concatenate([-y[..., q:], y[..., :q]], -1)


def apply_rope(x, cos, sin):
    half = HEAD_DIM // 2
    rot = jnp.concatenate([_rot_half(x[..., :half]), _rot_half(x[..., half:])], -1)
    out = x.astype(jnp.float32) * cos[:, None, :] + rot.astype(jnp.float32) * sin[:, None, :]
    return out.astype(x.dtype)


def sweep_queries(fn, q):
    b, length = q.shape[0], q.shape[1]
    nb = length // Q_BLOCK
    qb = jnp.moveaxis(q.reshape((b, nb, Q_BLOCK) + q.shape[2:]), 1, 0)
    out = jnp.moveaxis(lax.map(fn, qb), 0, 1)
    return out.reshape((b, length) + out.shape[3:])


def gqa_attention(q, k, v):
    scale = HEAD_DIM ** -0.5
    def blk(qb):
        s = jnp.einsum('bqhgd,bkhd->bhgqk', qb, k).astype(jnp.float32) * scale
        p = jax.nn.softmax(s, axis=-1)
        return jnp.einsum('bhgqk,bkhd->bqhgd', p.astype(v.dtype), v)
    return sweep_queries(blk, q)


def diff_attention(q, k, v, lam):
    scale = B_QK_DIM ** -0.5
    def blk(qb):
        s = jnp.einsum('bqhcd,bkhcd->bhcqk', qb, k).astype(jnp.float32) * scale
        p = jax.nn.softmax(s, axis=-1)
        w = p[:, :, 0] - lam * p[:, :, 1]
        return jnp.einsum('bhqk,bkhe->bqhe', w.astype(v.dtype), v)
    return sweep_queries(blk, q)


def fourier_mix(u):
    b, length, _ = u.shape
    ug = u.reshape(b, length, C_GROUPS, C_GROUP_DIM).astype(jnp.float32)
    f = jnp.fft.fft2(ug, axes=(1, 3), norm='ortho').real
    return f.reshape(b, length, C_WIDTH).astype(u.dtype)


def token_mix(h, w_in, g_qa, g_ka, lam, lam_init, g_subln, w_fourier, w_out, ctx):
    b, length, _ = h.shape
    proj = h @ w_in
    qa, ka, va, qb, kb, vb, uc = jnp.split(proj, IN_SPLITS, axis=-1)
    qa = rms_norm(qa.reshape(b, length, A_HEADS, HEAD_DIM), g_qa)
    ka = rms_norm(ka.reshape(b, length, A_KV_HEADS, HEAD_DIM), g_ka)
    va = va.reshape(b, length, A_KV_HEADS, HEAD_DIM)
    qb = qb.reshape(b, length, B_HEADS * 2, B_QK_DIM)
    kb = kb.reshape(b, length, B_HEADS * 2, B_QK_DIM)
    vb = vb.reshape(b, length, B_HEADS, B_V_DIM)
    if ctx is None:
        new = (ka, va, kb.reshape(b, length, B_HEADS, 2 * B_QK_DIM), vb)
        ka_all, va_all = ka, va
        kb_all = kb.reshape(b, length, B_HEADS, 2, B_QK_DIM)
        vb_all = vb
    else:
        cos, sin = rope_tables(length)
        qa = apply_rope(qa, cos, sin)
        ka = apply_rope(ka, cos, sin)
        qb = apply_rope(qb, cos, sin)
        kb = apply_rope(kb, cos, sin)
        c_ka, c_va, c_kb, c_vb = ctx
        lc = c_ka.shape[1]
        ka_all = jnp.concatenate([c_ka, ka], 1)
        va_all = jnp.concatenate([c_va, va], 1)
        kb_all = jnp.concatenate([c_kb.reshape(b, lc, B_HEADS, 2, B_QK_DIM),
                                  kb.reshape(b, length, B_HEADS, 2, B_QK_DIM)], 1)
        vb_all = jnp.concatenate([c_vb, vb], 1)
        new = None
    o_a = gqa_attention(qa.reshape(b, length, A_KV_HEADS, A_GROUP, HEAD_DIM), ka_all, va_all)
    o_a = o_a.reshape(b, length, A_WIDTH)
    o_b = diff_attention(qb.reshape(b, length, B_HEADS, 2, B_QK_DIM), kb_all, vb_all, lam)
    o_b = (rms_norm(o_b, g_subln) * (1.0 - lam_init)).reshape(b, length, B_WIDTH)
    o_c = fourier_mix(uc) @ w_fourier
    out = jnp.concatenate([o_a, o_b, o_c], -1) @ w_out
    return out, new


def swiglu(h, w_gu, w_down):
    g, u = jnp.split(h @ w_gu, 2, axis=-1)
    return (jax.nn.silu(g) * u) @ w_down


def trunk(x, cvec, caches, w_mod, b_mod, w_in, g_qa, g_ka, lam_q1, lam_k1, lam_q2, lam_k2,
          g_subln, w_fourier, w_out, w_ffn1_gu, w_ffn1_down, w_ffn2_gu, w_ffn2_down, ln_g, ln_b):
    new_list = []
    for l in range(DEPTH):
        mod = jax.nn.silu(cvec) @ w_mod[l] + b_mod[l]
        sh1, sc1, gt1, sh2, sc2, gt2, sh3, sc3, gt3 = [m[:, None, :] for m in jnp.split(mod, N_MOD, -1)]
        lam_init = 0.8 - 0.6 * math.exp(-0.3 * l)
        lam = (jnp.exp(jnp.sum(lam_q1[l].astype(jnp.float32) * lam_k1[l].astype(jnp.float32)))
               - jnp.exp(jnp.sum(lam_q2[l].astype(jnp.float32) * lam_k2[l].astype(jnp.float32)))
               + lam_init)
        f1 = swiglu(x * (1 + sc1) + sh1, w_ffn1_gu[l], w_ffn1_down[l])
        x = layer_norm(ALPHA * x + 0.5 * gt1 * f1, ln_g[l, 0], ln_b[l, 0])
        ctx = None if caches is None else tuple(cch[:, l] for cch in caches)
        mo, new = token_mix(x * (1 + sc2) + sh2, w_in[l], g_qa[l], g_ka[l], lam, lam_init,
                            g_subln[l], w_fourier[l], w_out[l], ctx)
        x = layer_norm(ALPHA * x + gt2 * mo, ln_g[l, 1], ln_b[l, 1])
        f2 = swiglu(x * (1 + sc3) + sh3, w_ffn2_gu[l], w_ffn2_down[l])
        x = layer_norm(ALPHA * x + 0.5 * gt3 * f2, ln_g[l, 2], ln_b[l, 2])
        if new is not None:
            new_list.append(new)
    return x, new_list


def setup_inputs(seed: int = 0) -> dict:
    key = jax.random.key(seed)
    ks = jax.random.split(key, 32)
    f32 = jnp.float32
    nrm = lambda k, s: jax.random.normal(k, s, f32)
    d = D_MODEL
    return {
        "x_prompt": nrm(ks[0], (BATCH, SEQ, d)),
        "x_sample": nrm(ks[1], (DEC_BATCH, DEC_SEQ, d)),
        "cache_a_k": nrm(ks[2], (DEC_BATCH, DEPTH, PAST_LEN, A_KV_HEADS, HEAD_DIM)),
        "cache_a_v": nrm(ks[3], (DEC_BATCH, DEPTH, PAST_LEN, A_KV_HEADS, HEAD_DIM)),
        "cache_b_k": nrm(ks[4], (DEC_BATCH, DEPTH, PAST_LEN, B_HEADS, 2 * B_QK_DIM)),
        "cache_b_v": nrm(ks[5], (DEC_BATCH, DEPTH, PAST_LEN, B_HEADS, B_V_DIM)),
        "c": nrm(ks[6], (DEC_BATCH, d)),
        "c_ctx": nrm(ks[7], (d,)),
        "w_mod": nrm(ks[8], (DEPTH, d, N_MOD * d)) * (0.5 * d ** -0.5),
        "b_mod": nrm(ks[9], (DEPTH, N_MOD * d)) * 0.01,
        "w_in": nrm(ks[10], (DEPTH, d, IN_WIDTH)) * d ** -0.5,
        "g_qa": 1.0 + 0.02 * nrm(ks[11], (DEPTH, HEAD_DIM)),
        "g_ka": 1.0 + 0.02 * nrm(ks[12], (DEPTH, HEAD_DIM)),
        "lam_q1": 0.1 * nrm(ks[13], (DEPTH, B_QK_DIM)),
        "lam_k1": 0.1 * nrm(ks[14], (DEPTH, B_QK_DIM)),
        "lam_q2": 0.1 * nrm(ks[15], (DEPTH, B_QK_DIM)),
        "lam_k2": 0.1 * nrm(ks[16], (DEPTH, B_QK_DIM)),
        "g_subln": 1.0 + 0.02 * nrm(ks[17], (DEPTH, B_V_DIM)),
        "w_fourier": nrm(ks[18], (DEPTH, C_WIDTH, C_WIDTH)) * C_WIDTH ** -0.5,
        "w_out": nrm(ks[19], (DEPTH, MIX_WIDTH, d)) * (BETA * MIX_WIDTH ** -0.5),
        "w_ffn1_gu": nrm(ks[20], (DEPTH, d, 2 * FFN_DIM)) * d ** -0.5,
        "w_ffn1_down": nrm(ks[21], (DEPTH, FFN_DIM, d)) * (BETA * FFN_DIM ** -0.5),
        "w_ffn2_gu": nrm(ks[22], (DEPTH, d, 2 * FFN_DIM)) * d ** -0.5,
        "w_ffn2_down": nrm(ks[23], (DEPTH, FFN_DIM, d)) * (BETA * FFN_DIM ** -0.5),
        "ln_g": 1.0 + 0.02 * nrm(ks[24], (DEPTH, 3, d)),
        "ln_b": 0.02 * nrm(ks[25], (DEPTH, 3, d)),
    }


def reference(x_prompt, x_sample, cache_a_k, cache_a_v, cache_b_k, cache_b_v, c, c_ctx,
              w_mod, b_mod, w_in, g_qa, g_ka, lam_q1, lam_k1, lam_q2, lam_k2, g_subln,
              w_fourier, w_out, w_ffn1_gu, w_ffn1_down, w_ffn2_gu, w_ffn2_down, ln_g, ln_b):
    weights = (w_mod, b_mod, w_in, g_qa, g_ka, lam_q1, lam_k1, lam_q2, lam_k2, g_subln,
               w_fourier, w_out, w_ffn1_gu, w_ffn1_down, w_ffn2_gu, w_ffn2_down, ln_g, ln_b)
    y_prompt, new = trunk(x_prompt, c_ctx[None, :], None, *weights)
    new_a_k = jnp.stack([n[0] for n in new], axis=1)
    new_a_v = jnp.stack([n[1] for n in new], axis=1)
    new_b_k = jnp.stack([n[2] for n in new], axis=1)
    new_b_v = jnp.stack([n[3] for n in new], axis=1)
    y_sample, _ = trunk(x_sample, c, (cache_a_k, cache_a_v, cache_b_k, cache_b_v), *weights)
    return (y_prompt, y_sample, new_a_k, new_a_v, new_b_k, new_b_v)
```

```cpp
#include <hip/hip_runtime.h>
#include <hip/hip_cooperative_groups.h>
#include <cstdio>
#include <cstdint>
namespace cg = cooperative_groups;

#ifndef MK_PER_PHASE
#define MK_PER_PHASE 0
#endif

#define DI __device__ __forceinline__
#define LAS __attribute__((address_space(3)))
typedef unsigned short bf16_t;
typedef short bf16x8 __attribute__((ext_vector_type(8)));
typedef short s16x4 __attribute__((ext_vector_type(4)));
typedef float f32x4 __attribute__((ext_vector_type(4)));
typedef float f32x16 __attribute__((ext_vector_type(16)));
typedef unsigned u32x4 __attribute__((ext_vector_type(4)));
typedef unsigned u32x2 __attribute__((ext_vector_type(2)));
typedef __bf16 bf16x2_t __attribute__((ext_vector_type(2)));
typedef float f32x2_t __attribute__((ext_vector_type(2)));

DI unsigned pk2(float lo, float hi) { f32x2_t v = {lo, hi}; bf16x2_t b = __builtin_convertvector(v, bf16x2_t); return __builtin_bit_cast(unsigned, b); }
DI bf16_t f2bf(float f) { return (bf16_t)(pk2(f, 0.f) & 0xffffu); }
DI int otid() { int t = threadIdx.x; asm volatile("" : "+v"(t)); return t; }
DI float wave_sum(float v) { v += __shfl_xor(v, 1); v += __shfl_xor(v, 2); v += __shfl_xor(v, 4); v += __shfl_xor(v, 8); v += __shfl_xor(v, 16); v += __shfl_xor(v, 32); return v; }

constexpr int T = 12288, TP = 4096, D = 1024, FF = 2816, NIN = 2560, LKS = 4352;
constexpr float ALPHA = 1.41421356237f;
constexpr float QSCALE = 0.125f * 1.44269504089f;

constexpr size_t al256(size_t x) { return (x + 255) & ~(size_t)255; }
constexpr size_t WS_CTL = 0;
constexpr size_t WS_MOD = 4096;
constexpr size_t WS_ROPE = WS_MOD + al256(2 * 3 * 9216 * 4);
constexpr size_t WS_DFTP = WS_ROPE + 8192;
constexpr size_t WS_DFTS = WS_DFTP + 256 * 512 * 2;
constexpr size_t WS_WGU1 = WS_DFTS + (size_t)4096 * 8192 * 2;
constexpr size_t WS_WD1 = WS_WGU1 + (size_t)5632 * 1024 * 2;
constexpr size_t WS_WIN = WS_WD1 + (size_t)1024 * 2816 * 2;
constexpr size_t WS_WOUT = WS_WIN + (size_t)2560 * 1024 * 2;
constexpr size_t WS_WGU2 = WS_WOUT + (size_t)1024 * 1024 * 2;
constexpr size_t WS_WD2 = WS_WGU2 + (size_t)5632 * 1024 * 2;
constexpr size_t WS_X = WS_WD2 + (size_t)1024 * 2816 * 2;
constexpr size_t WS_KAS = WS_X + (size_t)T * D * 4;
constexpr size_t WS_VAS = WS_KAS + (size_t)2 * 2 * LKS * 64 * 2;
constexpr size_t WS_KBS = WS_VAS + (size_t)2 * 2 * LKS * 64 * 2;
constexpr size_t WS_VBS = WS_KBS + (size_t)2 * 8 * LKS * 64 * 2;
constexpr size_t WS_H = WS_VBS + (size_t)2 * 4 * 128 * LKS * 2;
constexpr size_t WS_R = WS_H + (size_t)T * D * 2;
constexpr size_t WS_ACT = WS_R;
constexpr size_t WS_QA = WS_R;
constexpr size_t WS_QB = WS_QA + (size_t)T * 256 * 2;
constexpr size_t WS_KAP = WS_QB + (size_t)T * 512 * 2;
constexpr size_t WS_VAP = WS_KAP + (size_t)16 * 2 * 256 * 64 * 2;
constexpr size_t WS_KBP = WS_VAP + (size_t)16 * 2 * 256 * 64 * 2;
constexpr size_t WS_VBP = WS_KBP + (size_t)16 * 8 * 256 * 64 * 2;
constexpr size_t WS_UTP = WS_VBP + (size_t)16 * 4 * 128 * 256 * 2;
constexpr size_t WS_UTS = WS_UTP + (size_t)4096 * 512 * 2;
constexpr size_t WS_MIX = WS_UTS + (size_t)512 * 8192 * 2;
constexpr size_t WS_FACC = WS_MIX + (size_t)T * D * 2;
constexpr size_t WS_REND = WS_FACC + (size_t)T * 256 * 4;
constexpr size_t WS_END = (WS_REND > WS_ACT + (size_t)T * FF * 2) ? WS_REND : WS_ACT + (size_t)T * FF * 2;

constexpr int LDS_RING = 131072, MISC_OFF = LDS_RING, LDS_BYTES = LDS_RING + 256;

struct KArgs { const float* in[26]; float* out; unsigned char* ws; int ph_lo, ph_hi; };

namespace pg8 {
constexpr int BM = 256, BK = 64, HALF = 128, HTB = HALF * BK * 2, STAGE_BYTES = 8 * HTB, NXCD = 8, WGM = 8;
DI int lds_byte(int r, int c) { const int st = (r >> 4) * 2 + (c >> 5), rr = r & 15, cc = c & 31, ob = rr * 64 + cc * 2; return st * 1024 + (ob ^ (((ob >> 9) & 1) << 5)); }
DI void stage_rc(int b, int& R, int& C) { const int st = b / 1024, sb = b % 1024, swz = sb ^ (((sb >> 9) & 1) << 5); R = (st >> 1) * 16 + swz / 64; C = (st & 1) * 32 + (swz % 64) / 2; }
DI int perm32(int rho) { const int n = rho >> 4, i = rho & 15; return 8 * (i >> 2) + 4 * n + (i & 3); }

struct Unit { int pm, pn, ko; };
struct Gemm { const bf16_t* A; const bf16_t* Bt; int ld, K; };

struct StaticOrder {
    int nM, nN, nwg, G, c;
    DI void init(int M, int N, int G_, int c_) { nM = M / BM; nN = N / BM; nwg = nM * nN; G = G_; c = c_; }
    DI bool next(int i, Unit& u) const {
        const long L = (long)i * G + c; if (L >= nwg) return false;
        int wgid = (int)L; { const int q = nwg / NXCD, r = nwg % NXCD, xcd = wgid % NXCD, off = wgid / NXCD; wgid = (xcd < r ? xcd * (q + 1) : r * (q + 1) + (xcd - r) * q) + off; }
        const int nig = WGM * nN, gid = wgid / nig, fm = gid * WGM, gsz = (nM - fm) < WGM ? (nM - fm) : WGM;
        u.pm = fm + ((wgid % nig) % gsz); u.pn = (wgid % nig) / gsz; u.ko = 0; return true;
    }
};
struct FourOrder {
    int G, c, total, mode;
    DI bool next(int i, Unit& u) const {
        const int L = i * G + c; if (L >= total) return false;
        if (mode == 0) { u.ko = (L >> 5) * 1024; const int tile = L & 31; u.pm = tile >> 1; u.pn = tile & 1; }
        else { u.ko = 0; u.pm = 0; u.pn = L; }
        return true;
    }
};

template <class Epi, class Sched, bool ALIGN_EPI, bool SP2>
DI void gemm_phase(LAS unsigned char* lds, const Gemm g, const Sched& S, const Epi& E) {
    int tid = threadIdx.x; asm volatile("" : "+v"(tid));
    const int wid = __builtin_amdgcn_readfirstlane(tid >> 6), lane = tid & 63, wr = wid >> 2, wc = wid & 3, fr = lane & 15, fq = lane >> 4;
    const int K = g.K, nt = K / BK, ld = g.ld;
    unsigned voffA[2], voffB[2];
#pragma unroll
    for (int i = 0; i < 2; ++i) { int R, C; stage_rc(tid * 16 + i * 8192, R, C); const int Rb = (R & ~31) + perm32(R & 31);
        voffA[i] = (unsigned)(R * ld + C) * 2u; voffB[i] = (unsigned)(Rb * ld + C) * 2u; }
    const size_t kstep = (size_t)(BK * 2);
    const size_t hstep = (size_t)HALF * ld * 2;
    const size_t tstep = 2 * hstep;
    const unsigned ldsw = (unsigned)wid * 1024u;
    const int aoff = lds_byte(wr * 64 + fr, fq * 8), boff = lds_byte(wc * 32 + fr, fq * 8);
#define PG8_SA(b, h) (((b) * 2 + (h)) * HTB)
#define PG8_SB(b, h) ((4 + (b) * 2 + (h)) * HTB)
#define PG8_STAGE(bufoff, gbase, voff) do { _Pragma("unroll") for (int _i = 0; _i < 2; ++_i) \
        __builtin_amdgcn_global_load_lds((const unsigned*)((const char*)(gbase) + (voff)[_i]), (LAS unsigned*)(lds + (bufoff) + ldsw + _i * 8192), 16, 0, 0); } while (0)
#define PG8_LDA(dst, b, h) do { _Pragma("unroll") for (int m = 0; m < 4; ++m) _Pragma("unroll") for (int k = 0; k < 2; ++k) dst[m][k] = *(const LAS bf16x8*)(lds + PG8_SA(b, h) + aoff + m * 2048 + k * 1024); } while (0)
#define PG8_LDB(dst, b, h) do { _Pragma("unroll") for (int n = 0; n < 2; ++n) _Pragma("unroll") for (int k = 0; k < 2; ++k) dst[n][k] = *(const LAS bf16x8*)(lds + PG8_SB(b, h) + boff + n * 2048 + k * 1024); } while (0)
#define PG8_MMA(ai, bj, At, Bt) do { __builtin_amdgcn_s_setprio(1); _Pragma("unroll") for (int m = 0; m < 4; ++m) _Pragma("unroll") for (int n = 0; n < 2; ++n) _Pragma("unroll") for (int k = 0; k < 2; ++k) \
        acc[ai][bj][m][n] = __builtin_amdgcn_mfma_f32_16x16x32_bf16(Bt[n][k], At[m][k], acc[ai][bj][m][n], 0, 0, 0); __builtin_amdgcn_s_setprio(0); } while (0)
#define PG8_WAIT_V(n) asm volatile("s_waitcnt vmcnt(" #n ")" ::: "memory")
#define PG8_WAIT_L(n) asm volatile("s_waitcnt lgkmcnt(" #n ")" ::: "memory")
#define PG8_BAR __builtin_amdgcn_s_barrier()
#define PG8_SCHED __builtin_amdgcn_sched_barrier(0)
    Unit cur, nxt; int ui = 0;
    if (!S.next(0, cur)) return;
    f32x4 acc[2][2][4][2];
#pragma unroll
    for (int a = 0; a < 2; ++a)
#pragma unroll
        for (int b = 0; b < 2; ++b)
#pragma unroll
            for (int m = 0; m < 4; ++m)
#pragma unroll
                for (int n = 0; n < 2; ++n) acc[a][b][m][n] = (f32x4){0.f, 0.f, 0.f, 0.f};
    bf16x8 At[4][2], B0[2][2], B1[2][2];
    const char* cA = (const char*)g.A + (size_t)cur.pm * tstep + (size_t)cur.ko * 2; const char* cB = (const char*)g.Bt + (size_t)cur.pn * tstep + (size_t)cur.ko * 2;
    if constexpr (SP2) {
        PG8_STAGE(PG8_SB(0, 0), cB, voffB); PG8_STAGE(PG8_SB(0, 1), cB + hstep, voffB); PG8_STAGE(PG8_SA(0, 0), cA, voffA); PG8_STAGE(PG8_SA(0, 1), cA + hstep, voffA);
        if (wr == 1) PG8_BAR;
        PG8_WAIT_V(2); PG8_BAR;
        PG8_STAGE(PG8_SB(1, 0), cB + kstep, voffB); PG8_STAGE(PG8_SA(1, 0), cA + kstep, voffA); PG8_STAGE(PG8_SB(1, 1), cB + hstep + kstep, voffB);
        PG8_WAIT_V(6); PG8_BAR;
    } else {
        PG8_STAGE(PG8_SB(0, 0), cB, voffB); PG8_STAGE(PG8_SA(0, 0), cA, voffA); PG8_STAGE(PG8_SB(0, 1), cB + hstep, voffB); PG8_STAGE(PG8_SA(0, 1), cA + hstep, voffA);
        if (wr == 1) PG8_BAR;
        PG8_WAIT_V(4); PG8_BAR;
        PG8_STAGE(PG8_SB(1, 0), cB + kstep, voffB); PG8_STAGE(PG8_SA(1, 0), cA + kstep, voffA); PG8_STAGE(PG8_SB(1, 1), cB + hstep + kstep, voffB);
        PG8_WAIT_V(6); PG8_BAR;
    }
    for (;;) {
        const bool has_next = S.next(ui + 1, nxt);
        const char* nA = has_next ? (const char*)g.A + (size_t)nxt.pm * tstep + (size_t)nxt.ko * 2 : cA; const char* nB = has_next ? (const char*)g.Bt + (size_t)nxt.pn * tstep + (size_t)nxt.ko * 2 : cB;
        for (int t = 0; t < nt; t += 2) {
            const bool last = (t == nt - 2);
            const char* a1 = cA + (size_t)(t + 1) * kstep;
            const char* a2 = last ? nA : cA + (size_t)(t + 2) * kstep; const char* b2 = last ? nB : cB + (size_t)(t + 2) * kstep;
            const char* a3 = a2 + kstep; const char* b3 = b2 + kstep;
            if constexpr (SP2) {
            PG8_LDB(B0, 0, 0); PG8_LDB(B1, 0, 1); PG8_SCHED; PG8_LDA(At, 0, 0); PG8_STAGE(PG8_SA(1, 1), a1 + hstep, voffA);
            PG8_WAIT_V(8); PG8_WAIT_L(0); PG8_BAR; PG8_MMA(0, 0, At, B0); PG8_MMA(0, 1, At, B1); PG8_BAR; PG8_SCHED;
            PG8_LDA(At, 0, 1); PG8_STAGE(PG8_SB(0, 0), b2, voffB); PG8_STAGE(PG8_SB(0, 1), b2 + hstep, voffB); PG8_STAGE(PG8_SA(0, 0), a2, voffA);
            PG8_WAIT_V(8); PG8_WAIT_L(0); PG8_BAR; PG8_MMA(1, 0, At, B0); PG8_MMA(1, 1, At, B1); PG8_BAR; PG8_SCHED;
            PG8_LDB(B0, 1, 0); PG8_LDB(B1, 1, 1); PG8_SCHED; PG8_LDA(At, 1, 0); PG8_STAGE(PG8_SA(0, 1), a2 + hstep, voffA);
            PG8_WAIT_V(8); PG8_WAIT_L(0); PG8_BAR; PG8_MMA(0, 0, At, B0); PG8_MMA(0, 1, At, B1); PG8_BAR; PG8_SCHED;
            PG8_LDA(At, 1, 1); PG8_STAGE(PG8_SB(1, 0), b3, voffB); PG8_STAGE(PG8_SB(1, 1), b3 + hstep, voffB); PG8_STAGE(PG8_SA(1, 0), a3, voffA);
            PG8_WAIT_V(8); PG8_WAIT_L(0); PG8_BAR; PG8_MMA(1, 0, At, B0); PG8_MMA(1, 1, At, B1); PG8_BAR; PG8_SCHED;
            } else {
            PG8_LDB(B0, 0, 0); PG8_SCHED; PG8_LDA(At, 0, 0); PG8_STAGE(PG8_SA(1, 1), a1 + hstep, voffA);
            PG8_WAIT_L(8); PG8_BAR; PG8_WAIT_L(0); PG8_MMA(0, 0, At, B0); PG8_BAR; PG8_SCHED;
            PG8_LDB(B1, 0, 1); PG8_STAGE(PG8_SB(0, 0), b2, voffB);
            PG8_BAR; PG8_WAIT_L(0); PG8_MMA(0, 1, At, B1); PG8_BAR;
            PG8_LDA(At, 0, 1); PG8_STAGE(PG8_SA(0, 0), a2, voffA);
            PG8_BAR; PG8_WAIT_L(0); PG8_MMA(1, 0, At, B0); PG8_BAR; PG8_SCHED;
            PG8_STAGE(PG8_SB(0, 1), b2 + hstep, voffB);
            PG8_WAIT_V(6); PG8_BAR; PG8_MMA(1, 1, At, B1); PG8_BAR;
            PG8_LDB(B0, 1, 0); PG8_SCHED; PG8_LDA(At, 1, 0); PG8_STAGE(PG8_SA(0, 1), a2 + hstep, voffA);
            PG8_WAIT_L(8); PG8_BAR; PG8_WAIT_L(0); PG8_MMA(0, 0, At, B0); PG8_BAR; PG8_SCHED;
            PG8_LDB(B1, 1, 1); PG8_STAGE(PG8_SB(1, 0), b3, voffB);
            PG8_BAR; PG8_WAIT_L(0); PG8_MMA(0, 1, At, B1); PG8_BAR;
            PG8_LDA(At, 1, 1); PG8_STAGE(PG8_SA(1, 0), a3, voffA);
            PG8_BAR; PG8_WAIT_L(0); PG8_MMA(1, 0, At, B0); PG8_BAR; PG8_SCHED;
            PG8_STAGE(PG8_SB(1, 1), b3 + hstep, voffB);
            PG8_WAIT_V(6); PG8_BAR; PG8_MMA(1, 1, At, B1); PG8_BAR;
            }
        }
        if constexpr (ALIGN_EPI) { if (wr == 0) PG8_BAR; }
        E(acc, cur, wr, wc, fr, fq);
        if (!has_next) break;
#pragma unroll
        for (int a = 0; a < 2; ++a)
#pragma unroll
            for (int b = 0; b < 2; ++b)
#pragma unroll
                for (int m = 0; m < 4; ++m)
#pragma unroll
                    for (int n = 0; n < 2; ++n) acc[a][b][m][n] = (f32x4){0.f, 0.f, 0.f, 0.f};
        cur = nxt; cA = nA; cB = nB; ++ui;
        if constexpr (ALIGN_EPI) { if (wr == 1) PG8_BAR; }
    }
    PG8_WAIT_V(0);
    if constexpr (!ALIGN_EPI) { if (wr == 0) PG8_BAR; }
    PG8_BAR;
#undef PG8_SA
#undef PG8_SB
#undef PG8_STAGE
#undef PG8_LDA
#undef PG8_LDB
#undef PG8_MMA
#undef PG8_WAIT_V
#undef PG8_WAIT_L
#undef PG8_BAR
#undef PG8_SCHED
}

DI int mod_of_row_tile(int pm) { return pm < 16 ? 0 : 1 + ((pm - 16) >> 4); }

struct EpiGU {
    bf16_t* ACT;
    DI void operator()(const f32x4 (&acc)[2][2][4][2], const Unit& u, int wr, int wc, int fr_in, int fq_in) const {
        int fr = fr_in, fq = fq_in; asm volatile("" : "+v"(fr), "+v"(fq));
#pragma unroll
        for (int ai = 0; ai < 2; ++ai)
#pragma unroll
            for (int m = 0; m < 4; ++m) {
                const int row = u.pm * 256 + ai * 128 + wr * 64 + m * 16 + fr;
                float o[8];
#pragma unroll
                for (int n = 0; n < 2; ++n)
#pragma unroll
                    for (int j = 0; j < 4; ++j) { const float gg = acc[ai][0][m][n][j], uu = acc[ai][1][m][n][j];
                        const float sg = gg * __builtin_amdgcn_rcpf(1.f + __builtin_amdgcn_exp2f(-1.44269504089f * gg)); o[n * 4 + j] = sg * uu; }
                u32x4 w; w.x = pk2(o[0], o[1]); w.y = pk2(o[2], o[3]); w.z = pk2(o[4], o[5]); w.w = pk2(o[6], o[7]);
                *(u32x4*)(ACT + (size_t)row * FF + u.pn * 128 + wc * 32 + fq * 8) = w;
            }
    }
};

struct EpiRes {
    const float* srcP; const float* srcS; float* X; const float* gate; float coef;
    DI void operator()(const f32x4 (&acc)[2][2][4][2], const Unit& u, int wr, int wc, int fr_in, int fq_in) const {
        int fr = fr_in, fq = fq_in; asm volatile("" : "+v"(fr), "+v"(fq));
        const float* gt = gate + mod_of_row_tile(u.pm) * 9216;
        f32x4 gv[2][2];
#pragma unroll
        for (int bj = 0; bj < 2; ++bj)
#pragma unroll
            for (int n = 0; n < 2; ++n) gv[bj][n] = *(const f32x4*)(gt + u.pn * 256 + bj * 128 + wc * 32 + fq * 8 + n * 4) * coef;
#pragma unroll
        for (int ai = 0; ai < 2; ++ai)
#pragma unroll
            for (int m = 0; m < 4; ++m) {
                const int row = u.pm * 256 + ai * 128 + wr * 64 + m * 16 + fr;
                const float* sp = (row < TP) ? srcP + (size_t)row * D : srcS + (size_t)(row - TP) * D;
#pragma unroll
                for (int bj = 0; bj < 2; ++bj)
#pragma unroll
                    for (int n = 0; n < 2; ++n) { const int c = u.pn * 256 + bj * 128 + wc * 32 + fq * 8 + n * 4;
                        const f32x4 xv = *(const f32x4*)(sp + c);
                        *(f32x4*)(X + (size_t)row * D + c) = xv * ALPHA + gv[bj][n] * acc[ai][bj][m][n]; }
            }
    }
};

struct EpiFour {
    float* FACC; int mode;
    DI void operator()(const f32x4 (&acc)[2][2][4][2], const Unit& u, int wr, int wc, int fr_in, int fq_in) const {
        int fr = fr_in, fq = fq_in; asm volatile("" : "+v"(fr), "+v"(fq));
        const int tok0 = ((mode == 0) ? TP + u.pn * 4096 + u.pm * 256 : u.pn * 256) + wr * 64 + fr;
        float* p0 = FACC + (size_t)tok0 * 256 + wc * 32 + fq * 8;
#pragma unroll
        for (int ai = 0; ai < 2; ++ai)
#pragma unroll
            for (int m = 0; m < 4; ++m) {
                float* p = p0 + (ai * 128 + m * 16) * 256;
                asm volatile("" : "+v"(p));
#pragma unroll
                for (int bj = 0; bj < 2; ++bj)
#pragma unroll
                    for (int n = 0; n < 2; ++n)
#pragma unroll
                        for (int j = 0; j < 4; ++j) unsafeAtomicAdd(p + bj * 128 + n * 4 + j, acc[ai][bj][m][n][j]);
                __builtin_amdgcn_sched_barrier(0);
            }
    }
};

struct EpiIn {
    int l; const float* g_qa; const float* g_ka; float* out; unsigned char* ws;
    DI void operator()(const f32x4 (&acc)[2][2][4][2], const Unit& u, int wr, int wc, int fr_in, int fq_in) const {
        int fr = fr_in, fq = fq_in; asm volatile("" : "+v"(fr), "+v"(fq));
        const int t = u.pn; const bool prompt = u.pm < 16;
        const float* rope = (const float*)(ws + WS_ROPE);
        bf16_t* const QA = (bf16_t*)(ws + WS_QA); bf16_t* const QB = (bf16_t*)(ws + WS_QB); bf16_t* const KAS = (bf16_t*)(ws + WS_KAS); bf16_t* const VAS = (bf16_t*)(ws + WS_VAS);
        bf16_t* const KBS = (bf16_t*)(ws + WS_KBS); bf16_t* const VBS = (bf16_t*)(ws + WS_VBS); bf16_t* const KAP = (bf16_t*)(ws + WS_KAP); bf16_t* const VAP = (bf16_t*)(ws + WS_VAP);
        bf16_t* const KBP = (bf16_t*)(ws + WS_KBP); bf16_t* const VBP = (bf16_t*)(ws + WS_VBP); bf16_t* const UTP = (bf16_t*)(ws + WS_UTP); bf16_t* const UTS = (bf16_t*)(ws + WS_UTS);
        if (t >= 8) {
            const int cs = t - 8;
#pragma unroll
            for (int ai = 0; ai < 2; ++ai)
#pragma unroll
                for (int m = 0; m < 4; ++m) {
                    const int row = u.pm * 256 + ai * 128 + wr * 64 + m * 16 + fr;
                    bf16_t* base; size_t pitch;
                    if (prompt) { base = UTP + (size_t)(row >> 8) * 256 * 512 + cs * 256 + (row & 255); pitch = 512; }
                    else { const int rs = row - TP; base = UTS + (size_t)(rs >> 12) * 256 * 8192 + cs * 4096 + (rs & 4095); pitch = 8192; }
#pragma unroll
                    for (int bj = 0; bj < 2; ++bj)
#pragma unroll
                        for (int n = 0; n < 2; ++n)
#pragma unroll
                            for (int j = 0; j < 4; ++j) base[(size_t)(bj * 128 + wc * 32 + fq * 8 + n * 4 + j) * pitch] = f2bf(acc[ai][bj][m][n][j]);
                    __builtin_amdgcn_sched_barrier(0);
                }
            return;
        }
        const bool do_norm = (t == 0) || (t == 1 && wc < 2);
        const bool is_v = (t == 1 && wc >= 2) || t >= 6;
        const bool is_q = (t == 0) || t == 2 || t == 3;
        const bool do_rope = !prompt && !is_v;
        const float* gp = (t == 0 ? g_qa : g_ka) + l * 64 + fq * 8;
#pragma unroll
        for (int ai = 0; ai < 2; ++ai)
#pragma unroll
            for (int m = 0; m < 4; ++m) {
                const int row = u.pm * 256 + ai * 128 + wr * 64 + m * 16 + fr;
                int b, pos;
                if (prompt) { b = row >> 8; pos = row & 255; } else { const int rs = row - TP; b = rs >> 12; pos = rs & 4095; }
                float v[2][8];
#pragma unroll
                for (int bj = 0; bj < 2; ++bj)
#pragma unroll
                    for (int n = 0; n < 2; ++n)
#pragma unroll
                        for (int j = 0; j < 4; ++j) v[bj][n * 4 + j] = acc[ai][bj][m][n][j];
                if (do_norm) {
                    float ss = 0.f;
#pragma unroll
                    for (int bj = 0; bj < 2; ++bj)
#pragma unroll
                        for (int e = 0; e < 8; ++e) ss += v[bj][e] * v[bj][e];
                    ss += __shfl_xor(ss, 16); ss += __shfl_xor(ss, 32);
                    const float rs_ = rsqrtf(ss * (1.f / 64.f) + 1e-6f);
#pragma unroll
                    for (int bj = 0; bj < 2; ++bj)
#pragma unroll
                        for (int e = 0; e < 8; ++e) v[bj][e] = v[bj][e] * rs_ * gp[bj * 32 + e];
                }
                if (prompt && !is_q) {
                    float* op;
                    if (t == 1) op = out + (wc < 2 ? 12582912 : 13631488) + ((size_t)((b * 2 + l) * 256 + pos)) * 128 + (wc & 1) * 64;
                    else if (t < 6) op = out + 14680064 + ((size_t)((b * 2 + l) * 256 + pos)) * 512 + ((t - 4) * 4 + wc) * 64;
                    else op = out + 18874368 + ((size_t)((b * 2 + l) * 256 + pos)) * 512 + (t - 6) * 256 + wc * 64;
#pragma unroll
                    for (int bj = 0; bj < 2; ++bj) {
                        *(f32x4*)(op + bj * 32 + fq * 8) = (f32x4){v[bj][0], v[bj][1], v[bj][2], v[bj][3]};
                        *(f32x4*)(op + bj * 32 + fq * 8 + 4) = (f32x4){v[bj][4], v[bj][5], v[bj][6], v[bj][7]};
                    }
                }
                if (do_rope) {
#pragma unroll
                    for (int bj = 0; bj < 2; ++bj) {
                        const int pv_ = bj == 0 ? (pos >> 6) : (pos & 63);
                        const float* rp = rope + (pv_ * 16 + (fq & 1) * 8) * 2;
#pragma unroll
                        for (int e = 0; e < 8; ++e) {
                            const float cc = rp[2 * e], sn = rp[2 * e + 1];
                            const float other = __shfl_xor(v[bj][e], 32);
                            v[bj][e] = v[bj][e] * cc + (fq < 2 ? -other : other) * sn;
                        }
                    }
                }
                if (is_v) {
                    bf16_t* base; size_t pitch;
                    if (t == 1) { const int kvh = wc - 2; if (prompt) { base = VAP + (size_t)(b * 2 + kvh) * 64 * 256 + pos; pitch = 256; } else { base = VAS + (size_t)(b * 2 + kvh) * 64 * LKS + 256 + pos; pitch = LKS; } }
                    else { const int hh = (t - 6) * 2 + (wc >> 1); const int d0 = (wc & 1) * 64;
                        if (prompt) { base = VBP + ((size_t)(b * 4 + hh) * 128 + d0) * 256 + pos; pitch = 256; } else { base = VBS + ((size_t)(b * 4 + hh) * 128 + d0) * LKS + 256 + pos; pitch = LKS; } }
#pragma unroll
                    for (int bj = 0; bj < 2; ++bj)
#pragma unroll
                        for (int e = 0; e < 8; ++e) base[(size_t)(bj * 32 + fq * 8 + e) * pitch] = f2bf(v[bj][e]);
                } else {
                    bf16_t* op;
                    if (t == 0) op = QA + (size_t)row * 256 + wc * 64;
                    else if (t == 1) op = prompt ? KAP + ((size_t)(b * 2 + wc) * 256 + pos) * 64 : KAS + ((size_t)(b * 2 + wc) * LKS + 256 + pos) * 64;
                    else if (t < 4) op = QB + (size_t)row * 512 + ((t - 2) * 4 + wc) * 64;
                    else { const int s = (t - 4) * 4 + wc; op = prompt ? KBP + ((size_t)(b * 8 + s) * 256 + pos) * 64 : KBS + ((size_t)(b * 8 + s) * LKS + 256 + pos) * 64; }
                    const float sc = is_q ? QSCALE : 1.f;
#pragma unroll
                    for (int bj = 0; bj < 2; ++bj) {
                        u32x4 w; w.x = pk2(v[bj][0] * sc, v[bj][1] * sc); w.y = pk2(v[bj][2] * sc, v[bj][3] * sc); w.z = pk2(v[bj][4] * sc, v[bj][5] * sc); w.w = pk2(v[bj][6] * sc, v[bj][7] * sc);
                        *(u32x4*)(op + bj * 32 + fq * 8) = w;
                    }
                }
                __builtin_amdgcn_sched_barrier(0);
            }
    }
};
}

template <int DV>
DI void attn_unit(const bf16_t* __restrict__ Q, int qpitch, const bf16_t* __restrict__ K, const bf16_t* __restrict__ VT, int Lk, bf16_t* __restrict__ O, int opitch, LAS unsigned char* lds) {
    constexpr int KROW = 144, VROW = 136, KBYTES = 64 * KROW, VBYTES = DV * VROW, BUF = KBYTES + VBYTES, NV = DV / 64, NDB = DV / 32;
    int tid = threadIdx.x; asm volatile("" : "+v"(tid));
    const int wave = tid >> 6, lane = tid & 63, r = lane & 31, h = lane >> 5;
    bf16x8 qf[4];
    { const bf16_t* qrow = Q + (size_t)(wave * 32 + r) * qpitch;
#pragma unroll
      for (int s = 0; s < 4; ++s) qf[s] = *(const bf16x8*)(qrow + 16 * s + 8 * h); }
    f32x16 o[NDB];
#pragma unroll
    for (int db = 0; db < NDB; ++db)
#pragma unroll
        for (int i = 0; i < 16; ++i) o[db][i] = 0.f;
    float mrun = -1e30f, lrun = 0.f;
    const int skey = tid >> 3, sch = tid & 7;
    const bf16_t* kg = K + (size_t)skey * 64 + sch * 8;
    const bf16_t* vg = VT + (size_t)skey * Lk + sch * 8;
    const unsigned kwoff = skey * KROW + sch * 16, vwoff = KBYTES + skey * VROW + sch * 16;
    u32x4 kreg, vreg[NV];
    kreg = *(const u32x4*)kg;
#pragma unroll
    for (int i = 0; i < NV; ++i) vreg[i] = *(const u32x4*)(vg + (size_t)(64 * i) * Lk);
    *(LAS u32x4*)(lds + kwoff) = kreg;
#pragma unroll
    for (int i = 0; i < NV; ++i) { *(LAS u32x2*)(lds + vwoff + i * 64 * VROW) = (u32x2){vreg[i].x, vreg[i].y}; *(LAS u32x2*)(lds + vwoff + i * 64 * VROW + 8) = (u32x2){vreg[i].z, vreg[i].w}; }
    __syncthreads();
    const int nt = Lk >> 6;
    for (int kt = 0; kt < nt; ++kt) {
        LAS unsigned char* cb = lds + (kt & 1) * BUF;
        LAS unsigned char* nb = lds + ((kt & 1) ^ 1) * BUF;
        const bool more = kt + 1 < nt;
        if (more) {
            kreg = *(const u32x4*)(kg + (size_t)(kt + 1) * 64 * 64);
#pragma unroll
            for (int i = 0; i < NV; ++i) vreg[i] = *(const u32x4*)(vg + (size_t)(64 * i) * Lk + (kt + 1) * 64);
        }
        f32x16 s0, s1;
#pragma unroll
        for (int i = 0; i < 16; ++i) { s0[i] = 0.f; s1[i] = 0.f; }
#pragma unroll
        for (int s = 0; s < 4; ++s) {
            const bf16x8 k0 = *(const LAS bf16x8*)(cb + r * KROW + (16 * s + 8 * h) * 2);
            const bf16x8 k1 = *(const LAS bf16x8*)(cb + (32 + r) * KROW + (16 * s + 8 * h) * 2);
            s0 = __builtin_amdgcn_mfma_f32_32x32x16_bf16(k0, qf[s], s0, 0, 0, 0);
            s1 = __builtin_amdgcn_mfma_f32_32x32x16_bf16(k1, qf[s], s1, 0, 0, 0);
        }
        __builtin_amdgcn_sched_barrier(0);
        float mx = s0[0];
#pragma unroll
        for (int i = 1; i < 16; ++i) mx = fmaxf(mx, s0[i]);
#pragma unroll
        for (int i = 0; i < 16; ++i) mx = fmaxf(mx, s1[i]);
        mx = fmaxf(mx, __shfl_xor(mx, 32));
        const float mnew = fmaxf(mrun, mx);
        const float alpha = __builtin_amdgcn_exp2f(mrun - mnew);
        mrun = mnew;
        float rs = 0.f;
#pragma unroll
        for (int i = 0; i < 16; ++i) { s0[i] = __builtin_amdgcn_exp2f(s0[i] - mnew); s1[i] = __builtin_amdgcn_exp2f(s1[i] - mnew); rs += s0[i] + s1[i]; }
        lrun = lrun * alpha + rs;
#pragma unroll
        for (int db = 0; db < NDB; ++db)
#pragma unroll
            for (int i = 0; i < 16; ++i) o[db][i] *= alpha;
#pragma unroll
        for (int kb = 0; kb < 2; ++kb)
#pragma unroll
            for (int s2 = 0; s2 < 2; ++s2) {
                u32x4 pw;
                if (kb == 0) { pw.x = pk2(s0[8 * s2 + 0], s0[8 * s2 + 1]); pw.y = pk2(s0[8 * s2 + 2], s0[8 * s2 + 3]); pw.z = pk2(s0[8 * s2 + 4], s0[8 * s2 + 5]); pw.w = pk2(s0[8 * s2 + 6], s0[8 * s2 + 7]); }
                else { pw.x = pk2(s1[8 * s2 + 0], s1[8 * s2 + 1]); pw.y = pk2(s1[8 * s2 + 2], s1[8 * s2 + 3]); pw.z = pk2(s1[8 * s2 + 4], s1[8 * s2 + 5]); pw.w = pk2(s1[8 * s2 + 6], s1[8 * s2 + 7]); }
                const bf16x8 pf = __builtin_bit_cast(bf16x8, pw);
#pragma unroll
                for (int db = 0; db < NDB; ++db) {
                    const LAS unsigned char* vp = cb + KBYTES + (32 * db + r) * VROW + (32 * kb + 16 * s2 + 4 * h) * 2;
                    const u32x2 lo = *(const LAS u32x2*)vp, hi = *(const LAS u32x2*)(vp + 16);
                    const u32x4 vw = {lo.x, lo.y, hi.x, hi.y};
                    o[db] = __builtin_amdgcn_mfma_f32_32x32x16_bf16(__builtin_bit_cast(bf16x8, vw), pf, o[db], 0, 0, 0);
                }
                __builtin_amdgcn_sched_barrier(0);
            }
        if (more) {
            *(LAS u32x4*)(nb + kwoff) = kreg;
#pragma unroll
            for (int i = 0; i < NV; ++i) { *(LAS u32x2*)(nb + vwoff + i * 64 * VROW) = (u32x2){vreg[i].x, vreg[i].y}; *(LAS u32x2*)(nb + vwoff + i * 64 * VROW + 8) = (u32x2){vreg[i].z, vreg[i].w}; }
        }
        __syncthreads();
    }
    lrun += __shfl_xor(lrun, 32);
    const float inv = 1.f / lrun;
    bf16_t* orow = O + (size_t)(wave * 32 + r) * opitch;
#pragma unroll
    for (int db = 0; db < NDB; ++db)
#pragma unroll
        for (int g = 0; g < 4; ++g) {
            u32x2 w; w.x = pk2(o[db][4 * g] * inv, o[db][4 * g + 1] * inv); w.y = pk2(o[db][4 * g + 2] * inv, o[db][4 * g + 3] * inv);
            *(u32x2*)(orow + 32 * db + 8 * g + 4 * h) = w;
        }
}

template <int MODE> DI int srccol(int np) {
    if (MODE == 1) { const int pn = np >> 8, j = np & 255; return j < 128 ? 128 * pn + j : FF + 128 * pn + (j - 128); }
    if (MODE == 2) { const int t = np >> 8, p = np & 255; return 256 * t + 64 * ((p >> 5) & 3) + 32 * (p >> 7) + (p & 31); }
    return np;
}
template <int MODE> DI void tr_section(const float* __restrict__ src, int Nsrc, int Kr, int Nd, bf16_t* __restrict__ dst, int ldd, LAS float* tile) {
    const int tid = otid(), nkt = Kr >> 6, total = nkt * (Nd >> 6);
    for (int it = blockIdx.x; it < total; it += gridDim.x) {
        const int n0 = (it / nkt) * 64, k0 = (it % nkt) * 64;
        const int nn = tid & 63, kq = tid >> 6, sc = srccol<MODE>(n0 + nn);
#pragma unroll
        for (int i = 0; i < 8; ++i) { const int kk = kq + 8 * i; tile[kk * 65 + nn] = src[(size_t)(k0 + kk) * Nsrc + sc]; }
        __syncthreads();
        const int n2 = tid >> 3, kc = tid & 7;
        u32x4 w;
        w.x = pk2(tile[(8 * kc + 0) * 65 + n2], tile[(8 * kc + 1) * 65 + n2]); w.y = pk2(tile[(8 * kc + 2) * 65 + n2], tile[(8 * kc + 3) * 65 + n2]);
        w.z = pk2(tile[(8 * kc + 4) * 65 + n2], tile[(8 * kc + 5) * 65 + n2]); w.w = pk2(tile[(8 * kc + 6) * 65 + n2], tile[(8 * kc + 7) * 65 + n2]);
        *(u32x4*)(dst + (size_t)(n0 + n2) * ldd + k0 + 8 * kc) = w;
        __syncthreads();
    }
}

DI void convert_layer(const KArgs& a, int l, LAS unsigned char* lds) {
    unsigned char* ws = a.ws; const int tid = otid(), G = gridDim.x;
    LAS float* tile = (LAS float*)(lds + 32768);
    LAS float* t64 = (LAS float*)(lds + 65536);
    if (tid < 64) t64[tid] = cospif((float)tid * (1.f / 32.f));
    __syncthreads();
    tr_section<1>(a.in[20] + (size_t)l * D * 2 * FF, 2 * FF, D, 2 * FF, (bf16_t*)(ws + WS_WGU1), D, tile);
    tr_section<0>(a.in[21] + (size_t)l * FF * D, D, FF, D, (bf16_t*)(ws + WS_WD1), FF, tile);
    tr_section<2>(a.in[10] + (size_t)l * D * 2304, 2304, D, 2048, (bf16_t*)(ws + WS_WIN), D, tile);
    tr_section<0>(a.in[19] + (size_t)l * D * D, D, 768, D, (bf16_t*)(ws + WS_WOUT), D, tile);
    tr_section<1>(a.in[22] + (size_t)l * D * 2 * FF, 2 * FF, D, 2 * FF, (bf16_t*)(ws + WS_WGU2), D, tile);
    tr_section<0>(a.in[23] + (size_t)l * FF * D, D, FF, D, (bf16_t*)(ws + WS_WD2), FF, tile);
    { bf16_t* WinT = (bf16_t*)(ws + WS_WIN);
      for (int it = blockIdx.x; it < 1024; it += G) {
          const int rowi = it >> 1, kdim = (it & 1) * 512 + tid, cs = rowi >> 8, g = (rowi >> 6) & 3, k = rowi & 63;
          const float* wp = a.in[10] + ((size_t)l * D + kdim) * 2304 + 2048 + g * 64;
          float s = 0.f;
#pragma unroll 4
          for (int c4 = 0; c4 < 16; ++c4) { const f32x4 wv = *(const f32x4*)(wp + 4 * c4);
#pragma unroll
              for (int e = 0; e < 4; ++e) { const int idx = (k * (4 * c4 + e)) & 63; s += wv[e] * (cs ? t64[(idx - 16) & 63] : t64[idx]); } }
          WinT[(size_t)(2048 + rowi) * D + kdim] = f2bf(s);
      } }
    { bf16_t* WoutT = (bf16_t*)(ws + WS_WOUT);
      for (int it = blockIdx.x; it < 512; it += G) {
          const int i = it >> 1, n = (it & 1) * 512 + tid;
          const float* wf = a.in[18] + ((size_t)l * 256 + i) * 256;
          const float* wo = a.in[19] + ((size_t)l * D + 768) * D + n;
          float s = 0.f;
#pragma unroll 8
          for (int j = 0; j < 256; ++j) s += wf[j] * wo[(size_t)j * D];
          WoutT[(size_t)n * D + 768 + i] = f2bf(s);
      } }
    { bf16_t* KAS = (bf16_t*)(ws + WS_KAS); bf16_t* VAS = (bf16_t*)(ws + WS_VAS); bf16_t* KBS = (bf16_t*)(ws + WS_KBS); bf16_t* VBS = (bf16_t*)(ws + WS_VBS);
      for (int i = blockIdx.x * 512 + tid; i < 2 * 256 * 1280; i += G * 512) {
          const int e = i % 1280, bp = i / 1280, b = bp >> 8, pos = bp & 255;
          const size_t cbase = (size_t)((b * 2 + l) * 256 + pos);
          if (e < 128) { const int kvh = e >> 6, d = e & 63; KAS[((size_t)(b * 2 + kvh) * LKS + pos) * 64 + d] = f2bf(a.in[2][cbase * 128 + e]); }
          else if (e < 256) { const int e2 = e - 128, kvh = e2 >> 6, d = e2 & 63; VAS[((size_t)(b * 2 + kvh) * 64 + d) * LKS + pos] = f2bf(a.in[3][cbase * 128 + e2]); }
          else if (e < 768) { const int e2 = e - 256, s = e2 >> 6, d = e2 & 63; KBS[((size_t)(b * 8 + s) * LKS + pos) * 64 + d] = f2bf(a.in[4][cbase * 512 + e2]); }
          else { const int e2 = e - 768, hh = e2 >> 7, d = e2 & 127; VBS[((size_t)(b * 4 + hh) * 128 + d) * LKS + pos] = f2bf(a.in[5][cbase * 512 + e2]); }
      } }
    __syncthreads();
}

DI void p0_prologue(const KArgs& a, LAS unsigned char* lds) {
    unsigned char* ws = a.ws; const int tid = otid(), G = gridDim.x;
    if (blockIdx.x == 0 && tid < 64) ((unsigned*)(ws + WS_CTL))[tid] = 0u;
    { LAS float* sv = (LAS float*)lds; LAS float* red = (LAS float*)(lds + 16384);
      for (int i = tid; i < 3072; i += 512) { const int m = i >> 10, k = i & 1023; const float cv = (m == 0) ? a.in[7][k] : a.in[6][(m - 1) * D + k]; sv[i] = cv / (1.f + __expf(-cv)); }
      __syncthreads();
      float* MOD = (float*)(ws + WS_MOD);
      for (int it = blockIdx.x; it < 288; it += G) {
          const int l = it / 144, c0 = (it % 144) * 64, kg = tid >> 6, cc = tid & 63;
          const float* w = a.in[8] + (size_t)l * D * 9216 + c0 + cc;
          float a0 = 0.f, a1 = 0.f, a2 = 0.f;
#pragma unroll 8
          for (int k = kg; k < D; k += 8) { const float wv = w[(size_t)k * 9216]; a0 += sv[k] * wv; a1 += sv[1024 + k] * wv; a2 += sv[2048 + k] * wv; }
          red[(kg * 3 + 0) * 64 + cc] = a0; red[(kg * 3 + 1) * 64 + cc] = a1; red[(kg * 3 + 2) * 64 + cc] = a2;
          __syncthreads();
          if (tid < 192) { const int m = tid >> 6, c2 = tid & 63; float s = 0.f;
#pragma unroll
              for (int q = 0; q < 8; ++q) s += red[(q * 3 + m) * 64 + c2];
              MOD[(size_t)(l * 3 + m) * 9216 + c0 + c2] = s + a.in[9][l * 9216 + c0 + c2]; }
          __syncthreads();
      } }
    if (blockIdx.x == G - 1) {
        float* ROPE = (float*)(ws + WS_ROPE);
        for (int i = tid; i < 1024; i += 512) { const int pos = i >> 4, f = i & 15;
            const float inv = exp2f(-(float)f * (13.2877123795f / 16.f)); float rev = (float)pos * inv * 0.15915494309f; rev -= floorf(rev);
            ROPE[2 * i] = cospif(2.f * rev); ROPE[2 * i + 1] = sinpif(2.f * rev); }
    }
    { LAS float* tab = (LAS float*)lds;
      __syncthreads();
      for (int i = tid; i < 4096; i += 512) tab[i] = cospif((float)i * (1.f / 2048.f));
      __syncthreads();
      bf16_t* DS = (bf16_t*)(ws + WS_DFTS);
      for (int p = blockIdx.x; p < 4096; p += G)
          for (int ch = tid; ch < 1024; ch += 512) {
              const int k0 = ch * 8, n0 = k0 & 4095; const bool sp = k0 >= 4096; float v[8];
#pragma unroll
              for (int e = 0; e < 8; ++e) { const int idx = (p * (n0 + e)) & 4095; v[e] = (sp ? -tab[(idx - 1024) & 4095] : tab[idx]) * (1.f / 512.f); }
              u32x4 w; w.x = pk2(v[0], v[1]); w.y = pk2(v[2], v[3]); w.z = pk2(v[4], v[5]); w.w = pk2(v[6], v[7]);
              *(u32x4*)(DS + (size_t)p * 8192 + k0) = w;
          }
      bf16_t* DP = (bf16_t*)(ws + WS_DFTP);
      for (int p = blockIdx.x; p < 256; p += G)
          if (tid < 64) {
              const int k0 = tid * 8, n0 = k0 & 255; const bool sp = k0 >= 256; float v[8];
#pragma unroll
              for (int e = 0; e < 8; ++e) { const int idx = ((p * (n0 + e)) & 255) * 16; v[e] = (sp ? -tab[(idx - 1024) & 4095] : tab[idx]) * (1.f / 128.f); }
              u32x4 w; w.x = pk2(v[0], v[1]); w.y = pk2(v[2], v[3]); w.z = pk2(v[4], v[5]); w.w = pk2(v[6], v[7]);
              *(u32x4*)(DP + (size_t)p * 512 + k0) = w;
          }
      __syncthreads(); }
    convert_layer(a, 0, lds);
}

DI void p_modulate0(const KArgs& a) {
    const float* MOD = (const float*)(a.ws + WS_MOD); bf16_t* H = (bf16_t*)(a.ws + WS_H);
    for (int i = blockIdx.x * 512 + otid(); i < T * 128; i += gridDim.x * 512) {
        const int row = i >> 7, c0 = (i & 127) * 8;
        const float* sp = (row < TP) ? a.in[0] + (size_t)row * D : a.in[1] + (size_t)(row - TP) * D;
        const float* md = MOD + (size_t)(row < TP ? 0 : 1 + ((row - TP) >> 12)) * 9216;
        float v[8];
#pragma unroll
        for (int q = 0; q < 2; ++q) { const f32x4 x = *(const f32x4*)(sp + c0 + 4 * q), sh = *(const f32x4*)(md + c0 + 4 * q), sc = *(const f32x4*)(md + 1024 + c0 + 4 * q);
#pragma unroll
            for (int e = 0; e < 4; ++e) v[4 * q + e] = x[e] * (1.f + sc[e]) + sh[e]; }
        u32x4 w; w.x = pk2(v[0], v[1]); w.y = pk2(v[2], v[3]); w.z = pk2(v[4], v[5]); w.w = pk2(v[6], v[7]);
        *(u32x4*)(H + (size_t)row * D + c0) = w;
    }
}

DI void p_layernorm(const float* X, float* xo, bf16_t* H, const float* g, const float* bta, const float* modn  ) {
    const int tid = otid(), wave = tid >> 6, lane = tid & 63;
    for (int row = blockIdx.x * 8 + wave; row < T; row += gridDim.x * 8) {
        f32x4 v[4];
#pragma unroll
        for (int i = 0; i < 4; ++i) v[i] = *(const f32x4*)(X + (size_t)row * D + i * 256 + lane * 4);
        float s = 0.f;
#pragma unroll
        for (int i = 0; i < 4; ++i) s += (v[i][0] + v[i][1]) + (v[i][2] + v[i][3]);
        const float mean = wave_sum(s) * (1.f / 1024.f);
        float q = 0.f;
#pragma unroll
        for (int i = 0; i < 4; ++i) { v[i] = v[i] - mean; q += (v[i][0] * v[i][0] + v[i][1] * v[i][1]) + (v[i][2] * v[i][2] + v[i][3] * v[i][3]); }
        const float rstd = rsqrtf(wave_sum(q) * (1.f / 1024.f) + 1e-5f);
        const float* md = modn ? modn + (size_t)(row < TP ? 0 : 1 + ((row - TP) >> 12)) * 9216 : nullptr;
#pragma unroll
        for (int i = 0; i < 4; ++i) {
            const int c = i * 256 + lane * 4;
            const f32x4 y = v[i] * rstd * *(const f32x4*)(g + c) + *(const f32x4*)(bta + c);
            *(f32x4*)(xo + (size_t)row * D + c) = y;
            if (md) { const f32x4 sh = *(const f32x4*)(md + c), sc = *(const f32x4*)(md + 1024 + c);
                u32x2 w; w.x = pk2(y[0] * (1.f + sc[0]) + sh[0], y[1] * (1.f + sc[1]) + sh[1]); w.y = pk2(y[2] * (1.f + sc[2]) + sh[2], y[3] * (1.f + sc[3]) + sh[3]);
                *(u32x2*)(H + (size_t)row * D + c) = w; }
        }
    }
}

DI void p_combine(const KArgs& a, int l) {
    const int tid = otid(), wave = tid >> 6, lane = tid & 63;
    const bf16_t* OBT = (const bf16_t*)(a.ws + WS_H); bf16_t* MIX = (bf16_t*)(a.ws + WS_MIX); const float* FACC = (const float*)(a.ws + WS_FACC);
    const float lam_init = (l == 0) ? 0.2f : (0.8f - 0.6f * 0.74081822068f);
    const float d1 = wave_sum(a.in[13][l * 64 + lane] * a.in[14][l * 64 + lane]), d2 = wave_sum(a.in[15][l * 64 + lane] * a.in[16][l * 64 + lane]);
    const float lam = expf(d1) - expf(d2) + lam_init;
    const float g0 = a.in[17][l * 128 + 2 * lane] * (1.f - lam_init), g1 = a.in[17][l * 128 + 2 * lane + 1] * (1.f - lam_init);
    for (int row = blockIdx.x * 8 + wave; row < T; row += gridDim.x * 8) {
#pragma unroll
        for (int hb = 0; hb < 4; ++hb) {
            const unsigned w1 = *(const unsigned*)(OBT + (size_t)row * D + hb * 256 + 2 * lane), w2 = *(const unsigned*)(OBT + (size_t)row * D + hb * 256 + 128 + 2 * lane);
            const float x0 = __uint_as_float(w1 << 16) - lam * __uint_as_float(w2 << 16), x1 = __uint_as_float(w1 & 0xffff0000u) - lam * __uint_as_float(w2 & 0xffff0000u);
            const float rs = rsqrtf(wave_sum(x0 * x0 + x1 * x1) * (1.f / 128.f) + 1e-6f);
            *(unsigned*)(MIX + (size_t)row * D + 256 + hb * 128 + 2 * lane) = pk2(x0 * rs * g0, x1 * rs * g1);
        }
        const f32x4 f = *(const f32x4*)(FACC + (size_t)row * 256 + lane * 4);
        u32x2 w; w.x = pk2(f[0], f[1]); w.y = pk2(f[2], f[3]);
        *(u32x2*)(MIX + (size_t)row * D + 768 + lane * 4) = w;
    }
}

constexpr int N_PHASES = 24;
#define PHM(i) ((MASK >> (i)) & 1)
template <int MASK> __global__ void __launch_bounds__(512) trunk_fwd(KArgs a) {
    extern __shared__ __attribute__((aligned(16))) unsigned char lds_raw[];
    LAS unsigned char* lds = (LAS unsigned char*)lds_raw;
    cg::grid_group grid = cg::this_grid();
    unsigned char* ws = a.ws;
    const int G = gridDim.x, c = blockIdx.x;
    float* X = (float*)(ws + WS_X); bf16_t* H = (bf16_t*)(ws + WS_H); bf16_t* ACT = (bf16_t*)(ws + WS_ACT); bf16_t* MIX = (bf16_t*)(ws + WS_MIX);
    const float* MOD = (const float*)(ws + WS_MOD);
    for (int ph = a.ph_lo; ph < a.ph_hi; ++ph) {
        const int tid = otid();
        if (ph == 0) { if (PHM(0)) p0_prologue(a, lds); }
        else if (ph == 1) { if (PHM(1)) p_modulate0(a); }
        else {
            const int l = (ph - 2) / 11, k = (ph - 2) % 11;
            const float* modl = MOD + (size_t)l * 3 * 9216;
            if (k == 0 || k == 8) { if (PHM(2)) {
                pg8::Gemm g{H, (const bf16_t*)(ws + (k == 0 ? WS_WGU1 : WS_WGU2)), D, D}; pg8::StaticOrder S; S.init(T, 2 * FF, G, c);
                pg8::EpiGU E{ACT};
                pg8::gemm_phase<pg8::EpiGU, pg8::StaticOrder, true, true>(lds, g, S, E); }
            } else if (k == 1 || k == 9 || k == 6) { if (PHM(3)) {
                pg8::Gemm g; pg8::EpiRes E;
                if (k == 6) { g = pg8::Gemm{MIX, (const bf16_t*)(ws + WS_WOUT), D, D}; E = pg8::EpiRes{X, X + (size_t)TP * D, X, modl + 5 * 1024, 1.0f}; }
                else { g = pg8::Gemm{ACT, (const bf16_t*)(ws + (k == 1 ? WS_WD1 : WS_WD2)), FF, FF};
                    const bool first = (l == 0 && k == 1);
                    E = pg8::EpiRes{first ? a.in[0] : X, first ? a.in[1] : X + (size_t)TP * D, X, modl + (k == 1 ? 2 : 8) * 1024, 0.5f}; }
                pg8::StaticOrder S; S.init(T, D, G, c);
                pg8::gemm_phase<pg8::EpiRes, pg8::StaticOrder, true, true>(lds, g, S, E); }
            } else if (k == 2 || k == 7 || k == 10) { if (PHM(4)) {
                const int which = (k == 2) ? 0 : (k == 7 ? 1 : 2);
                const float* lg = a.in[24] + (size_t)(l * 3 + which) * D; const float* lb = a.in[25] + (size_t)(l * 3 + which) * D;
                const bool final_ = (l == 1 && k == 10);
                const float* modn = (k == 2) ? modl + 3 * 1024 : (k == 7) ? modl + 6 * 1024 : (final_ ? nullptr : MOD + (size_t)(l + 1) * 3 * 9216);
                p_layernorm(X, final_ ? a.out : X, H, lg, lb, modn);
                if (k == 2) {
                    f32x4* F4 = (f32x4*)(ws + WS_FACC);
                    for (int i = c * 512 + tid; i < T * 64; i += G * 512) F4[i] = (f32x4){0.f, 0.f, 0.f, 0.f};
                }
                if (k == 10 && l == 0) convert_layer(a, 1, lds); }
            } else if (k == 3) { if (PHM(5)) {
                pg8::Gemm g{H, (const bf16_t*)(ws + WS_WIN), D, D}; pg8::StaticOrder S; S.init(T, NIN, G, c);
                pg8::EpiIn E{l, a.in[11], a.in[12], a.out, ws};
                pg8::gemm_phase<pg8::EpiIn, pg8::StaticOrder, true, true>(lds, g, S, E); }
            } else if (k == 4) {
                if (PHM(6)) {
#pragma clang loop unroll(disable)
                    for (int pass = 0; pass < 2; ++pass) {
                        const bool sp = pass == 0;
                        pg8::Gemm g{(const bf16_t*)(ws + (sp ? WS_DFTS : WS_DFTP)), (const bf16_t*)(ws + (sp ? WS_UTS : WS_UTP)), sp ? 8192 : 512, sp ? 1024 : 512};
                        pg8::FourOrder S{G, c, sp ? 256 : 16, pass}; pg8::EpiFour E{(float*)(ws + WS_FACC), pass};
                        pg8::gemm_phase<pg8::EpiFour, pg8::FourOrder, true, true>(lds, g, S, E);
                    }
                }
                volatile LAS int* qslot = (volatile LAS int*)(lds + MISC_OFF);
                unsigned* ctr = (unsigned*)(ws + WS_CTL) + l;
                const bf16_t* QA = (const bf16_t*)(ws + WS_QA); const bf16_t* QB = (const bf16_t*)(ws + WS_QB);
                bf16_t* OBT = (bf16_t*)(ws + WS_H);
                if (PHM(7)) for (;;) {
                    __syncthreads();
                    if (tid == 0) *qslot = (int)atomicAdd(ctr, 1u);
                    __syncthreads();
                    const int idx = *qslot;
                    if (idx >= 576) break;
                    const bf16_t *Qp, *Kp, *Vp; bf16_t* Op; int qpitch, Lk; bool wide;
                    if (idx < 256) { const int b = idx >> 7, s = (idx >> 4) & 7, qb = idx & 15; const size_t tok0 = TP + b * 4096 + qb * 256; wide = true; qpitch = 512; Lk = LKS;
                        Qp = QB + tok0 * 512 + s * 64; Kp = (const bf16_t*)(ws + WS_KBS) + (size_t)(b * 8 + s) * LKS * 64; Vp = (const bf16_t*)(ws + WS_VBS) + (size_t)(b * 4 + (s >> 1)) * 128 * LKS; Op = OBT + tok0 * D + s * 128; }
                    else if (idx < 384) { const int i = idx - 256, b = i >> 6, hq = (i >> 4) & 3, qb = i & 15; const size_t tok0 = TP + b * 4096 + qb * 256; wide = false; qpitch = 256; Lk = LKS;
                        Qp = QA + tok0 * 256 + hq * 64; Kp = (const bf16_t*)(ws + WS_KAS) + (size_t)(b * 2 + (hq >> 1)) * LKS * 64; Vp = (const bf16_t*)(ws + WS_VAS) + (size_t)(b * 2 + (hq >> 1)) * 64 * LKS; Op = MIX + tok0 * D + hq * 64; }
                    else if (idx < 512) { const int i = idx - 384, b = i >> 3, s = i & 7; const size_t tok0 = b * 256; wide = true; qpitch = 512; Lk = 256;
                        Qp = QB + tok0 * 512 + s * 64; Kp = (const bf16_t*)(ws + WS_KBP) + (size_t)(b * 8 + s) * 256 * 64; Vp = (const bf16_t*)(ws + WS_VBP) + (size_t)(b * 4 + (s >> 1)) * 128 * 256; Op = OBT + tok0 * D + s * 128; }
                    else { const int i = idx - 512, b = i >> 2, hq = i & 3; const size_t tok0 = b * 256; wide = false; qpitch = 256; Lk = 256;
                        Qp = QA + tok0 * 256 + hq * 64; Kp = (const bf16_t*)(ws + WS_KAP) + (size_t)(b * 2 + (hq >> 1)) * 256 * 64; Vp = (const bf16_t*)(ws + WS_VAP) + (size_t)(b * 2 + (hq >> 1)) * 64 * 256; Op = MIX + tok0 * D + hq * 64; }
                    if (wide) attn_unit<128>(Qp, qpitch, Kp, Vp, Lk, Op, D, lds); else attn_unit<64>(Qp, qpitch, Kp, Vp, Lk, Op, D, lds);
                }
            } else if (k == 5) {
                if (PHM(8)) p_combine(a, l);
            }
        }
        if (ph + 1 < a.ph_hi) grid.sync();
    }
}

typedef void (*kern_t)(KArgs);
extern "C" void kernel_launch(void* const* d_in, const int* in_sizes, int n_in, void* d_out, int out_size, void* d_ws, size_t ws_size, hipStream_t stream) {
    static int grid = 0;
#if MK_PER_PHASE
    static const kern_t kerns[8] = {trunk_fwd<0x1>, trunk_fwd<0x2>, trunk_fwd<0x4>, trunk_fwd<0x8>, trunk_fwd<0x10>, trunk_fwd<0x20>, trunk_fwd<0xC0>, trunk_fwd<0x100>};
    constexpr int NK = 8;
#else
    static const kern_t kerns[1] = {trunk_fwd<0x1ff>};
    constexpr int NK = 1;
#endif
    if (grid == 0) {
        if (n_in != 26 || ws_size < WS_END) { fprintf(stderr, "kernel_launch: need 26 inputs and %zu bytes of workspace; got %d, %zu\n", (size_t)WS_END, n_in, ws_size); grid = -1; return; }
        int dev = 0, cus = 0, per_cu = 0;
        if (hipGetDevice(&dev) != hipSuccess || hipDeviceGetAttribute(&cus, hipDeviceAttributeMultiprocessorCount, dev) != hipSuccess) { grid = -1; return; }
        for (int i = 0; i < NK; ++i) {
            if (hipFuncSetAttribute((const void*)kerns[i], hipFuncAttributeMaxDynamicSharedMemorySize, LDS_BYTES) != hipSuccess) { fprintf(stderr, "kernel_launch: hipFuncSetAttribute failed\n"); grid = -1; return; }
            if (hipOccupancyMaxActiveBlocksPerMultiprocessor(&per_cu, (const void*)kerns[i], 512, LDS_BYTES) != hipSuccess || per_cu < 1) { fprintf(stderr, "kernel_launch: occupancy query says %d\n", per_cu); (void)hipGetLastError(); grid = -1; return; }
        }
        grid = cus * 1;
    }
    if (grid < 0) return;
    KArgs a{};
    for (int i = 0; i < 26; ++i) a.in[i] = (const float*)d_in[i];
    a.out = (float*)d_out; a.ws = (unsigned char*)d_ws;
#if MK_PER_PHASE
    for (int ph = 0; ph < N_PHASES; ++ph) {
        a.ph_lo = ph; a.ph_hi = ph + 1;
        int ki;
        if (ph < 2) ki = ph;
        else { const int k = (ph - 2) % 11; ki = (k == 0 || k == 8) ? 2 : (k == 1 || k == 9 || k == 6) ? 3 : (k == 2 || k == 7 || k == 10) ? 4 : (k == 3) ? 5 : (k == 4) ? 6 : 7; }
        hipLaunchKernelGGL(kerns[ki], dim3(grid), dim3(512), LDS_BYTES, stream, a);
    }
#else
    a.ph_lo = 0; a.ph_hi = N_PHASES;
    void* args[] = {&a};
    hipError_t e = hipLaunchCooperativeKernel((const void*)kerns[0], dim3(grid), dim3(512), args, LDS_BYTES, stream);
    if (e != hipSuccess) fprintf(stderr, "cooperative launch failed: %s (grid %d)\n", hipGetErrorString(e), grid);
#endif
}
```

```cpp
#include <hip/hip_runtime.h>
#include <hip/hip_cooperative_groups.h>
#include <cstdio>
#include <cstdint>
namespace cg = cooperative_groups;

#ifndef MK_PER_PHASE
#define MK_PER_PHASE 0
#endif

#define DI __device__ __forceinline__
#define LAS __attribute__((address_space(3)))
typedef unsigned short bf16_t;
typedef short bf16x8 __attribute__((ext_vector_type(8)));
typedef short s16x4 __attribute__((ext_vector_type(4)));
typedef float f32x4 __attribute__((ext_vector_type(4)));
typedef float f32x16 __attribute__((ext_vector_type(16)));
typedef unsigned u32x4 __attribute__((ext_vector_type(4)));
typedef unsigned u32x2 __attribute__((ext_vector_type(2)));
typedef __bf16 bf16x2_t __attribute__((ext_vector_type(2)));
typedef float f32x2_t __attribute__((ext_vector_type(2)));

DI unsigned pk2(float lo, float hi) { f32x2_t v = {lo, hi}; bf16x2_t b = __builtin_convertvector(v, bf16x2_t); return __builtin_bit_cast(unsigned, b); }
DI bf16_t f2bf(float f) { return (bf16_t)(pk2(f, 0.f) & 0xffffu); }
DI int otid() { int t = threadIdx.x; asm volatile("" : "+v"(t)); return t; }
DI float wave_sum(float v) { v += __shfl_xor(v, 1); v += __shfl_xor(v, 2); v += __shfl_xor(v, 4); v += __shfl_xor(v, 8); v += __shfl_xor(v, 16); v += __shfl_xor(v, 32); return v; }

constexpr int T = 12288, TP = 4096, D = 1024, FF = 2816, NIN = 2560, LKS = 4352;
constexpr float ALPHA = 1.41421356237f;
constexpr float QSCALE = 0.125f * 1.44269504089f;

constexpr size_t al256(size_t x) { return (x + 255) & ~(size_t)255; }
constexpr size_t WS_CTL = 0;
constexpr size_t WS_MOD = 16384;
constexpr size_t WS_ROPE = WS_MOD + al256(2 * 3 * 9216 * 4);
constexpr size_t WS_DFTP = WS_ROPE + 8192;
constexpr size_t WS_DFTS = WS_DFTP + 256 * 512 * 2;
constexpr size_t WS_WGU1 = WS_DFTS + (size_t)4096 * 8192 * 2;
constexpr size_t WS_WD1 = WS_WGU1 + (size_t)5632 * 1024 * 2;
constexpr size_t WS_WIN = WS_WD1 + (size_t)1024 * 2816 * 2;
constexpr size_t WS_WOUT = WS_WIN + (size_t)2560 * 1024 * 2;
constexpr size_t WS_WGU2 = WS_WOUT + (size_t)1024 * 1024 * 2;
constexpr size_t WS_WD2 = WS_WGU2 + (size_t)5632 * 1024 * 2;
constexpr size_t WS_X = WS_WD2 + (size_t)1024 * 2816 * 2;
constexpr size_t WS_KAS = WS_X + (size_t)T * D * 4;
constexpr size_t WS_VAS = WS_KAS + (size_t)2 * 2 * LKS * 64 * 2;
constexpr size_t WS_KBS = WS_VAS + (size_t)2 * 2 * LKS * 64 * 2;
constexpr size_t WS_VBS = WS_KBS + (size_t)2 * 8 * LKS * 64 * 2;
constexpr size_t WS_H = WS_VBS + (size_t)2 * 4 * 128 * LKS * 2;
constexpr size_t WS_R = WS_H + (size_t)T * D * 2;
constexpr size_t WS_ACT = WS_R;
constexpr size_t WS_QA = WS_R;
constexpr size_t WS_QB = WS_QA + (size_t)T * 256 * 2;
constexpr size_t WS_KAP = WS_QB + (size_t)T * 512 * 2;
constexpr size_t WS_VAP = WS_KAP + (size_t)16 * 2 * 256 * 64 * 2;
constexpr size_t WS_KBP = WS_VAP + (size_t)16 * 2 * 256 * 64 * 2;
constexpr size_t WS_VBP = WS_KBP + (size_t)16 * 8 * 256 * 64 * 2;
constexpr size_t WS_UTP = WS_VBP + (size_t)16 * 4 * 128 * 256 * 2;
constexpr size_t WS_UTS = WS_UTP + (size_t)4096 * 512 * 2;
constexpr size_t WS_MIX = WS_UTS + (size_t)512 * 8192 * 2;
constexpr size_t WS_FACC = WS_MIX + (size_t)T * D * 2;
constexpr size_t WS_REND = WS_FACC + (size_t)T * 256 * 4;
constexpr size_t WS_END = (WS_REND > WS_ACT + (size_t)T * FF * 2) ? WS_REND : WS_ACT + (size_t)T * FF * 2;

constexpr int LDS_RING = 131072, MISC_OFF = LDS_RING, LDS_BYTES = LDS_RING + 256;

struct KArgs { const float* in[26]; float* out; unsigned char* ws; int ph_lo, ph_hi; };

namespace pg8 {
constexpr int BM = 256, BK = 64, HALF = 128, HTB = HALF * BK * 2, STAGE_BYTES = 8 * HTB, NXCD = 8, WGM = 8;
DI int lds_byte(int r, int c) { const int st = (r >> 4) * 2 + (c >> 5), rr = r & 15, cc = c & 31, ob = rr * 64 + cc * 2; return st * 1024 + (ob ^ (((ob >> 9) & 1) << 5)); }
DI void stage_rc(int b, int& R, int& C) { const int st = b / 1024, sb = b % 1024, swz = sb ^ (((sb >> 9) & 1) << 5); R = (st >> 1) * 16 + swz / 64; C = (st & 1) * 32 + (swz % 64) / 2; }
DI int perm32(int rho) { const int n = rho >> 4, i = rho & 15; return 8 * (i >> 2) + 4 * n + (i & 3); }

struct Unit { int pm, pn, ko; };
struct Gemm { const bf16_t* A; const bf16_t* Bt; int ld, K; };

struct StaticOrder {
    int nM, nN, nwg, G, c;
    DI void init(int M, int N, int G_, int c_) { nM = M / BM; nN = N / BM; nwg = nM * nN; G = G_; c = c_; }
    DI bool next(int i, Unit& u) const {
        const long L = (long)i * G + c; if (L >= nwg) return false;
        int wgid = (int)L; { const int q = nwg / NXCD, r = nwg % NXCD, xcd = wgid % NXCD, off = wgid / NXCD; wgid = (xcd < r ? xcd * (q + 1) : r * (q + 1) + (xcd - r) * q) + off; }
        const int nig = WGM * nN, gid = wgid / nig, fm = gid * WGM, gsz = (nM - fm) < WGM ? (nM - fm) : WGM;
        u.pm = fm + ((wgid % nig) % gsz); u.pn = (wgid % nig) / gsz; u.ko = 0; return true;
    }
};
struct FourOrder {
    int G, c, total, mode;
    DI bool next(int i, Unit& u) const {
        const int L = i * G + c; if (L >= total) return false;
        if (mode == 0) { u.ko = (L >> 5) * 1024; const int tile = L & 31; u.pm = tile >> 1; u.pn = tile & 1; }
        else { u.ko = 0; u.pm = 0; u.pn = L; }
        return true;
    }
};

template <class Epi, class Sched, bool ALIGN_EPI, bool SP2>
DI void gemm_phase(LAS unsigned char* lds, const Gemm g, const Sched& S, const Epi& E) {
    int tid = threadIdx.x; asm volatile("" : "+v"(tid));
    const int wid = __builtin_amdgcn_readfirstlane(tid >> 6), lane = tid & 63, wr = wid >> 2, wc = wid & 3, fr = lane & 15, fq = lane >> 4;
    const int K = g.K, nt = K / BK, ld = g.ld;
    unsigned voffA[2], voffB[2];
#pragma unroll
    for (int i = 0; i < 2; ++i) { int R, C; stage_rc(tid * 16 + i * 8192, R, C); const int Rb = (R & ~31) + perm32(R & 31);
        voffA[i] = (unsigned)(R * ld + C) * 2u; voffB[i] = (unsigned)(Rb * ld + C) * 2u; }
    const size_t kstep = (size_t)(BK * 2);
    const size_t hstep = (size_t)HALF * ld * 2;
    const size_t tstep = 2 * hstep;
    const unsigned ldsw = (unsigned)wid * 1024u;
    const int aoff = lds_byte(wr * 64 + fr, fq * 8), boff = lds_byte(wc * 32 + fr, fq * 8);
#define PG8_SA(b, h) (((b) * 2 + (h)) * HTB)
#define PG8_SB(b, h) ((4 + (b) * 2 + (h)) * HTB)
#define PG8_STAGE(bufoff, gbase, voff) do { _Pragma("unroll") for (int _i = 0; _i < 2; ++_i) \
        __builtin_amdgcn_global_load_lds((const unsigned*)((const char*)(gbase) + (voff)[_i]), (LAS unsigned*)(lds + (bufoff) + ldsw + _i * 8192), 16, 0, 0); } while (0)
#define PG8_LDA(dst, b, h) do { _Pragma("unroll") for (int m = 0; m < 4; ++m) _Pragma("unroll") for (int k = 0; k < 2; ++k) dst[m][k] = *(const LAS bf16x8*)(lds + PG8_SA(b, h) + aoff + m * 2048 + k * 1024); } while (0)
#define PG8_LDB(dst, b, h) do { _Pragma("unroll") for (int n = 0; n < 2; ++n) _Pragma("unroll") for (int k = 0; k < 2; ++k) dst[n][k] = *(const LAS bf16x8*)(lds + PG8_SB(b, h) + boff + n * 2048 + k * 1024); } while (0)
#define PG8_MMA(ai, bj, At, Bt) do { __builtin_amdgcn_s_setprio(1); _Pragma("unroll") for (int m = 0; m < 4; ++m) _Pragma("unroll") for (int n = 0; n < 2; ++n) _Pragma("unroll") for (int k = 0; k < 2; ++k) \
        acc[ai][bj][m][n] = __builtin_amdgcn_mfma_f32_16x16x32_bf16(Bt[n][k], At[m][k], acc[ai][bj][m][n], 0, 0, 0); __builtin_amdgcn_s_setprio(0); } while (0)
#define PG8_WAIT_V(n) asm volatile("s_waitcnt vmcnt(" #n ")" ::: "memory")
#define PG8_WAIT_L(n) asm volatile("s_waitcnt lgkmcnt(" #n ")" ::: "memory")
#define PG8_BAR __builtin_amdgcn_s_barrier()
#define PG8_SCHED __builtin_amdgcn_sched_barrier(0)
    Unit cur, nxt; int ui = 0;
    if (!S.next(0, cur)) return;
    f32x4 acc[2][2][4][2];
#pragma unroll
    for (int a = 0; a < 2; ++a)
#pragma unroll
        for (int b = 0; b < 2; ++b)
#pragma unroll
            for (int m = 0; m < 4; ++m)
#pragma unroll
                for (int n = 0; n < 2; ++n) acc[a][b][m][n] = (f32x4){0.f, 0.f, 0.f, 0.f};
    bf16x8 At[4][2], B0[2][2], B1[2][2];
    const char* cA = (const char*)g.A + (size_t)cur.pm * tstep + (size_t)cur.ko * 2; const char* cB = (const char*)g.Bt + (size_t)cur.pn * tstep + (size_t)cur.ko * 2;
    if constexpr (SP2) {
        PG8_STAGE(PG8_SB(0, 0), cB, voffB); PG8_STAGE(PG8_SB(0, 1), cB + hstep, voffB); PG8_STAGE(PG8_SA(0, 0), cA, voffA); PG8_STAGE(PG8_SA(0, 1), cA + hstep, voffA);
        if (wr == 1) PG8_BAR;
        PG8_WAIT_V(2); PG8_BAR;
        PG8_STAGE(PG8_SB(1, 0), cB + kstep, voffB); PG8_STAGE(PG8_SA(1, 0), cA + kstep, voffA); PG8_STAGE(PG8_SB(1, 1), cB + hstep + kstep, voffB);
        PG8_WAIT_V(6); PG8_BAR;
    } else {
        PG8_STAGE(PG8_SB(0, 0), cB, voffB); PG8_STAGE(PG8_SA(0, 0), cA, voffA); PG8_STAGE(PG8_SB(0, 1), cB + hstep, voffB); PG8_STAGE(PG8_SA(0, 1), cA + hstep, voffA);
        if (wr == 1) PG8_BAR;
        PG8_WAIT_V(4); PG8_BAR;
        PG8_STAGE(PG8_SB(1, 0), cB + kstep, voffB); PG8_STAGE(PG8_SA(1, 0), cA + kstep, voffA); PG8_STAGE(PG8_SB(1, 1), cB + hstep + kstep, voffB);
        PG8_WAIT_V(6); PG8_BAR;
    }
    for (;;) {
        const bool has_next = S.next(ui + 1, nxt);
        const char* nA = has_next ? (const char*)g.A + (size_t)nxt.pm * tstep + (size_t)nxt.ko * 2 : cA; const char* nB = has_next ? (const char*)g.Bt + (size_t)nxt.pn * tstep + (size_t)nxt.ko * 2 : cB;
        for (int t = 0; t < nt; t += 2) {
            const bool last = (t == nt - 2);
            const char* a1 = cA + (size_t)(t + 1) * kstep;
            const char* a2 = last ? nA : cA + (size_t)(t + 2) * kstep; const char* b2 = last ? nB : cB + (size_t)(t + 2) * kstep;
            const char* a3 = a2 + kstep; const char* b3 = b2 + kstep;
            if constexpr (SP2) {
            PG8_LDB(B0, 0, 0); PG8_LDB(B1, 0, 1); PG8_SCHED; PG8_LDA(At, 0, 0); PG8_STAGE(PG8_SA(1, 1), a1 + hstep, voffA);
            PG8_WAIT_V(8); PG8_WAIT_L(0); PG8_BAR; PG8_MMA(0, 0, At, B0); PG8_MMA(0, 1, At, B1); PG8_BAR; PG8_SCHED;
            PG8_LDA(At, 0, 1); PG8_STAGE(PG8_SB(0, 0), b2, voffB); PG8_STAGE(PG8_SB(0, 1), b2 + hstep, voffB); PG8_STAGE(PG8_SA(0, 0), a2, voffA);
            PG8_WAIT_V(8); PG8_WAIT_L(0); PG8_BAR; PG8_MMA(1, 0, At, B0); PG8_MMA(1, 1, At, B1); PG8_BAR; PG8_SCHED;
            PG8_LDB(B0, 1, 0); PG8_LDB(B1, 1, 1); PG8_SCHED; PG8_LDA(At, 1, 0); PG8_STAGE(PG8_SA(0, 1), a2 + hstep, voffA);
            PG8_WAIT_V(8); PG8_WAIT_L(0); PG8_BAR; PG8_MMA(0, 0, At, B0); PG8_MMA(0, 1, At, B1); PG8_BAR; PG8_SCHED;
            PG8_LDA(At, 1, 1); PG8_STAGE(PG8_SB(1, 0), b3, voffB); PG8_STAGE(PG8_SB(1, 1), b3 + hstep, voffB); PG8_STAGE(PG8_SA(1, 0), a3, voffA);
            PG8_WAIT_V(8); PG8_WAIT_L(0); PG8_BAR; PG8_MMA(1, 0, At, B0); PG8_MMA(1, 1, At, B1); PG8_BAR; PG8_SCHED;
            } else {
            PG8_LDB(B0, 0, 0); PG8_SCHED; PG8_LDA(At, 0, 0); PG8_STAGE(PG8_SA(1, 1), a1 + hstep, voffA);
            PG8_WAIT_L(8); PG8_BAR; PG8_WAIT_L(0); PG8_MMA(0, 0, At, B0); PG8_BAR; PG8_SCHED;
            PG8_LDB(B1, 0, 1); PG8_STAGE(PG8_SB(0, 0), b2, voffB);
            PG8_BAR; PG8_WAIT_L(0); PG8_MMA(0, 1, At, B1); PG8_BAR;
            PG8_LDA(At, 0, 1); PG8_STAGE(PG8_SA(0, 0), a2, voffA);
            PG8_BAR; PG8_WAIT_L(0); PG8_MMA(1, 0, At, B0); PG8_BAR; PG8_SCHED;
            PG8_STAGE(PG8_SB(0, 1), b2 + hstep, voffB);
            PG8_WAIT_V(6); PG8_BAR; PG8_MMA(1, 1, At, B1); PG8_BAR;
            PG8_LDB(B0, 1, 0); PG8_SCHED; PG8_LDA(At, 1, 0); PG8_STAGE(PG8_SA(0, 1), a2 + hstep, voffA);
            PG8_WAIT_L(8); PG8_BAR; PG8_WAIT_L(0); PG8_MMA(0, 0, At, B0); PG8_BAR; PG8_SCHED;
            PG8_LDB(B1, 1, 1); PG8_STAGE(PG8_SB(1, 0), b3, voffB);
            PG8_BAR; PG8_WAIT_L(0); PG8_MMA(0, 1, At, B1); PG8_BAR;
            PG8_LDA(At, 1, 1); PG8_STAGE(PG8_SA(1, 0), a3, voffA);
            PG8_BAR; PG8_WAIT_L(0); PG8_MMA(1, 0, At, B0); PG8_BAR; PG8_SCHED;
            PG8_STAGE(PG8_SB(1, 1), b3 + hstep, voffB);
            PG8_WAIT_V(6); PG8_BAR; PG8_MMA(1, 1, At, B1); PG8_BAR;
            }
        }
        if constexpr (ALIGN_EPI) { if (wr == 0) PG8_BAR; }
        E(acc, cur, wr, wc, fr, fq);
        if (!has_next) break;
#pragma unroll
        for (int a = 0; a < 2; ++a)
#pragma unroll
            for (int b = 0; b < 2; ++b)
#pragma unroll
                for (int m = 0; m < 4; ++m)
#pragma unroll
                    for (int n = 0; n < 2; ++n) acc[a][b][m][n] = (f32x4){0.f, 0.f, 0.f, 0.f};
        cur = nxt; cA = nA; cB = nB; ++ui;
        if constexpr (ALIGN_EPI) { if (wr == 1) PG8_BAR; }
    }
    PG8_WAIT_V(0);
    if constexpr (!ALIGN_EPI) { if (wr == 0) PG8_BAR; }
    PG8_BAR;
#undef PG8_SA
#undef PG8_SB
#undef PG8_STAGE
#undef PG8_LDA
#undef PG8_LDB
#undef PG8_MMA
#undef PG8_WAIT_V
#undef PG8_WAIT_L
#undef PG8_BAR
#undef PG8_SCHED
}

DI int mod_of_row_tile(int pm) { return pm < 16 ? 0 : 1 + ((pm - 16) >> 4); }

struct EpiGU {
    bf16_t* ACT;
    DI void operator()(const f32x4 (&acc)[2][2][4][2], const Unit& u, int wr, int wc, int fr_in, int fq_in) const {
        int fr = fr_in, fq = fq_in; asm volatile("" : "+v"(fr), "+v"(fq));
#pragma unroll
        for (int ai = 0; ai < 2; ++ai)
#pragma unroll
            for (int m = 0; m < 4; ++m) {
                const int row = u.pm * 256 + ai * 128 + wr * 64 + m * 16 + fr;
                float o[8];
#pragma unroll
                for (int n = 0; n < 2; ++n)
#pragma unroll
                    for (int j = 0; j < 4; ++j) { const float gg = acc[ai][0][m][n][j], uu = acc[ai][1][m][n][j];
                        const float sg = gg * __builtin_amdgcn_rcpf(1.f + __builtin_amdgcn_exp2f(-1.44269504089f * gg)); o[n * 4 + j] = sg * uu; }
                u32x4 w; w.x = pk2(o[0], o[1]); w.y = pk2(o[2], o[3]); w.z = pk2(o[4], o[5]); w.w = pk2(o[6], o[7]);
                *(u32x4*)(ACT + (size_t)row * FF + u.pn * 128 + wc * 32 + fq * 8) = w;
            }
    }
};

struct EpiRes {
    const float* srcP; const float* srcS; float* X; const float* gate; float coef;
    DI void operator()(const f32x4 (&acc)[2][2][4][2], const Unit& u, int wr, int wc, int fr_in, int fq_in) const {
        int fr = fr_in, fq = fq_in; asm volatile("" : "+v"(fr), "+v"(fq));
        const float* gt = gate + mod_of_row_tile(u.pm) * 9216;
        f32x4 gv[2][2];
#pragma unroll
        for (int bj = 0; bj < 2; ++bj)
#pragma unroll
            for (int n = 0; n < 2; ++n) gv[bj][n] = *(const f32x4*)(gt + u.pn * 256 + bj * 128 + wc * 32 + fq * 8 + n * 4) * coef;
#pragma unroll
        for (int ai = 0; ai < 2; ++ai)
#pragma unroll
            for (int m = 0; m < 4; ++m) {
                const int row = u.pm * 256 + ai * 128 + wr * 64 + m * 16 + fr;
                const float* sp = (row < TP) ? srcP + (size_t)row * D : srcS + (size_t)(row - TP) * D;
#pragma unroll
                for (int bj = 0; bj < 2; ++bj)
#pragma unroll
                    for (int n = 0; n < 2; ++n) { const int c = u.pn * 256 + bj * 128 + wc * 32 + fq * 8 + n * 4;
                        const f32x4 xv = *(const f32x4*)(sp + c);
                        *(f32x4*)(X + (size_t)row * D + c) = xv * ALPHA + gv[bj][n] * acc[ai][bj][m][n]; }
            }
    }
};

struct EpiFour {
    float* FACC; int mode;
    DI void operator()(const f32x4 (&acc)[2][2][4][2], const Unit& u, int wr, int wc, int fr_in, int fq_in) const {
        int fr = fr_in, fq = fq_in; asm volatile("" : "+v"(fr), "+v"(fq));
        const int tok0 = ((mode == 0) ? TP + u.pn * 4096 + u.pm * 256 : u.pn * 256) + wr * 64 + fr;
        float* p0 = FACC + (size_t)tok0 * 256 + wc * 32 + fq * 8;
#pragma unroll
        for (int ai = 0; ai < 2; ++ai)
#pragma unroll
            for (int m = 0; m < 4; ++m) {
                float* p = p0 + (ai * 128 + m * 16) * 256;
                asm volatile("" : "+v"(p));
#pragma unroll
                for (int bj = 0; bj < 2; ++bj)
#pragma unroll
                    for (int n = 0; n < 2; ++n)
#pragma unroll
                        for (int j = 0; j < 4; ++j) unsafeAtomicAdd(p + bj * 128 + n * 4 + j, acc[ai][bj][m][n][j]);
                __builtin_amdgcn_sched_barrier(0);
            }
    }
};

struct EpiIn {
    int l; const float* g_qa; const float* g_ka; float* out; unsigned char* ws;
    DI void operator()(const f32x4 (&acc)[2][2][4][2], const Unit& u, int wr, int wc, int fr_in, int fq_in) const {
        int fr = fr_in, fq = fq_in; asm volatile("" : "+v"(fr), "+v"(fq));
        const int t = u.pn; const bool prompt = u.pm < 16;
        const float* rope = (const float*)(ws + WS_ROPE);
        bf16_t* const QA = (bf16_t*)(ws + WS_QA); bf16_t* const QB = (bf16_t*)(ws + WS_QB); bf16_t* const KAS = (bf16_t*)(ws + WS_KAS); bf16_t* const VAS = (bf16_t*)(ws + WS_VAS);
        bf16_t* const KBS = (bf16_t*)(ws + WS_KBS); bf16_t* const VBS = (bf16_t*)(ws + WS_VBS); bf16_t* const KAP = (bf16_t*)(ws + WS_KAP); bf16_t* const VAP = (bf16_t*)(ws + WS_VAP);
        bf16_t* const KBP = (bf16_t*)(ws + WS_KBP); bf16_t* const VBP = (bf16_t*)(ws + WS_VBP); bf16_t* const UTP = (bf16_t*)(ws + WS_UTP); bf16_t* const UTS = (bf16_t*)(ws + WS_UTS);
        if (t >= 8) {
            const int cs = t - 8;
#pragma unroll
            for (int ai = 0; ai < 2; ++ai)
#pragma unroll
                for (int m = 0; m < 4; ++m) {
                    const int row = u.pm * 256 + ai * 128 + wr * 64 + m * 16 + fr;
                    bf16_t* base; size_t pitch;
                    if (prompt) { base = UTP + (size_t)(row >> 8) * 256 * 512 + cs * 256 + (row & 255); pitch = 512; }
                    else { const int rs = row - TP; base = UTS + (size_t)(rs >> 12) * 256 * 8192 + cs * 4096 + (rs & 4095); pitch = 8192; }
#pragma unroll
                    for (int bj = 0; bj < 2; ++bj)
#pragma unroll
                        for (int n = 0; n < 2; ++n)
#pragma unroll
                            for (int j = 0; j < 4; ++j) base[(size_t)(bj * 128 + wc * 32 + fq * 8 + n * 4 + j) * pitch] = f2bf(acc[ai][bj][m][n][j]);
                    __builtin_amdgcn_sched_barrier(0);
                }
            return;
        }
        const bool do_norm = (t == 0) || (t == 1 && wc < 2);
        const bool is_v = (t == 1 && wc >= 2) || t >= 6;
        const bool is_q = (t == 0) || t == 2 || t == 3;
        const bool do_rope = !prompt && !is_v;
        const float* gp = (t == 0 ? g_qa : g_ka) + l * 64 + fq * 8;
#pragma unroll
        for (int ai = 0; ai < 2; ++ai)
#pragma unroll
            for (int m = 0; m < 4; ++m) {
                const int row = u.pm * 256 + ai * 128 + wr * 64 + m * 16 + fr;
                int b, pos;
                if (prompt) { b = row >> 8; pos = row & 255; } else { const int rs = row - TP; b = rs >> 12; pos = rs & 4095; }
                float v[2][8];
#pragma unroll
                for (int bj = 0; bj < 2; ++bj)
#pragma unroll
                    for (int n = 0; n < 2; ++n)
#pragma unroll
                        for (int j = 0; j < 4; ++j) v[bj][n * 4 + j] = acc[ai][bj][m][n][j];
                if (do_norm) {
                    float ss = 0.f;
#pragma unroll
                    for (int bj = 0; bj < 2; ++bj)
#pragma unroll
                        for (int e = 0; e < 8; ++e) ss += v[bj][e] * v[bj][e];
                    ss += __shfl_xor(ss, 16); ss += __shfl_xor(ss, 32);
                    const float rs_ = rsqrtf(ss * (1.f / 64.f) + 1e-6f);
#pragma unroll
                    for (int bj = 0; bj < 2; ++bj)
#pragma unroll
                        for (int e = 0; e < 8; ++e) v[bj][e] = v[bj][e] * rs_ * gp[bj * 32 + e];
                }
                if (prompt && !is_q) {
                    float* op;
                    if (t == 1) op = out + (wc < 2 ? 12582912 : 13631488) + ((size_t)((b * 2 + l) * 256 + pos)) * 128 + (wc & 1) * 64;
                    else if (t < 6) op = out + 14680064 + ((size_t)((b * 2 + l) * 256 + pos)) * 512 + ((t - 4) * 4 + wc) * 64;
                    else op = out + 18874368 + ((size_t)((b * 2 + l) * 256 + pos)) * 512 + (t - 6) * 256 + wc * 64;
#pragma unroll
                    for (int bj = 0; bj < 2; ++bj) {
                        *(f32x4*)(op + bj * 32 + fq * 8) = (f32x4){v[bj][0], v[bj][1], v[bj][2], v[bj][3]};
                        *(f32x4*)(op + bj * 32 + fq * 8 + 4) = (f32x4){v[bj][4], v[bj][5], v[bj][6], v[bj][7]};
                    }
                }
                if (do_rope) {
#pragma unroll
                    for (int bj = 0; bj < 2; ++bj) {
                        const int pv_ = bj == 0 ? (pos >> 6) : (pos & 63);
                        const float* rp = rope + (pv_ * 16 + (fq & 1) * 8) * 2;
#pragma unroll
                        for (int e = 0; e < 8; ++e) {
                            const float cc = rp[2 * e], sn = rp[2 * e + 1];
                            const float other = __shfl_xor(v[bj][e], 32);
                            v[bj][e] = v[bj][e] * cc + (fq < 2 ? -other : other) * sn;
                        }
                    }
                }
                if (is_v) {
                    bf16_t* base; size_t pitch;
                    if (t == 1) { const int kvh = wc - 2; if (prompt) { base = VAP + (size_t)(b * 2 + kvh) * 64 * 256 + pos; pitch = 256; } else { base = VAS + (size_t)(b * 2 + kvh) * 64 * LKS + 256 + pos; pitch = LKS; } }
                    else { const int hh = (t - 6) * 2 + (wc >> 1); const int d0 = (wc & 1) * 64;
                        if (prompt) { base = VBP + ((size_t)(b * 4 + hh) * 128 + d0) * 256 + pos; pitch = 256; } else { base = VBS + ((size_t)(b * 4 + hh) * 128 + d0) * LKS + 256 + pos; pitch = LKS; } }
#pragma unroll
                    for (int bj = 0; bj < 2; ++bj)
#pragma unroll
                        for (int e = 0; e < 8; ++e) base[(size_t)(bj * 32 + fq * 8 + e) * pitch] = f2bf(v[bj][e]);
                } else {
                    bf16_t* op;
                    if (t == 0) op = QA + (size_t)row * 256 + wc * 64;
                    else if (t == 1) op = prompt ? KAP + ((size_t)(b * 2 + wc) * 256 + pos) * 64 : KAS + ((size_t)(b * 2 + wc) * LKS + 256 + pos) * 64;
                    else if (t < 4) op = QB + (size_t)row * 512 + ((t - 2) * 4 + wc) * 64;
                    else { const int s = (t - 4) * 4 + wc; op = prompt ? KBP + ((size_t)(b * 8 + s) * 256 + pos) * 64 : KBS + ((size_t)(b * 8 + s) * LKS + 256 + pos) * 64; }
                    const float sc = is_q ? QSCALE : 1.f;
#pragma unroll
                    for (int bj = 0; bj < 2; ++bj) {
                        u32x4 w; w.x = pk2(v[bj][0] * sc, v[bj][1] * sc); w.y = pk2(v[bj][2] * sc, v[bj][3] * sc); w.z = pk2(v[bj][4] * sc, v[bj][5] * sc); w.w = pk2(v[bj][6] * sc, v[bj][7] * sc);
                        *(u32x4*)(op + bj * 32 + fq * 8) = w;
                    }
                }
                __builtin_amdgcn_sched_barrier(0);
            }
    }
};
}

template <int DV>
DI void attn_unit(const bf16_t* __restrict__ Q, int qpitch, const bf16_t* __restrict__ K, const bf16_t* __restrict__ VT, int Lk, bf16_t* __restrict__ O, int opitch, LAS unsigned char* lds) {
    constexpr int KROW = 144, VROW = 136, KBYTES = 64 * KROW, VBYTES = DV * VROW, BUF = KBYTES + VBYTES, NV = DV / 64, NDB = DV / 32;
    int tid = threadIdx.x; asm volatile("" : "+v"(tid));
    const int wave = tid >> 6, lane = tid & 63, r = lane & 31, h = lane >> 5;
    bf16x8 qf[4];
    { const bf16_t* qrow = Q + (size_t)(wave * 32 + r) * qpitch;
#pragma unroll
      for (int s = 0; s < 4; ++s) qf[s] = *(const bf16x8*)(qrow + 16 * s + 8 * h); }
    f32x16 o[NDB];
#pragma unroll
    for (int db = 0; db < NDB; ++db)
#pragma unroll
        for (int i = 0; i < 16; ++i) o[db][i] = 0.f;
    float mrun = -1e30f, lrun = 0.f;
    const int skey = tid >> 3, sch = tid & 7;
    const bf16_t* kg = K + (size_t)skey * 64 + sch * 8;
    const bf16_t* vg = VT + (size_t)skey * Lk + sch * 8;
    const unsigned kwoff = skey * KROW + sch * 16, vwoff = KBYTES + skey * VROW + sch * 16;
    u32x4 kreg, vreg[NV];
    kreg = *(const u32x4*)kg;
#pragma unroll
    for (int i = 0; i < NV; ++i) vreg[i] = *(const u32x4*)(vg + (size_t)(64 * i) * Lk);
    *(LAS u32x4*)(lds + kwoff) = kreg;
#pragma unroll
    for (int i = 0; i < NV; ++i) { *(LAS u32x2*)(lds + vwoff + i * 64 * VROW) = (u32x2){vreg[i].x, vreg[i].y}; *(LAS u32x2*)(lds + vwoff + i * 64 * VROW + 8) = (u32x2){vreg[i].z, vreg[i].w}; }
    __syncthreads();
    const int nt = Lk >> 6;
    for (int kt = 0; kt < nt; ++kt) {
        LAS unsigned char* cb = lds + (kt & 1) * BUF;
        LAS unsigned char* nb = lds + ((kt & 1) ^ 1) * BUF;
        const bool more = kt + 1 < nt;
        if (more) {
            kreg = *(const u32x4*)(kg + (size_t)(kt + 1) * 64 * 64);
#pragma unroll
            for (int i = 0; i < NV; ++i) vreg[i] = *(const u32x4*)(vg + (size_t)(64 * i) * Lk + (kt + 1) * 64);
        }
        f32x16 s0, s1;
#pragma unroll
        for (int i = 0; i < 16; ++i) { s0[i] = 0.f; s1[i] = 0.f; }
#pragma unroll
        for (int s = 0; s < 4; ++s) {
            const bf16x8 k0 = *(const LAS bf16x8*)(cb + r * KROW + (16 * s + 8 * h) * 2);
            const bf16x8 k1 = *(const LAS bf16x8*)(cb + (32 + r) * KROW + (16 * s + 8 * h) * 2);
            s0 = __builtin_amdgcn_mfma_f32_32x32x16_bf16(k0, qf[s], s0, 0, 0, 0);
            s1 = __builtin_amdgcn_mfma_f32_32x32x16_bf16(k1, qf[s], s1, 0, 0, 0);
        }
        __builtin_amdgcn_sched_barrier(0);
        float mx = s0[0];
#pragma unroll
        for (int i = 1; i < 16; ++i) mx = fmaxf(mx, s0[i]);
#pragma unroll
        for (int i = 0; i < 16; ++i) mx = fmaxf(mx, s1[i]);
        mx = fmaxf(mx, __shfl_xor(mx, 32));
        const float mnew = fmaxf(mrun, mx);
        const float alpha = __builtin_amdgcn_exp2f(mrun - mnew);
        mrun = mnew;
        float rs = 0.f;
#pragma unroll
        for (int i = 0; i < 16; ++i) { s0[i] = __builtin_amdgcn_exp2f(s0[i] - mnew); s1[i] = __builtin_amdgcn_exp2f(s1[i] - mnew); rs += s0[i] + s1[i]; }
        lrun = lrun * alpha + rs;
#pragma unroll
        for (int db = 0; db < NDB; ++db)
#pragma unroll
            for (int i = 0; i < 16; ++i) o[db][i] *= alpha;
#pragma unroll
        for (int kb = 0; kb < 2; ++kb)
#pragma unroll
            for (int s2 = 0; s2 < 2; ++s2) {
                u32x4 pw;
                if (kb == 0) { pw.x = pk2(s0[8 * s2 + 0], s0[8 * s2 + 1]); pw.y = pk2(s0[8 * s2 + 2], s0[8 * s2 + 3]); pw.z = pk2(s0[8 * s2 + 4], s0[8 * s2 + 5]); pw.w = pk2(s0[8 * s2 + 6], s0[8 * s2 + 7]); }
                else { pw.x = pk2(s1[8 * s2 + 0], s1[8 * s2 + 1]); pw.y = pk2(s1[8 * s2 + 2], s1[8 * s2 + 3]); pw.z = pk2(s1[8 * s2 + 4], s1[8 * s2 + 5]); pw.w = pk2(s1[8 * s2 + 6], s1[8 * s2 + 7]); }
                const bf16x8 pf = __builtin_bit_cast(bf16x8, pw);
#pragma unroll
                for (int db = 0; db < NDB; ++db) {
                    const LAS unsigned char* vp = cb + KBYTES + (32 * db + r) * VROW + (32 * kb + 16 * s2 + 4 * h) * 2;
                    const u32x2 lo = *(const LAS u32x2*)vp, hi = *(const LAS u32x2*)(vp + 16);
                    const u32x4 vw = {lo.x, lo.y, hi.x, hi.y};
                    o[db] = __builtin_amdgcn_mfma_f32_32x32x16_bf16(__builtin_bit_cast(bf16x8, vw), pf, o[db], 0, 0, 0);
                }
                __builtin_amdgcn_sched_barrier(0);
            }
        if (more) {
            *(LAS u32x4*)(nb + kwoff) = kreg;
#pragma unroll
            for (int i = 0; i < NV; ++i) { *(LAS u32x2*)(nb + vwoff + i * 64 * VROW) = (u32x2){vreg[i].x, vreg[i].y}; *(LAS u32x2*)(nb + vwoff + i * 64 * VROW + 8) = (u32x2){vreg[i].z, vreg[i].w}; }
        }
        __syncthreads();
    }
    lrun += __shfl_xor(lrun, 32);
    const float inv = 1.f / lrun;
    bf16_t* orow = O + (size_t)(wave * 32 + r) * opitch;
#pragma unroll
    for (int db = 0; db < NDB; ++db)
#pragma unroll
        for (int g = 0; g < 4; ++g) {
            u32x2 w; w.x = pk2(o[db][4 * g] * inv, o[db][4 * g + 1] * inv); w.y = pk2(o[db][4 * g + 2] * inv, o[db][4 * g + 3] * inv);
            *(u32x2*)(orow + 32 * db + 8 * g + 4 * h) = w;
        }
}

template <int MODE> DI int srccol(int np) {
    if (MODE == 1) { const int pn = np >> 8, j = np & 255; return j < 128 ? 128 * pn + j : FF + 128 * pn + (j - 128); }
    if (MODE == 2) { const int t = np >> 8, p = np & 255; return 256 * t + 64 * ((p >> 5) & 3) + 32 * (p >> 7) + (p & 31); }
    return np;
}
template <int MODE> DI void tr_section(const float* __restrict__ src, int Nsrc, int Kr, int Nd, bf16_t* __restrict__ dst, int ldd, LAS float* tile) {
    const int tid = otid(), nkt = Kr >> 6, total = nkt * (Nd >> 6);
    for (int it = blockIdx.x; it < total; it += gridDim.x) {
        const int n0 = (it / nkt) * 64, k0 = (it % nkt) * 64;
        const int nn = tid & 63, kq = tid >> 6, sc = srccol<MODE>(n0 + nn);
#pragma unroll
        for (int i = 0; i < 8; ++i) { const int kk = kq + 8 * i; tile[kk * 65 + nn] = src[(size_t)(k0 + kk) * Nsrc + sc]; }
        __syncthreads();
        const int n2 = tid >> 3, kc = tid & 7;
        u32x4 w;
        w.x = pk2(tile[(8 * kc + 0) * 65 + n2], tile[(8 * kc + 1) * 65 + n2]); w.y = pk2(tile[(8 * kc + 2) * 65 + n2], tile[(8 * kc + 3) * 65 + n2]);
        w.z = pk2(tile[(8 * kc + 4) * 65 + n2], tile[(8 * kc + 5) * 65 + n2]); w.w = pk2(tile[(8 * kc + 6) * 65 + n2], tile[(8 * kc + 7) * 65 + n2]);
        *(u32x4*)(dst + (size_t)(n0 + n2) * ldd + k0 + 8 * kc) = w;
        __syncthreads();
    }
}

DI void convert_layer(const KArgs& a, int l, LAS unsigned char* lds) {
    unsigned char* ws = a.ws; const int tid = otid(), G = gridDim.x;
    LAS float* tile = (LAS float*)(lds + 32768);
    LAS float* t64 = (LAS float*)(lds + 65536);
    if (tid < 64) t64[tid] = cospif((float)tid * (1.f / 32.f));
    __syncthreads();
    tr_section<1>(a.in[20] + (size_t)l * D * 2 * FF, 2 * FF, D, 2 * FF, (bf16_t*)(ws + WS_WGU1), D, tile);
    tr_section<0>(a.in[21] + (size_t)l * FF * D, D, FF, D, (bf16_t*)(ws + WS_WD1), FF, tile);
    tr_section<2>(a.in[10] + (size_t)l * D * 2304, 2304, D, 2048, (bf16_t*)(ws + WS_WIN), D, tile);
    tr_section<0>(a.in[19] + (size_t)l * D * D, D, 768, D, (bf16_t*)(ws + WS_WOUT), D, tile);
    tr_section<1>(a.in[22] + (size_t)l * D * 2 * FF, 2 * FF, D, 2 * FF, (bf16_t*)(ws + WS_WGU2), D, tile);
    tr_section<0>(a.in[23] + (size_t)l * FF * D, D, FF, D, (bf16_t*)(ws + WS_WD2), FF, tile);
    { bf16_t* WinT = (bf16_t*)(ws + WS_WIN);
      for (int it = blockIdx.x; it < 1024; it += G) {
          const int rowi = it >> 1, kdim = (it & 1) * 512 + tid, cs = rowi >> 8, g = (rowi >> 6) & 3, k = rowi & 63;
          const float* wp = a.in[10] + ((size_t)l * D + kdim) * 2304 + 2048 + g * 64;
          float s = 0.f;
#pragma unroll 4
          for (int c4 = 0; c4 < 16; ++c4) { const f32x4 wv = *(const f32x4*)(wp + 4 * c4);
#pragma unroll
              for (int e = 0; e < 4; ++e) { const int idx = (k * (4 * c4 + e)) & 63; s += wv[e] * (cs ? t64[(idx - 16) & 63] : t64[idx]); } }
          WinT[(size_t)(2048 + rowi) * D + kdim] = f2bf(s);
      } }
    { bf16_t* WoutT = (bf16_t*)(ws + WS_WOUT);
      for (int it = blockIdx.x; it < 512; it += G) {
          const int i = it >> 1, n = (it & 1) * 512 + tid;
          const float* wf = a.in[18] + ((size_t)l * 256 + i) * 256;
          const float* wo = a.in[19] + ((size_t)l * D + 768) * D + n;
          float s = 0.f;
#pragma unroll 8
          for (int j = 0; j < 256; ++j) s += wf[j] * wo[(size_t)j * D];
          WoutT[(size_t)n * D + 768 + i] = f2bf(s);
      } }
    { bf16_t* KAS = (bf16_t*)(ws + WS_KAS); bf16_t* VAS = (bf16_t*)(ws + WS_VAS); bf16_t* KBS = (bf16_t*)(ws + WS_KBS); bf16_t* VBS = (bf16_t*)(ws + WS_VBS);
      for (int i = blockIdx.x * 512 + tid; i < 2 * 256 * 1280; i += G * 512) {
          const int e = i % 1280, bp = i / 1280, b = bp >> 8, pos = bp & 255;
          const size_t cbase = (size_t)((b * 2 + l) * 256 + pos);
          if (e < 128) { const int kvh = e >> 6, d = e & 63; KAS[((size_t)(b * 2 + kvh) * LKS + pos) * 64 + d] = f2bf(a.in[2][cbase * 128 + e]); }
          else if (e < 256) { const int e2 = e - 128, kvh = e2 >> 6, d = e2 & 63; VAS[((size_t)(b * 2 + kvh) * 64 + d) * LKS + pos] = f2bf(a.in[3][cbase * 128 + e2]); }
          else if (e < 768) { const int e2 = e - 256, s = e2 >> 6, d = e2 & 63; KBS[((size_t)(b * 8 + s) * LKS + pos) * 64 + d] = f2bf(a.in[4][cbase * 512 + e2]); }
          else { const int e2 = e - 768, hh = e2 >> 7, d = e2 & 127; VBS[((size_t)(b * 4 + hh) * 128 + d) * LKS + pos] = f2bf(a.in[5][cbase * 512 + e2]); }
      } }
    __syncthreads();
}

DI void p0_prologue(const KArgs& a, LAS unsigned char* lds) {
    unsigned char* ws = a.ws; const int tid = otid(), G = gridDim.x;
    { LAS float* sv = (LAS float*)lds; LAS float* red = (LAS float*)(lds + 16384);
      for (int i = tid; i < 3072; i += 512) { const int m = i >> 10, k = i & 1023; const float cv = (m == 0) ? a.in[7][k] : a.in[6][(m - 1) * D + k]; sv[i] = cv / (1.f + __expf(-cv)); }
      __syncthreads();
      float* MOD = (float*)(ws + WS_MOD);
      for (int it = blockIdx.x; it < 288; it += G) {
          const int l = it / 144, c0 = (it % 144) * 64, kg = tid >> 6, cc = tid & 63;
          const float* w = a.in[8] + (size_t)l * D * 9216 + c0 + cc;
          float a0 = 0.f, a1 = 0.f, a2 = 0.f;
#pragma unroll 8
          for (int k = kg; k < D; k += 8) { const float wv = w[(size_t)k * 9216]; a0 += sv[k] * wv; a1 += sv[1024 + k] * wv; a2 += sv[2048 + k] * wv; }
          red[(kg * 3 + 0) * 64 + cc] = a0; red[(kg * 3 + 1) * 64 + cc] = a1; red[(kg * 3 + 2) * 64 + cc] = a2;
          __syncthreads();
          if (tid < 192) { const int m = tid >> 6, c2 = tid & 63; float s = 0.f;
#pragma unroll
              for (int q = 0; q < 8; ++q) s += red[(q * 3 + m) * 64 + c2];
              MOD[(size_t)(l * 3 + m) * 9216 + c0 + c2] = s + a.in[9][l * 9216 + c0 + c2]; }
          __syncthreads();
      } }
    if (blockIdx.x == G - 1) {
        float* ROPE = (float*)(ws + WS_ROPE);
        for (int i = tid; i < 1024; i += 512) { const int pos = i >> 4, f = i & 15;
            const float inv = exp2f(-(float)f * (13.2877123795f / 16.f)); float rev = (float)pos * inv * 0.15915494309f; rev -= floorf(rev);
            ROPE[2 * i] = cospif(2.f * rev); ROPE[2 * i + 1] = sinpif(2.f * rev); }
    }
    { LAS float* tab = (LAS float*)lds;
      __syncthreads();
      for (int i = tid; i < 4096; i += 512) tab[i] = cospif((float)i * (1.f / 2048.f));
      __syncthreads();
      bf16_t* DS = (bf16_t*)(ws + WS_DFTS);
      for (int p = blockIdx.x; p < 4096; p += G)
          for (int ch = tid; ch < 1024; ch += 512) {
              const int k0 = ch * 8, n0 = k0 & 4095; const bool sp = k0 >= 4096; float v[8];
#pragma unroll
              for (int e = 0; e < 8; ++e) { const int idx = (p * (n0 + e)) & 4095; v[e] = (sp ? -tab[(idx - 1024) & 4095] : tab[idx]) * (1.f / 512.f); }
              u32x4 w; w.x = pk2(v[0], v[1]); w.y = pk2(v[2], v[3]); w.z = pk2(v[4], v[5]); w.w = pk2(v[6], v[7]);
              *(u32x4*)(DS + (size_t)p * 8192 + k0) = w;
          }
      bf16_t* DP = (bf16_t*)(ws + WS_DFTP);
      for (int p = blockIdx.x; p < 256; p += G)
          if (tid < 64) {
              const int k0 = tid * 8, n0 = k0 & 255; const bool sp = k0 >= 256; float v[8];
#pragma unroll
              for (int e = 0; e < 8; ++e) { const int idx = ((p * (n0 + e)) & 255) * 16; v[e] = (sp ? -tab[(idx - 1024) & 4095] : tab[idx]) * (1.f / 128.f); }
              u32x4 w; w.x = pk2(v[0], v[1]); w.y = pk2(v[2], v[3]); w.z = pk2(v[4], v[5]); w.w = pk2(v[6], v[7]);
              *(u32x4*)(DP + (size_t)p * 512 + k0) = w;
          }
      __syncthreads(); }
    convert_layer(a, 0, lds);
}

DI void p_modulate0(const KArgs& a) {
    const float* MOD = (const float*)(a.ws + WS_MOD); bf16_t* H = (bf16_t*)(a.ws + WS_H);
    for (int i = blockIdx.x * 512 + otid(); i < T * 128; i += gridDim.x * 512) {
        const int row = i >> 7, c0 = (i & 127) * 8;
        const float* sp = (row < TP) ? a.in[0] + (size_t)row * D : a.in[1] + (size_t)(row - TP) * D;
        const float* md = MOD + (size_t)(row < TP ? 0 : 1 + ((row - TP) >> 12)) * 9216;
        float v[8];
#pragma unroll
        for (int q = 0; q < 2; ++q) { const f32x4 x = *(const f32x4*)(sp + c0 + 4 * q), sh = *(const f32x4*)(md + c0 + 4 * q), sc = *(const f32x4*)(md + 1024 + c0 + 4 * q);
#pragma unroll
            for (int e = 0; e < 4; ++e) v[4 * q + e] = x[e] * (1.f + sc[e]) + sh[e]; }
        u32x4 w; w.x = pk2(v[0], v[1]); w.y = pk2(v[2], v[3]); w.z = pk2(v[4], v[5]); w.w = pk2(v[6], v[7]);
        *(u32x4*)(H + (size_t)row * D + c0) = w;
    }
}

DI void p_layernorm(const float* X, float* xo, bf16_t* H, const float* g, const float* bta, const float* modn  ) {
    const int tid = otid(), wave = tid >> 6, lane = tid & 63;
    for (int row = blockIdx.x * 8 + wave; row < T; row += gridDim.x * 8) {
        f32x4 v[4];
#pragma unroll
        for (int i = 0; i < 4; ++i) v[i] = *(const f32x4*)(X + (size_t)row * D + i * 256 + lane * 4);
        float s = 0.f;
#pragma unroll
        for (int i = 0; i < 4; ++i) s += (v[i][0] + v[i][1]) + (v[i][2] + v[i][3]);
        const float mean = wave_sum(s) * (1.f / 1024.f);
        float q = 0.f;
#pragma unroll
        for (int i = 0; i < 4; ++i) { v[i] = v[i] - mean; q += (v[i][0] * v[i][0] + v[i][1] * v[i][1]) + (v[i][2] * v[i][2] + v[i][3] * v[i][3]); }
        const float rstd = rsqrtf(wave_sum(q) * (1.f / 1024.f) + 1e-5f);
        const float* md = modn ? modn + (size_t)(row < TP ? 0 : 1 + ((row - TP) >> 12)) * 9216 : nullptr;
#pragma unroll
        for (int i = 0; i < 4; ++i) {
            const int c = i * 256 + lane * 4;
            const f32x4 y = v[i] * rstd * *(const f32x4*)(g + c) + *(const f32x4*)(bta + c);
            *(f32x4*)(xo + (size_t)row * D + c) = y;
            if (md) { const f32x4 sh = *(const f32x4*)(md + c), sc = *(const f32x4*)(md + 1024 + c);
                u32x2 w; w.x = pk2(y[0] * (1.f + sc[0]) + sh[0], y[1] * (1.f + sc[1]) + sh[1]); w.y = pk2(y[2] * (1.f + sc[2]) + sh[2], y[3] * (1.f + sc[3]) + sh[3]);
                *(u32x2*)(H + (size_t)row * D + c) = w; }
        }
    }
}

DI void p_combine(const KArgs& a, int l) {
    const int tid = otid(), wave = tid >> 6, lane = tid & 63;
    const bf16_t* OBT = (const bf16_t*)(a.ws + WS_H); bf16_t* MIX = (bf16_t*)(a.ws + WS_MIX); const float* FACC = (const float*)(a.ws + WS_FACC);
    const float lam_init = (l == 0) ? 0.2f : (0.8f - 0.6f * 0.74081822068f);
    const float d1 = wave_sum(a.in[13][l * 64 + lane] * a.in[14][l * 64 + lane]), d2 = wave_sum(a.in[15][l * 64 + lane] * a.in[16][l * 64 + lane]);
    const float lam = expf(d1) - expf(d2) + lam_init;
    const float g0 = a.in[17][l * 128 + 2 * lane] * (1.f - lam_init), g1 = a.in[17][l * 128 + 2 * lane + 1] * (1.f - lam_init);
    for (int row = blockIdx.x * 8 + wave; row < T; row += gridDim.x * 8) {
#pragma unroll
        for (int hb = 0; hb < 4; ++hb) {
            const unsigned w1 = *(const unsigned*)(OBT + (size_t)row * D + hb * 256 + 2 * lane), w2 = *(const unsigned*)(OBT + (size_t)row * D + hb * 256 + 128 + 2 * lane);
            const float x0 = __uint_as_float(w1 << 16) - lam * __uint_as_float(w2 << 16), x1 = __uint_as_float(w1 & 0xffff0000u) - lam * __uint_as_float(w2 & 0xffff0000u);
            const float rs = rsqrtf(wave_sum(x0 * x0 + x1 * x1) * (1.f / 128.f) + 1e-6f);
            *(unsigned*)(MIX + (size_t)row * D + 256 + hb * 128 + 2 * lane) = pk2(x0 * rs * g0, x1 * rs * g1);
        }
        const f32x4 f = *(const f32x4*)(FACC + (size_t)row * 256 + lane * 4);
        u32x2 w; w.x = pk2(f[0], f[1]); w.y = pk2(f[2], f[3]);
        *(u32x2*)(MIX + (size_t)row * D + 768 + lane * 4) = w;
    }
}


#define XB_TMO      128
#define XB_XCNT(j)  (256  + 64 * (j))
#define XB_XSUB(j)  (1280 + 64 * (j))
#define XB_XGEN(j)  (2304 + 64 * (j))
#define XB_TOP      3328
#define XB_TOPGEN   3392
#define XCD_BAR_WORDS 3456
#define XB_SPIN_CAP (1u << 18)
DI unsigned xb_ld(unsigned* p)              { return __hip_atomic_load(p, __ATOMIC_RELAXED, __HIP_MEMORY_SCOPE_AGENT); }
DI unsigned xb_add(unsigned* p, unsigned v) { return __hip_atomic_fetch_add(p, v, __ATOMIC_RELAXED, __HIP_MEMORY_SCOPE_AGENT); }
DI unsigned xb_xcc_id() { return (unsigned)__builtin_amdgcn_s_getreg((3 << 11) | 20) & 0xFu; }
#define XB_SPIN(cond, bar) do { unsigned _sp = 0; while (cond) { __builtin_amdgcn_s_sleep(1); \
    if ((++_sp & 255u) == 0u) { if (xb_ld(&(bar)[XB_TMO])) break; if (_sp > XB_SPIN_CAP) { atomicAdd(&(bar)[XB_TMO], 1u); break; } } } } while (0)
struct XcdBarrier { unsigned* bar; unsigned x; volatile LAS unsigned* st; };
DI XcdBarrier xcd_barrier_post(unsigned* bar, volatile LAS unsigned* st) {
    XcdBarrier b; b.bar = bar; b.x = xb_xcc_id(); b.st = st;
    if (threadIdx.x == 0) (void)xb_add(&bar[XB_XCNT(b.x)], 1u);
    return b;
}
DI void xcd_barrier_complete(unsigned* bar, unsigned x, unsigned& nloc, unsigned& nx) {
    const unsigned G = gridDim.x * gridDim.y * gridDim.z;
    unsigned sum, cnt, mine, sp = 0u;
    for (;;) {
        sum = 0u; cnt = 0u; mine = 0u;
#pragma unroll
        for (unsigned j = 0; j < 16; ++j) { const unsigned c = xb_ld(&bar[XB_XCNT(j)]); sum += c; cnt += (c > 0u) ? 1u : 0u; mine = (j == x) ? c : mine; }
        if (sum == G) break;
        __builtin_amdgcn_s_sleep(1);
        if ((++sp & 255u) == 0u) { if (xb_ld(&bar[XB_TMO])) break; if (sp > XB_SPIN_CAP) { atomicAdd(&bar[XB_TMO], 1u); break; } }
    }
    nloc = mine > 0u ? mine : 1u; nx = cnt > 0u ? cnt : 1u;
}
DI void xcd_barrier(const XcdBarrier& b) {
    asm volatile("s_waitcnt vmcnt(0)" ::: "memory");
    __syncthreads();
    if (threadIdx.x == 0) {
        unsigned* bar = b.bar;
        __builtin_amdgcn_s_waitcnt(0);
        unsigned nloc = b.st[0], nx = b.st[1];
        if (nloc == 0u) { xcd_barrier_complete(bar, b.x, nloc, nx); b.st[0] = nloc; b.st[1] = nx; }
        const unsigned old = xb_add(&bar[XB_XSUB(b.x)], 1u);
        const unsigned gen = old / nloc;
        if (old + 1u == (gen + 1u) * nloc) {
            __builtin_amdgcn_fence(__ATOMIC_RELEASE, "agent");
            asm volatile("s_waitcnt vmcnt(0)" ::: "memory");
            const unsigned og = xb_add(&bar[XB_TOP], 1u);
            const unsigned tg = og / nx;
            if (og + 1u == (tg + 1u) * nx) xb_add(&bar[XB_TOPGEN], 1u);
            else XB_SPIN(xb_ld(&bar[XB_TOPGEN]) == tg, bar);
            __builtin_amdgcn_fence(__ATOMIC_ACQUIRE, "agent");
            xb_add(&bar[XB_XGEN(b.x)], 1u);
            asm volatile("s_waitcnt vmcnt(0)" ::: "memory");
        } else {
            XB_SPIN(xb_ld(&bar[XB_XGEN(b.x)]) == gen, bar);
            __builtin_amdgcn_fence(__ATOMIC_ACQUIRE, "agent");
            asm volatile("s_waitcnt vmcnt(0)" ::: "memory");
        }
    }
    __syncthreads();
}

#ifndef PROBE_MASK
#define PROBE_MASK 0
#endif
constexpr int N_PHASES = 24;
#define PHM(i) ((MASK >> (i)) & 1)
template <int MASK> __global__ void __launch_bounds__(512) trunk_fwd(KArgs a) {
    extern __shared__ __attribute__((aligned(16))) unsigned char lds_raw[];
    LAS unsigned char* lds = (LAS unsigned char*)lds_raw;
    cg::grid_group grid = cg::this_grid();
    unsigned char* ws = a.ws;
    const int G = gridDim.x, c = blockIdx.x;
    float* X = (float*)(ws + WS_X); bf16_t* H = (bf16_t*)(ws + WS_H); bf16_t* ACT = (bf16_t*)(ws + WS_ACT); bf16_t* MIX = (bf16_t*)(ws + WS_MIX);
    const float* MOD = (const float*)(ws + WS_MOD);
    volatile LAS unsigned* misc = (volatile LAS unsigned*)(lds + MISC_OFF);
    if (threadIdx.x < 16) misc[threadIdx.x] = 0u;
    __syncthreads();
    XcdBarrier xbar = xcd_barrier_post((unsigned*)(ws + WS_CTL) + 64, misc + 8);
    for (int ph = a.ph_lo; ph < a.ph_hi; ++ph) {
        const int tid = otid();
        int kbit; if (ph < 2) kbit = ph; else { const int k_ = (ph - 2) % 11; kbit = (k_ == 0 || k_ == 8) ? 2 : (k_ == 1 || k_ == 9 || k_ == 6) ? 3 : (k_ == 2 || k_ == 7 || k_ == 10) ? 4 : (k_ == 3) ? 5 : (k_ == 4) ? 7 : 8; }
        const int nrep = ((PROBE_MASK >> kbit) & 1) ? 2 : 1;
#pragma clang loop unroll(disable)
        for (int rep = 0; rep < nrep; ++rep) {
        if (ph == 0) { if (PHM(0)) p0_prologue(a, lds); }
        else if (ph == 1) { if (PHM(1)) p_modulate0(a); }
        else {
            const int l = (ph - 2) / 11, k = (ph - 2) % 11;
            const float* modl = MOD + (size_t)l * 3 * 9216;
            if (k == 0 || k == 8) { if (PHM(2)) {
                pg8::Gemm g{H, (const bf16_t*)(ws + (k == 0 ? WS_WGU1 : WS_WGU2)), D, D}; pg8::StaticOrder S; S.init(T, 2 * FF, G, c);
                pg8::EpiGU E{ACT};
                pg8::gemm_phase<pg8::EpiGU, pg8::StaticOrder, true, true>(lds, g, S, E); }
            } else if (k == 1 || k == 9 || k == 6) { if (PHM(3)) {
                pg8::Gemm g; pg8::EpiRes E;
                if (k == 6) { g = pg8::Gemm{MIX, (const bf16_t*)(ws + WS_WOUT), D, D}; E = pg8::EpiRes{X, X + (size_t)TP * D, X, modl + 5 * 1024, 1.0f}; }
                else { g = pg8::Gemm{ACT, (const bf16_t*)(ws + (k == 1 ? WS_WD1 : WS_WD2)), FF, FF};
                    const bool first = (l == 0 && k == 1);
                    E = pg8::EpiRes{first ? a.in[0] : X, first ? a.in[1] : X + (size_t)TP * D, X, modl + (k == 1 ? 2 : 8) * 1024, 0.5f}; }
                pg8::StaticOrder S; S.init(T, D, G, c);
                pg8::gemm_phase<pg8::EpiRes, pg8::StaticOrder, true, true>(lds, g, S, E); }
            } else if (k == 2 || k == 7 || k == 10) { if (PHM(4)) {
                const int which = (k == 2) ? 0 : (k == 7 ? 1 : 2);
                const float* lg = a.in[24] + (size_t)(l * 3 + which) * D; const float* lb = a.in[25] + (size_t)(l * 3 + which) * D;
                const bool final_ = (l == 1 && k == 10);
                const float* modn = (k == 2) ? modl + 3 * 1024 : (k == 7) ? modl + 6 * 1024 : (final_ ? nullptr : MOD + (size_t)(l + 1) * 3 * 9216);
                p_layernorm(X, final_ ? a.out : X, H, lg, lb, modn);
                if (k == 2) {
                    f32x4* F4 = (f32x4*)(ws + WS_FACC);
                    for (int i = c * 512 + tid; i < T * 64; i += G * 512) F4[i] = (f32x4){0.f, 0.f, 0.f, 0.f};
                }
                if (k == 10 && l == 0) convert_layer(a, 1, lds); }
            } else if (k == 3) { if (PHM(5)) {
                pg8::Gemm g{H, (const bf16_t*)(ws + WS_WIN), D, D}; pg8::StaticOrder S; S.init(T, NIN, G, c);
                pg8::EpiIn E{l, a.in[11], a.in[12], a.out, ws};
                pg8::gemm_phase<pg8::EpiIn, pg8::StaticOrder, true, true>(lds, g, S, E); }
            } else if (k == 4) {
                if (PHM(6) && rep == 0) {
#pragma clang loop unroll(disable)
                    for (int pass = 0; pass < 2; ++pass) {
                        const bool sp = pass == 0;
                        pg8::Gemm g{(const bf16_t*)(ws + (sp ? WS_DFTS : WS_DFTP)), (const bf16_t*)(ws + (sp ? WS_UTS : WS_UTP)), sp ? 8192 : 512, sp ? 1024 : 512};
                        pg8::FourOrder S{G, c, sp ? 256 : 16, pass}; pg8::EpiFour E{(float*)(ws + WS_FACC), pass};
                        pg8::gemm_phase<pg8::EpiFour, pg8::FourOrder, true, true>(lds, g, S, E);
                    }
                }
                volatile LAS int* qslot = (volatile LAS int*)(lds + MISC_OFF);
                unsigned* ctr = (unsigned*)(ws + WS_CTL) + l + 2 * rep;
                const bf16_t* QA = (const bf16_t*)(ws + WS_QA); const bf16_t* QB = (const bf16_t*)(ws + WS_QB);
                bf16_t* OBT = (bf16_t*)(ws + WS_H);
                if (PHM(7)) for (;;) {
                    __syncthreads();
                    if (tid == 0) *qslot = (int)atomicAdd(ctr, 1u);
                    __syncthreads();
                    const int idx = *qslot;
                    if (idx >= 576) break;
                    const bf16_t *Qp, *Kp, *Vp; bf16_t* Op; int qpitch, Lk; bool wide;
                    if (idx < 256) { const int b = idx >> 7, s = (idx >> 4) & 7, qb = idx & 15; const size_t tok0 = TP + b * 4096 + qb * 256; wide = true; qpitch = 512; Lk = LKS;
                        Qp = QB + tok0 * 512 + s * 64; Kp = (const bf16_t*)(ws + WS_KBS) + (size_t)(b * 8 + s) * LKS * 64; Vp = (const bf16_t*)(ws + WS_VBS) + (size_t)(b * 4 + (s >> 1)) * 128 * LKS; Op = OBT + tok0 * D + s * 128; }
                    else if (idx < 384) { const int i = idx - 256, b = i >> 6, hq = (i >> 4) & 3, qb = i & 15; const size_t tok0 = TP + b * 4096 + qb * 256; wide = false; qpitch = 256; Lk = LKS;
                        Qp = QA + tok0 * 256 + hq * 64; Kp = (const bf16_t*)(ws + WS_KAS) + (size_t)(b * 2 + (hq >> 1)) * LKS * 64; Vp = (const bf16_t*)(ws + WS_VAS) + (size_t)(b * 2 + (hq >> 1)) * 64 * LKS; Op = MIX + tok0 * D + hq * 64; }
                    else if (idx < 512) { const int i = idx - 384, b = i >> 3, s = i & 7; const size_t tok0 = b * 256; wide = true; qpitch = 512; Lk = 256;
                        Qp = QB + tok0 * 512 + s * 64; Kp = (const bf16_t*)(ws + WS_KBP) + (size_t)(b * 8 + s) * 256 * 64; Vp = (const bf16_t*)(ws + WS_VBP) + (size_t)(b * 4 + (s >> 1)) * 128 * 256; Op = OBT + tok0 * D + s * 128; }
                    else { const int i = idx - 512, b = i >> 2, hq = i & 3; const size_t tok0 = b * 256; wide = false; qpitch = 256; Lk = 256;
                        Qp = QA + tok0 * 256 + hq * 64; Kp = (const bf16_t*)(ws + WS_KAP) + (size_t)(b * 2 + (hq >> 1)) * 256 * 64; Vp = (const bf16_t*)(ws + WS_VAP) + (size_t)(b * 2 + (hq >> 1)) * 64 * 256; Op = MIX + tok0 * D + hq * 64; }
                    if (wide) attn_unit<128>(Qp, qpitch, Kp, Vp, Lk, Op, D, lds); else attn_unit<64>(Qp, qpitch, Kp, Vp, Lk, Op, D, lds);
                }
            } else if (k == 5) {
                if (PHM(8)) p_combine(a, l);
            }
        }
        if (rep + 1 < nrep) xcd_barrier(xbar);
        }
        if (ph + 1 < a.ph_hi) { if (ph == 0) grid.sync(); else xcd_barrier(xbar); }
    }
}

typedef void (*kern_t)(KArgs);
extern "C" void kernel_launch(void* const* d_in, const int* in_sizes, int n_in, void* d_out, int out_size, void* d_ws, size_t ws_size, hipStream_t stream) {
    static int grid = 0;
#if MK_PER_PHASE
    static const kern_t kerns[8] = {trunk_fwd<0x1>, trunk_fwd<0x2>, trunk_fwd<0x4>, trunk_fwd<0x8>, trunk_fwd<0x10>, trunk_fwd<0x20>, trunk_fwd<0xC0>, trunk_fwd<0x100>};
    constexpr int NK = 8;
#else
    static const kern_t kerns[1] = {trunk_fwd<0x1ff>};
    constexpr int NK = 1;
#endif
    if (grid == 0) {
        if (n_in != 26 || ws_size < WS_END) { fprintf(stderr, "kernel_launch: need 26 inputs and %zu bytes of workspace; got %d, %zu\n", (size_t)WS_END, n_in, ws_size); grid = -1; return; }
        int dev = 0, cus = 0, per_cu = 0;
        if (hipGetDevice(&dev) != hipSuccess || hipDeviceGetAttribute(&cus, hipDeviceAttributeMultiprocessorCount, dev) != hipSuccess) { grid = -1; return; }
        for (int i = 0; i < NK; ++i) {
            if (hipFuncSetAttribute((const void*)kerns[i], hipFuncAttributeMaxDynamicSharedMemorySize, LDS_BYTES) != hipSuccess) { fprintf(stderr, "kernel_launch: hipFuncSetAttribute failed\n"); grid = -1; return; }
            if (hipOccupancyMaxActiveBlocksPerMultiprocessor(&per_cu, (const void*)kerns[i], 512, LDS_BYTES) != hipSuccess || per_cu < 1) { fprintf(stderr, "kernel_launch: occupancy query says %d\n", per_cu); (void)hipGetLastError(); grid = -1; return; }
        }
        grid = cus * 1;
    }
    if (grid < 0) return;
    if (hipMemsetAsync((char*)d_ws + WS_CTL, 0, 16384, stream) != hipSuccess) { fprintf(stderr, "kernel_launch: memset failed\n"); return; }
    KArgs a{};
    for (int i = 0; i < 26; ++i) a.in[i] = (const float*)d_in[i];
    a.out = (float*)d_out; a.ws = (unsigned char*)d_ws;
#if MK_PER_PHASE
    for (int ph = 0; ph < N_PHASES; ++ph) {
        a.ph_lo = ph; a.ph_hi = ph + 1;
        int ki;
        if (ph < 2) ki = ph;
        else { const int k = (ph - 2) % 11; ki = (k == 0 || k == 8) ? 2 : (k == 1 || k == 9 || k == 6) ? 3 : (k == 2 || k == 7 || k == 10) ? 4 : (k == 3) ? 5 : (k == 4) ? 6 : 7; }
        hipLaunchKernelGGL(kerns[ki], dim3(grid), dim3(512), LDS_BYTES, stream, a);
    }
#else
    a.ph_lo = 0; a.ph_hi = N_PHASES;
    void* args[] = {&a};
    hipError_t e = hipLaunchCooperativeKernel((const void*)kerns[0], dim3(grid), dim3(512), args, LDS_BYTES, stream);
    if (e != hipSuccess) fprintf(stderr, "cooperative launch failed: %s (grid %d)\n", hipGetErrorString(e), grid);
#endif
}
```

```cpp
#include <hip/hip_runtime.h>
#include <hip/hip_cooperative_groups.h>
#include <cstdio>
#include <cstdint>
namespace cg = cooperative_groups;

#ifndef MK_PER_PHASE
#define MK_PER_PHASE 0
#endif

#define DI __device__ __forceinline__
#define LAS __attribute__((address_space(3)))
typedef unsigned short bf16_t;
typedef short bf16x8 __attribute__((ext_vector_type(8)));
typedef short s16x4 __attribute__((ext_vector_type(4)));
typedef float f32x4 __attribute__((ext_vector_type(4)));
typedef float f32x16 __attribute__((ext_vector_type(16)));
typedef unsigned u32x4 __attribute__((ext_vector_type(4)));
typedef unsigned u32x2 __attribute__((ext_vector_type(2)));
typedef __bf16 bf16x2_t __attribute__((ext_vector_type(2)));
typedef float f32x2_t __attribute__((ext_vector_type(2)));

DI unsigned pk2(float lo, float hi) { f32x2_t v = {lo, hi}; bf16x2_t b = __builtin_convertvector(v, bf16x2_t); return __builtin_bit_cast(unsigned, b); }
DI bf16_t f2bf(float f) { return (bf16_t)(pk2(f, 0.f) & 0xffffu); }
DI int otid() { int t = threadIdx.x; asm volatile("" : "+v"(t)); return t; }
DI float wave_sum(float v) { v += __shfl_xor(v, 1); v += __shfl_xor(v, 2); v += __shfl_xor(v, 4); v += __shfl_xor(v, 8); v += __shfl_xor(v, 16); v += __shfl_xor(v, 32); return v; }

constexpr int T = 12288, TP = 4096, D = 1024, FF = 2816, NIN = 2560, LKS = 4352;
constexpr float ALPHA = 1.41421356237f;
constexpr float QSCALE = 0.125f * 1.44269504089f;

constexpr size_t al256(size_t x) { return (x + 255) & ~(size_t)255; }
constexpr size_t WS_CTL = 0;
constexpr size_t WS_MOD = 16384;
constexpr size_t WS_ROPE = WS_MOD + al256(2 * 3 * 9216 * 4);
constexpr size_t WS_DFTP = WS_ROPE + 8192;
constexpr size_t WS_DFTS = WS_DFTP + 256 * 512 * 2;
constexpr size_t WS_WGU1 = WS_DFTS + (size_t)4096 * 8192 * 2;
constexpr size_t WS_WD1 = WS_WGU1 + (size_t)5632 * 1024 * 2;
constexpr size_t WS_WIN = WS_WD1 + (size_t)1024 * 2816 * 2;
constexpr size_t WS_WOUT = WS_WIN + (size_t)2560 * 1024 * 2;
constexpr size_t WS_WGU2 = WS_WOUT + (size_t)1024 * 1024 * 2;
constexpr size_t WS_WD2 = WS_WGU2 + (size_t)5632 * 1024 * 2;
constexpr size_t WS_X = WS_WD2 + (size_t)1024 * 2816 * 2;
constexpr size_t WS_KAS = WS_X + (size_t)T * D * 4;
constexpr size_t WS_VAS = WS_KAS + (size_t)2 * 2 * LKS * 64 * 2;
constexpr size_t WS_KBS = WS_VAS + (size_t)2 * 2 * LKS * 64 * 2;
constexpr size_t WS_VBS = WS_KBS + (size_t)2 * 8 * LKS * 64 * 2;
constexpr size_t WS_H = WS_VBS + (size_t)2 * 4 * 128 * LKS * 2;
constexpr size_t WS_R = WS_H + (size_t)T * D * 2;
constexpr size_t WS_ACT = WS_R;
constexpr size_t WS_QA = WS_R;
constexpr size_t WS_QB = WS_QA + (size_t)T * 256 * 2;
constexpr size_t WS_KAP = WS_QB + (size_t)T * 512 * 2;
constexpr size_t WS_VAP = WS_KAP + (size_t)16 * 2 * 256 * 64 * 2;
constexpr size_t WS_KBP = WS_VAP + (size_t)16 * 2 * 256 * 64 * 2;
constexpr size_t WS_VBP = WS_KBP + (size_t)16 * 8 * 256 * 64 * 2;
constexpr size_t WS_UTP = WS_VBP + (size_t)16 * 4 * 128 * 256 * 2;
constexpr size_t WS_UTS = WS_UTP + (size_t)4096 * 512 * 2;
constexpr size_t WS_MIX = WS_UTS + (size_t)512 * 8192 * 2;
constexpr size_t WS_FACC = WS_MIX + (size_t)T * D * 2;
constexpr size_t WS_REND = WS_FACC + (size_t)T * 256 * 4;
constexpr size_t WS_END = (WS_REND > WS_ACT + (size_t)T * FF * 2) ? WS_REND : WS_ACT + (size_t)T * FF * 2;

constexpr int LDS_RING = 131072, MISC_OFF = LDS_RING, LDS_BYTES = LDS_RING + 256;

struct KArgs { const float* in[26]; float* out; unsigned char* ws; int ph_lo, ph_hi; };
typedef const KArgs __attribute__((address_space(4)))* KP;

namespace pg8 {
constexpr int BM = 256, BK = 64, HALF = 128, HTB = HALF * BK * 2, STAGE_BYTES = 8 * HTB, NXCD = 8, WGM = 8;
DI int lds_byte(int r, int c) { const int st = (r >> 4) * 2 + (c >> 5), rr = r & 15, cc = c & 31, ob = rr * 64 + cc * 2; return st * 1024 + (ob ^ (((ob >> 9) & 1) << 5)); }
DI void stage_rc(int b, int& R, int& C) { const int st = b / 1024, sb = b % 1024, swz = sb ^ (((sb >> 9) & 1) << 5); R = (st >> 1) * 16 + swz / 64; C = (st & 1) * 32 + (swz % 64) / 2; }
DI int perm32(int rho) { const int n = rho >> 4, i = rho & 15; return 8 * (i >> 2) + 4 * n + (i & 3); }

struct Unit { int pm, pn, ko; };
struct Gemm { const bf16_t* A; const bf16_t* Bt; int ld, K; };

struct StaticOrder {
    int nM, nN, nwg, G, c;
    DI void init(int M, int N, int G_, int c_) { nM = M / BM; nN = N / BM; nwg = nM * nN; G = G_; c = c_; }
    DI bool next(int i, Unit& u) const {
        const long L = (long)i * G + c; if (L >= nwg) return false;
        int wgid = (int)L; { const int q = nwg / NXCD, r = nwg % NXCD, xcd = wgid % NXCD, off = wgid / NXCD; wgid = (xcd < r ? xcd * (q + 1) : r * (q + 1) + (xcd - r) * q) + off; }
        const int nig = WGM * nN, gid = wgid / nig, fm = gid * WGM, gsz = (nM - fm) < WGM ? (nM - fm) : WGM;
        u.pm = fm + ((wgid % nig) % gsz); u.pn = (wgid % nig) / gsz; u.ko = 0; return true;
    }
};
struct FourOrder {
    int G, c, total, mode;
    DI bool next(int i, Unit& u) const {
        const int L = i * G + c - (mode ? 32 : 0); if (L < 0 || L >= total) return false;
        u.ko = 0;
        if (mode == 0) { u.pm = L >> 1; u.pn = L & 1; } else { u.pm = 0; u.pn = L; }
        return true;
    }
};

template <class Epi, class Sched, bool ALIGN_EPI, bool SP2>
DI void gemm_phase(LAS unsigned char* lds, const Gemm g, const Sched& S, const Epi& E) {
    int tid = threadIdx.x; asm volatile("" : "+v"(tid));
    const int wid = __builtin_amdgcn_readfirstlane(tid >> 6), lane = tid & 63, wr = wid >> 2, wc = wid & 3, fr = lane & 15, fq = lane >> 4;
    const int K = g.K, nt = K / BK, ld = g.ld;
    unsigned voffA[2], voffB[2];
#pragma unroll
    for (int i = 0; i < 2; ++i) { int R, C; stage_rc(tid * 16 + i * 8192, R, C); const int Rb = (R & ~31) + perm32(R & 31);
        voffA[i] = (unsigned)(R * ld + C) * 2u; voffB[i] = (unsigned)(Rb * ld + C) * 2u; }
    const size_t kstep = (size_t)(BK * 2);
    const size_t hstep = (size_t)HALF * ld * 2;
    const size_t tstep = 2 * hstep;
    const unsigned ldsw = (unsigned)wid * 1024u;
    const int aoff = lds_byte(wr * 64 + fr, fq * 8), boff = lds_byte(wc * 32 + fr, fq * 8);
#define PG8_SA(b, h) (((b) * 2 + (h)) * HTB)
#define PG8_SB(b, h) ((4 + (b) * 2 + (h)) * HTB)
#define PG8_STAGE(bufoff, gbase, voff) do { _Pragma("unroll") for (int _i = 0; _i < 2; ++_i) \
        __builtin_amdgcn_global_load_lds((const unsigned*)((const char*)(gbase) + (voff)[_i]), (LAS unsigned*)(lds + (bufoff) + ldsw + _i * 8192), 16, 0, 0); } while (0)
#define PG8_LDA(dst, b, h) do { _Pragma("unroll") for (int m = 0; m < 4; ++m) _Pragma("unroll") for (int k = 0; k < 2; ++k) dst[m][k] = *(const LAS bf16x8*)(lds + PG8_SA(b, h) + aoff + m * 2048 + k * 1024); } while (0)
#define PG8_LDB(dst, b, h) do { _Pragma("unroll") for (int n = 0; n < 2; ++n) _Pragma("unroll") for (int k = 0; k < 2; ++k) dst[n][k] = *(const LAS bf16x8*)(lds + PG8_SB(b, h) + boff + n * 2048 + k * 1024); } while (0)
#define PG8_MMA(ai, bj, At, Bt) do { __builtin_amdgcn_s_setprio(1); _Pragma("unroll") for (int m = 0; m < 4; ++m) _Pragma("unroll") for (int n = 0; n < 2; ++n) _Pragma("unroll") for (int k = 0; k < 2; ++k) \
        acc[ai][bj][m][n] = __builtin_amdgcn_mfma_f32_16x16x32_bf16(Bt[n][k], At[m][k], acc[ai][bj][m][n], 0, 0, 0); __builtin_amdgcn_s_setprio(0); } while (0)
#define PG8_WAIT_V(n) asm volatile("s_waitcnt vmcnt(" #n ")" ::: "memory")
#define PG8_WAIT_L(n) asm volatile("s_waitcnt lgkmcnt(" #n ")" ::: "memory")
#define PG8_BAR __builtin_amdgcn_s_barrier()
#define PG8_SCHED __builtin_amdgcn_sched_barrier(0)
    Unit cur, nxt; int ui = 0;
    if (!S.next(0, cur)) return;
    f32x4 acc[2][2][4][2];
#pragma unroll
    for (int a = 0; a < 2; ++a)
#pragma unroll
        for (int b = 0; b < 2; ++b)
#pragma unroll
            for (int m = 0; m < 4; ++m)
#pragma unroll
                for (int n = 0; n < 2; ++n) acc[a][b][m][n] = (f32x4){0.f, 0.f, 0.f, 0.f};
    bf16x8 At[4][2], B0[2][2], B1[2][2];
    const char* cA = (const char*)g.A + (size_t)cur.pm * tstep + (size_t)cur.ko * 2; const char* cB = (const char*)g.Bt + (size_t)cur.pn * tstep + (size_t)cur.ko * 2;
    if constexpr (SP2) {
        PG8_STAGE(PG8_SB(0, 0), cB, voffB); PG8_STAGE(PG8_SB(0, 1), cB + hstep, voffB); PG8_STAGE(PG8_SA(0, 0), cA, voffA); PG8_STAGE(PG8_SA(0, 1), cA + hstep, voffA);
        if (wr == 1) PG8_BAR;
        PG8_WAIT_V(2); PG8_BAR;
        PG8_STAGE(PG8_SB(1, 0), cB + kstep, voffB); PG8_STAGE(PG8_SA(1, 0), cA + kstep, voffA); PG8_STAGE(PG8_SB(1, 1), cB + hstep + kstep, voffB);
        PG8_WAIT_V(6); PG8_BAR;
    } else {
        PG8_STAGE(PG8_SB(0, 0), cB, voffB); PG8_STAGE(PG8_SA(0, 0), cA, voffA); PG8_STAGE(PG8_SB(0, 1), cB + hstep, voffB); PG8_STAGE(PG8_SA(0, 1), cA + hstep, voffA);
        if (wr == 1) PG8_BAR;
        PG8_WAIT_V(4); PG8_BAR;
        PG8_STAGE(PG8_SB(1, 0), cB + kstep, voffB); PG8_STAGE(PG8_SA(1, 0), cA + kstep, voffA); PG8_STAGE(PG8_SB(1, 1), cB + hstep + kstep, voffB);
        PG8_WAIT_V(6); PG8_BAR;
    }
    for (;;) {
        const bool has_next = S.next(ui + 1, nxt);
        const char* nA = has_next ? (const char*)g.A + (size_t)nxt.pm * tstep + (size_t)nxt.ko * 2 : cA; const char* nB = has_next ? (const char*)g.Bt + (size_t)nxt.pn * tstep + (size_t)nxt.ko * 2 : cB;
        for (int t = 0; t < nt; t += 2) {
            const bool last = (t == nt - 2);
            const char* a1 = cA + (size_t)(t + 1) * kstep;
            const char* a2 = last ? nA : cA + (size_t)(t + 2) * kstep; const char* b2 = last ? nB : cB + (size_t)(t + 2) * kstep;
            const char* a3 = a2 + kstep; const char* b3 = b2 + kstep;
            if constexpr (SP2) {
            PG8_LDB(B0, 0, 0); PG8_LDB(B1, 0, 1); PG8_SCHED; PG8_LDA(At, 0, 0); PG8_STAGE(PG8_SA(1, 1), a1 + hstep, voffA);
            PG8_WAIT_V(8); PG8_WAIT_L(0); PG8_BAR; PG8_MMA(0, 0, At, B0); PG8_MMA(0, 1, At, B1); PG8_BAR; PG8_SCHED;
            PG8_LDA(At, 0, 1); PG8_STAGE(PG8_SB(0, 0), b2, voffB); PG8_STAGE(PG8_SB(0, 1), b2 + hstep, voffB); PG8_STAGE(PG8_SA(0, 0), a2, voffA);
            PG8_WAIT_V(8); PG8_WAIT_L(0); PG8_BAR; PG8_MMA(1, 0, At, B0); PG8_MMA(1, 1, At, B1); PG8_BAR; PG8_SCHED;
            PG8_LDB(B0, 1, 0); PG8_LDB(B1, 1, 1); PG8_SCHED; PG8_LDA(At, 1, 0); PG8_STAGE(PG8_SA(0, 1), a2 + hstep, voffA);
            PG8_WAIT_V(8); PG8_WAIT_L(0); PG8_BAR; PG8_MMA(0, 0, At, B0); PG8_MMA(0, 1, At, B1); PG8_BAR; PG8_SCHED;
            PG8_LDA(At, 1, 1); PG8_STAGE(PG8_SB(1, 0), b3, voffB); PG8_STAGE(PG8_SB(1, 1), b3 + hstep, voffB); PG8_STAGE(PG8_SA(1, 0), a3, voffA);
            PG8_WAIT_V(8); PG8_WAIT_L(0); PG8_BAR; PG8_MMA(1, 0, At, B0); PG8_MMA(1, 1, At, B1); PG8_BAR; PG8_SCHED;
            } else {
            PG8_LDB(B0, 0, 0); PG8_SCHED; PG8_LDA(At, 0, 0); PG8_STAGE(PG8_SA(1, 1), a1 + hstep, voffA);
            PG8_WAIT_L(8); PG8_BAR; PG8_WAIT_L(0); PG8_MMA(0, 0, At, B0); PG8_BAR; PG8_SCHED;
            PG8_LDB(B1, 0, 1); PG8_STAGE(PG8_SB(0, 0), b2, voffB);
            PG8_BAR; PG8_WAIT_L(0); PG8_MMA(0, 1, At, B1); PG8_BAR;
            PG8_LDA(At, 0, 1); PG8_STAGE(PG8_SA(0, 0), a2, voffA);
            PG8_BAR; PG8_WAIT_L(0); PG8_MMA(1, 0, At, B0); PG8_BAR; PG8_SCHED;
            PG8_STAGE(PG8_SB(0, 1), b2 + hstep, voffB);
            PG8_WAIT_V(6); PG8_BAR; PG8_MMA(1, 1, At, B1); PG8_BAR;
            PG8_LDB(B0, 1, 0); PG8_SCHED; PG8_LDA(At, 1, 0); PG8_STAGE(PG8_SA(0, 1), a2 + hstep, voffA);
            PG8_WAIT_L(8); PG8_BAR; PG8_WAIT_L(0); PG8_MMA(0, 0, At, B0); PG8_BAR; PG8_SCHED;
            PG8_LDB(B1, 1, 1); PG8_STAGE(PG8_SB(1, 0), b3, voffB);
            PG8_BAR; PG8_WAIT_L(0); PG8_MMA(0, 1, At, B1); PG8_BAR;
            PG8_LDA(At, 1, 1); PG8_STAGE(PG8_SA(1, 0), a3, voffA);
            PG8_BAR; PG8_WAIT_L(0); PG8_MMA(1, 0, At, B0); PG8_BAR; PG8_SCHED;
            PG8_STAGE(PG8_SB(1, 1), b3 + hstep, voffB);
            PG8_WAIT_V(6); PG8_BAR; PG8_MMA(1, 1, At, B1); PG8_BAR;
            }
        }
        if constexpr (ALIGN_EPI) { if (wr == 0) PG8_BAR; }
        E(acc, cur, wr, wc, fr, fq);
        if (!has_next) break;
#pragma unroll
        for (int a = 0; a < 2; ++a)
#pragma unroll
            for (int b = 0; b < 2; ++b)
#pragma unroll
                for (int m = 0; m < 4; ++m)
#pragma unroll
                    for (int n = 0; n < 2; ++n) acc[a][b][m][n] = (f32x4){0.f, 0.f, 0.f, 0.f};
        cur = nxt; cA = nA; cB = nB; ++ui;
        if constexpr (ALIGN_EPI) { if (wr == 1) PG8_BAR; }
    }
    PG8_WAIT_V(0);
    if constexpr (!ALIGN_EPI) { if (wr == 0) PG8_BAR; }
    PG8_BAR;
#undef PG8_SA
#undef PG8_SB
#undef PG8_STAGE
#undef PG8_LDA
#undef PG8_LDB
#undef PG8_MMA
#undef PG8_WAIT_V
#undef PG8_WAIT_L
#undef PG8_BAR
#undef PG8_SCHED
}

DI int mod_of_row_tile(int pm) { return pm < 16 ? 0 : 1 + ((pm - 16) >> 4); }

struct EpiGU {
    bf16_t* ACT;
    DI void operator()(const f32x4 (&acc)[2][2][4][2], const Unit& u, int wr, int wc, int fr_in, int fq_in) const {
        int fr = fr_in, fq = fq_in; asm volatile("" : "+v"(fr), "+v"(fq));
#pragma unroll
        for (int ai = 0; ai < 2; ++ai)
#pragma unroll
            for (int m = 0; m < 4; ++m) {
                const int row = u.pm * 256 + ai * 128 + wr * 64 + m * 16 + fr;
                float o[8];
#pragma unroll
                for (int n = 0; n < 2; ++n)
#pragma unroll
                    for (int j = 0; j < 4; ++j) { const float gg = acc[ai][0][m][n][j], uu = acc[ai][1][m][n][j];
                        const float sg = gg * __builtin_amdgcn_rcpf(1.f + __builtin_amdgcn_exp2f(-1.44269504089f * gg)); o[n * 4 + j] = sg * uu; }
                u32x4 w; w.x = pk2(o[0], o[1]); w.y = pk2(o[2], o[3]); w.z = pk2(o[4], o[5]); w.w = pk2(o[6], o[7]);
                *(u32x4*)(ACT + (size_t)row * FF + u.pn * 128 + wc * 32 + fq * 8) = w;
            }
    }
};

struct EpiRes {
    const float* srcP; const float* srcS; float* X; const float* gate; float coef;
    DI void operator()(const f32x4 (&acc)[2][2][4][2], const Unit& u, int wr, int wc, int fr_in, int fq_in) const {
        int fr = fr_in, fq = fq_in; asm volatile("" : "+v"(fr), "+v"(fq));
        const float* gt = gate + mod_of_row_tile(u.pm) * 9216;
        f32x4 gv[2][2];
#pragma unroll
        for (int bj = 0; bj < 2; ++bj)
#pragma unroll
            for (int n = 0; n < 2; ++n) gv[bj][n] = *(const f32x4*)(gt + u.pn * 256 + bj * 128 + wc * 32 + fq * 8 + n * 4) * coef;
#pragma unroll
        for (int ai = 0; ai < 2; ++ai)
#pragma unroll
            for (int m = 0; m < 4; ++m) {
                const int row = u.pm * 256 + ai * 128 + wr * 64 + m * 16 + fr;
                const float* sp = (row < TP) ? srcP + (size_t)row * D : srcS + (size_t)(row - TP) * D;
#pragma unroll
                for (int bj = 0; bj < 2; ++bj)
#pragma unroll
                    for (int n = 0; n < 2; ++n) { const int c = u.pn * 256 + bj * 128 + wc * 32 + fq * 8 + n * 4;
                        const f32x4 xv = *(const f32x4*)(sp + c);
                        *(f32x4*)(X + (size_t)row * D + c) = xv * ALPHA + gv[bj][n] * acc[ai][bj][m][n]; }
            }
    }
};

struct EpiFour {
    bf16_t* MIX; int mode;
    DI void operator()(const f32x4 (&acc)[2][2][4][2], const Unit& u, int wr, int wc, int fr_in, int fq_in) const {
        int fr = fr_in, fq = fq_in; asm volatile("" : "+v"(fr), "+v"(fq));
        const int tok0 = ((mode == 0) ? TP + u.pn * 4096 + u.pm * 256 : u.pn * 256) + wr * 64 + fr;
        bf16_t* p0 = MIX + (size_t)tok0 * D + 768 + wc * 32 + fq * 8;
#pragma unroll
        for (int ai = 0; ai < 2; ++ai)
#pragma unroll
            for (int m = 0; m < 4; ++m) {
                bf16_t* p = p0 + (size_t)(ai * 128 + m * 16) * D;
#pragma unroll
                for (int bj = 0; bj < 2; ++bj) {
                    u32x4 w; w.x = pk2(acc[ai][bj][m][0][0], acc[ai][bj][m][0][1]); w.y = pk2(acc[ai][bj][m][0][2], acc[ai][bj][m][0][3]);
                    w.z = pk2(acc[ai][bj][m][1][0], acc[ai][bj][m][1][1]); w.w = pk2(acc[ai][bj][m][1][2], acc[ai][bj][m][1][3]);
                    *(u32x4*)(p + bj * 128) = w;
                }
            }
    }
};

struct EpiIn {
    int l; const float* g_qa; const float* g_ka; float* out; unsigned char* ws;
    DI void operator()(const f32x4 (&acc)[2][2][4][2], const Unit& u, int wr, int wc, int fr_in, int fq_in) const {
        int fr = fr_in, fq = fq_in; asm volatile("" : "+v"(fr), "+v"(fq));
        const int t = u.pn; const bool prompt = u.pm < 16;
        const float* rope = (const float*)(ws + WS_ROPE);
        bf16_t* const QA = (bf16_t*)(ws + WS_QA); bf16_t* const QB = (bf16_t*)(ws + WS_QB); bf16_t* const KAS = (bf16_t*)(ws + WS_KAS); bf16_t* const VAS = (bf16_t*)(ws + WS_VAS);
        bf16_t* const KBS = (bf16_t*)(ws + WS_KBS); bf16_t* const VBS = (bf16_t*)(ws + WS_VBS); bf16_t* const KAP = (bf16_t*)(ws + WS_KAP); bf16_t* const VAP = (bf16_t*)(ws + WS_VAP);
        bf16_t* const KBP = (bf16_t*)(ws + WS_KBP); bf16_t* const VBP = (bf16_t*)(ws + WS_VBP); bf16_t* const UTP = (bf16_t*)(ws + WS_UTP); bf16_t* const UTS = (bf16_t*)(ws + WS_UTS);
        if (t >= 8) {
            const int cs = t - 8;
#pragma unroll
            for (int ai = 0; ai < 2; ++ai)
#pragma unroll
                for (int m = 0; m < 4; ++m) {
                    const int row = u.pm * 256 + ai * 128 + wr * 64 + m * 16 + fr;
                    bf16_t* base; size_t pitch;
                    if (prompt) { base = UTP + (size_t)(row >> 8) * 256 * 512 + cs * 256 + (row & 255); pitch = 512; }
                    else { const int rs = row - TP; base = UTS + (size_t)(rs >> 12) * 256 * 8192 + cs * 4096 + (rs & 4095); pitch = 8192; }
#pragma unroll
                    for (int bj = 0; bj < 2; ++bj)
#pragma unroll
                        for (int n = 0; n < 2; ++n)
#pragma unroll
                            for (int j = 0; j < 4; ++j) base[(size_t)(bj * 128 + wc * 32 + fq * 8 + n * 4 + j) * pitch] = f2bf(acc[ai][bj][m][n][j]);
                    __builtin_amdgcn_sched_barrier(0);
                }
            return;
        }
        const bool do_norm = (t == 0) || (t == 1 && wc < 2);
        const bool is_v = (t == 1 && wc >= 2) || t >= 6;
        const bool is_q = (t == 0) || t == 2 || t == 3;
        const bool do_rope = !prompt && !is_v;
        const float* gp = (t == 0 ? g_qa : g_ka) + l * 64 + fq * 8;
#pragma unroll
        for (int ai = 0; ai < 2; ++ai)
#pragma unroll
            for (int m = 0; m < 4; ++m) {
                const int row = u.pm * 256 + ai * 128 + wr * 64 + m * 16 + fr;
                int b, pos;
                if (prompt) { b = row >> 8; pos = row & 255; } else { const int rs = row - TP; b = rs >> 12; pos = rs & 4095; }
                float v[2][8];
#pragma unroll
                for (int bj = 0; bj < 2; ++bj)
#pragma unroll
                    for (int n = 0; n < 2; ++n)
#pragma unroll
                        for (int j = 0; j < 4; ++j) v[bj][n * 4 + j] = acc[ai][bj][m][n][j];
                if (do_norm) {
                    float ss = 0.f;
#pragma unroll
                    for (int bj = 0; bj < 2; ++bj)
#pragma unroll
                        for (int e = 0; e < 8; ++e) ss += v[bj][e] * v[bj][e];
                    ss += __shfl_xor(ss, 16); ss += __shfl_xor(ss, 32);
                    const float rs_ = rsqrtf(ss * (1.f / 64.f) + 1e-6f);
#pragma unroll
                    for (int bj = 0; bj < 2; ++bj)
#pragma unroll
                        for (int e = 0; e < 8; ++e) v[bj][e] = v[bj][e] * rs_ * gp[bj * 32 + e];
                }
                if (prompt && !is_q) {
                    float* op;
                    if (t == 1) op = out + (wc < 2 ? 12582912 : 13631488) + ((size_t)((b * 2 + l) * 256 + pos)) * 128 + (wc & 1) * 64;
                    else if (t < 6) op = out + 14680064 + ((size_t)((b * 2 + l) * 256 + pos)) * 512 + ((t - 4) * 4 + wc) * 64;
                    else op = out + 18874368 + ((size_t)((b * 2 + l) * 256 + pos)) * 512 + (t - 6) * 256 + wc * 64;
#pragma unroll
                    for (int bj = 0; bj < 2; ++bj) {
                        *(f32x4*)(op + bj * 32 + fq * 8) = (f32x4){v[bj][0], v[bj][1], v[bj][2], v[bj][3]};
                        *(f32x4*)(op + bj * 32 + fq * 8 + 4) = (f32x4){v[bj][4], v[bj][5], v[bj][6], v[bj][7]};
                    }
                }
                if (do_rope) {
#pragma unroll
                    for (int bj = 0; bj < 2; ++bj) {
                        const int pv_ = bj == 0 ? (pos >> 6) : (pos & 63);
                        const float* rp = rope + (pv_ * 16 + (fq & 1) * 8) * 2;
#pragma unroll
                        for (int e = 0; e < 8; ++e) {
                            const float cc = rp[2 * e], sn = rp[2 * e + 1];
                            const float other = __shfl_xor(v[bj][e], 32);
                            v[bj][e] = v[bj][e] * cc + (fq < 2 ? -other : other) * sn;
                        }
                    }
                }
                if (is_v) {
                    bf16_t* base; size_t pitch;
                    if (t == 1) { const int kvh = wc - 2; if (prompt) { base = VAP + (size_t)(b * 2 + kvh) * 64 * 256 + pos; pitch = 256; } else { base = VAS + (size_t)(b * 2 + kvh) * 64 * LKS + 256 + pos; pitch = LKS; } }
                    else { const int hh = (t - 6) * 2 + (wc >> 1); const int d0 = (wc & 1) * 64;
                        if (prompt) { base = VBP + ((size_t)(b * 4 + hh) * 128 + d0) * 256 + pos; pitch = 256; } else { base = VBS + ((size_t)(b * 4 + hh) * 128 + d0) * LKS + 256 + pos; pitch = LKS; } }
#pragma unroll
                    for (int bj = 0; bj < 2; ++bj)
#pragma unroll
                        for (int e = 0; e < 8; ++e) base[(size_t)(bj * 32 + fq * 8 + e) * pitch] = f2bf(v[bj][e]);
                } else {
                    bf16_t* op;
                    if (t == 0) op = QA + (size_t)row * 256 + wc * 64;
                    else if (t == 1) op = prompt ? KAP + ((size_t)(b * 2 + wc) * 256 + pos) * 64 : KAS + ((size_t)(b * 2 + wc) * LKS + 256 + pos) * 64;
                    else if (t < 4) op = QB + (size_t)row * 512 + ((t - 2) * 4 + wc) * 64;
                    else { const int s = (t - 4) * 4 + wc; op = prompt ? KBP + ((size_t)(b * 8 + s) * 256 + pos) * 64 : KBS + ((size_t)(b * 8 + s) * LKS + 256 + pos) * 64; }
                    const float sc = is_q ? QSCALE : 1.f;
#pragma unroll
                    for (int bj = 0; bj < 2; ++bj) {
                        u32x4 w; w.x = pk2(v[bj][0] * sc, v[bj][1] * sc); w.y = pk2(v[bj][2] * sc, v[bj][3] * sc); w.z = pk2(v[bj][4] * sc, v[bj][5] * sc); w.w = pk2(v[bj][6] * sc, v[bj][7] * sc);
                        *(u32x4*)(op + bj * 32 + fq * 8) = w;
                    }
                }
                __builtin_amdgcn_sched_barrier(0);
            }
    }
};
}

template <int DV>
DI void attn_unit(const bf16_t* __restrict__ Q, int qpitch, const bf16_t* __restrict__ K, const bf16_t* __restrict__ VT, int Lk, bf16_t* __restrict__ O, int opitch, LAS unsigned char* lds) {
    constexpr int KROW = 144, VROW = 136, KBYTES = 64 * KROW, VBYTES = DV * VROW, BUF = KBYTES + VBYTES, NV = DV / 64, NDB = DV / 32;
    int tid = threadIdx.x; asm volatile("" : "+v"(tid));
    const int wave = tid >> 6, lane = tid & 63, r = lane & 31, h = lane >> 5;
    bf16x8 qf[4];
    { const bf16_t* qrow = Q + (size_t)(wave * 32 + r) * qpitch;
#pragma unroll
      for (int s = 0; s < 4; ++s) qf[s] = *(const bf16x8*)(qrow + 16 * s + 8 * h); }
    f32x16 o[NDB];
#pragma unroll
    for (int db = 0; db < NDB; ++db)
#pragma unroll
        for (int i = 0; i < 16; ++i) o[db][i] = 0.f;
    float mrun = -1e30f, lrun = 0.f;
    const int skey = tid >> 3, sch = tid & 7;
    const bf16_t* kg = K + (size_t)skey * 64 + sch * 8;
    const bf16_t* vg = VT + (size_t)skey * Lk + sch * 8;
    const unsigned kwoff = skey * KROW + sch * 16, vwoff = KBYTES + skey * VROW + sch * 16;
    u32x4 kreg, vreg[NV];
    kreg = *(const u32x4*)kg;
#pragma unroll
    for (int i = 0; i < NV; ++i) vreg[i] = *(const u32x4*)(vg + (size_t)(64 * i) * Lk);
    *(LAS u32x4*)(lds + kwoff) = kreg;
#pragma unroll
    for (int i = 0; i < NV; ++i) { *(LAS u32x2*)(lds + vwoff + i * 64 * VROW) = (u32x2){vreg[i].x, vreg[i].y}; *(LAS u32x2*)(lds + vwoff + i * 64 * VROW + 8) = (u32x2){vreg[i].z, vreg[i].w}; }
    __syncthreads();
    const int nt = Lk >> 6;
    for (int kt = 0; kt < nt; ++kt) {
        LAS unsigned char* cb = lds + (kt & 1) * BUF;
        LAS unsigned char* nb = lds + ((kt & 1) ^ 1) * BUF;
        const bool more = kt + 1 < nt;
        if (more) {
            kreg = *(const u32x4*)(kg + (size_t)(kt + 1) * 64 * 64);
#pragma unroll
            for (int i = 0; i < NV; ++i) vreg[i] = *(const u32x4*)(vg + (size_t)(64 * i) * Lk + (kt + 1) * 64);
        }
        f32x16 s0, s1;
#pragma unroll
        for (int i = 0; i < 16; ++i) { s0[i] = 0.f; s1[i] = 0.f; }
#pragma unroll
        for (int s = 0; s < 4; ++s) {
            const bf16x8 k0 = *(const LAS bf16x8*)(cb + r * KROW + (16 * s + 8 * h) * 2);
            const bf16x8 k1 = *(const LAS bf16x8*)(cb + (32 + r) * KROW + (16 * s + 8 * h) * 2);
            s0 = __builtin_amdgcn_mfma_f32_32x32x16_bf16(k0, qf[s], s0, 0, 0, 0);
            s1 = __builtin_amdgcn_mfma_f32_32x32x16_bf16(k1, qf[s], s1, 0, 0, 0);
        }
        __builtin_amdgcn_sched_barrier(0);
        float mx = s0[0];
#pragma unroll
        for (int i = 1; i < 16; ++i) mx = fmaxf(mx, s0[i]);
#pragma unroll
        for (int i = 0; i < 16; ++i) mx = fmaxf(mx, s1[i]);
        mx = fmaxf(mx, __shfl_xor(mx, 32));
        const float mnew = fmaxf(mrun, mx);
        const float alpha = __builtin_amdgcn_exp2f(mrun - mnew);
        mrun = mnew;
        float rs = 0.f;
#pragma unroll
        for (int i = 0; i < 16; ++i) { s0[i] = __builtin_amdgcn_exp2f(s0[i] - mnew); s1[i] = __builtin_amdgcn_exp2f(s1[i] - mnew); rs += s0[i] + s1[i]; }
        lrun = lrun * alpha + rs;
#pragma unroll
        for (int db = 0; db < NDB; ++db)
#pragma unroll
            for (int i = 0; i < 16; ++i) o[db][i] *= alpha;
#pragma unroll
        for (int kb = 0; kb < 2; ++kb)
#pragma unroll
            for (int s2 = 0; s2 < 2; ++s2) {
                u32x4 pw;
                if (kb == 0) { pw.x = pk2(s0[8 * s2 + 0], s0[8 * s2 + 1]); pw.y = pk2(s0[8 * s2 + 2], s0[8 * s2 + 3]); pw.z = pk2(s0[8 * s2 + 4], s0[8 * s2 + 5]); pw.w = pk2(s0[8 * s2 + 6], s0[8 * s2 + 7]); }
                else { pw.x = pk2(s1[8 * s2 + 0], s1[8 * s2 + 1]); pw.y = pk2(s1[8 * s2 + 2], s1[8 * s2 + 3]); pw.z = pk2(s1[8 * s2 + 4], s1[8 * s2 + 5]); pw.w = pk2(s1[8 * s2 + 6], s1[8 * s2 + 7]); }
                const bf16x8 pf = __builtin_bit_cast(bf16x8, pw);
#pragma unroll
                for (int db = 0; db < NDB; ++db) {
                    const LAS unsigned char* vp = cb + KBYTES + (32 * db + r) * VROW + (32 * kb + 16 * s2 + 4 * h) * 2;
                    const u32x2 lo = *(const LAS u32x2*)vp, hi = *(const LAS u32x2*)(vp + 16);
                    const u32x4 vw = {lo.x, lo.y, hi.x, hi.y};
                    o[db] = __builtin_amdgcn_mfma_f32_32x32x16_bf16(__builtin_bit_cast(bf16x8, vw), pf, o[db], 0, 0, 0);
                }
                __builtin_amdgcn_sched_barrier(0);
            }
        if (more) {
            *(LAS u32x4*)(nb + kwoff) = kreg;
#pragma unroll
            for (int i = 0; i < NV; ++i) { *(LAS u32x2*)(nb + vwoff + i * 64 * VROW) = (u32x2){vreg[i].x, vreg[i].y}; *(LAS u32x2*)(nb + vwoff + i * 64 * VROW + 8) = (u32x2){vreg[i].z, vreg[i].w}; }
        }
        __syncthreads();
    }
    lrun += __shfl_xor(lrun, 32);
    const float inv = 1.f / lrun;
    bf16_t* orow = O + (size_t)(wave * 32 + r) * opitch;
#pragma unroll
    for (int db = 0; db < NDB; ++db)
#pragma unroll
        for (int g = 0; g < 4; ++g) {
            u32x2 w; w.x = pk2(o[db][4 * g] * inv, o[db][4 * g + 1] * inv); w.y = pk2(o[db][4 * g + 2] * inv, o[db][4 * g + 3] * inv);
            *(u32x2*)(orow + 32 * db + 8 * g + 4 * h) = w;
        }
}

template <int MODE> DI int srccol(int np) {
    if (MODE == 1) { const int pn = np >> 8, j = np & 255; return j < 128 ? 128 * pn + j : FF + 128 * pn + (j - 128); }
    if (MODE == 2) { const int t = np >> 8, p = np & 255; return 256 * t + 64 * ((p >> 5) & 3) + 32 * (p >> 7) + (p & 31); }
    return np;
}
template <int MODE> DI void tr_section(const float* __restrict__ src, int Nsrc, int Kr, int Nd, bf16_t* __restrict__ dst, int ldd, LAS float* tile) {
    const int tid = otid(), nkt = Kr >> 6, total = nkt * (Nd >> 6);
    for (int it = blockIdx.x; it < total; it += gridDim.x) {
        const int n0 = (it / nkt) * 64, k0 = (it % nkt) * 64;
        const int nn = tid & 63, kq = tid >> 6, sc = srccol<MODE>(n0 + nn);
#pragma unroll
        for (int i = 0; i < 8; ++i) { const int kk = kq + 8 * i; tile[kk * 65 + nn] = src[(size_t)(k0 + kk) * Nsrc + sc]; }
        __syncthreads();
        const int n2 = tid >> 3, kc = tid & 7;
        u32x4 w;
        w.x = pk2(tile[(8 * kc + 0) * 65 + n2], tile[(8 * kc + 1) * 65 + n2]); w.y = pk2(tile[(8 * kc + 2) * 65 + n2], tile[(8 * kc + 3) * 65 + n2]);
        w.z = pk2(tile[(8 * kc + 4) * 65 + n2], tile[(8 * kc + 5) * 65 + n2]); w.w = pk2(tile[(8 * kc + 6) * 65 + n2], tile[(8 * kc + 7) * 65 + n2]);
        *(u32x4*)(dst + (size_t)(n0 + n2) * ldd + k0 + 8 * kc) = w;
        __syncthreads();
    }
}

DI void convert_layer(KP a, int l, LAS unsigned char* lds) {
    unsigned char* ws = a->ws; const int tid = otid(), G = gridDim.x;
    LAS float* tile = (LAS float*)(lds + 32768);
    LAS float* t64 = (LAS float*)(lds + 65536);
    if (tid < 64) t64[tid] = cospif((float)tid * (1.f / 32.f));
    __syncthreads();
    tr_section<1>(a->in[20] + (size_t)l * D * 2 * FF, 2 * FF, D, 2 * FF, (bf16_t*)(ws + WS_WGU1), D, tile);
    tr_section<0>(a->in[21] + (size_t)l * FF * D, D, FF, D, (bf16_t*)(ws + WS_WD1), FF, tile);
    tr_section<2>(a->in[10] + (size_t)l * D * 2304, 2304, D, 2048, (bf16_t*)(ws + WS_WIN), D, tile);
    tr_section<0>(a->in[19] + (size_t)l * D * D, D, 768, D, (bf16_t*)(ws + WS_WOUT), D, tile);
    tr_section<1>(a->in[22] + (size_t)l * D * 2 * FF, 2 * FF, D, 2 * FF, (bf16_t*)(ws + WS_WGU2), D, tile);
    tr_section<0>(a->in[23] + (size_t)l * FF * D, D, FF, D, (bf16_t*)(ws + WS_WD2), FF, tile);
    { bf16_t* WinT = (bf16_t*)(ws + WS_WIN);
      for (int it = blockIdx.x; it < 1024; it += G) {
          const int rowi = it >> 1, kdim = (it & 1) * 512 + tid, cs = rowi >> 8, g = (rowi >> 6) & 3, k = rowi & 63;
          const float* wp = a->in[10] + ((size_t)l * D + kdim) * 2304 + 2048 + g * 64;
          float s = 0.f;
#pragma unroll 4
          for (int c4 = 0; c4 < 16; ++c4) { const f32x4 wv = *(const f32x4*)(wp + 4 * c4);
#pragma unroll
              for (int e = 0; e < 4; ++e) { const int idx = (k * (4 * c4 + e)) & 63; s += wv[e] * (cs ? t64[(idx - 16) & 63] : t64[idx]); } }
          WinT[(size_t)(2048 + rowi) * D + kdim] = f2bf(s);
      } }
    { bf16_t* WoutT = (bf16_t*)(ws + WS_WOUT);
      for (int it = blockIdx.x; it < 512; it += G) {
          const int i = it >> 1, n = (it & 1) * 512 + tid;
          const float* wf = a->in[18] + ((size_t)l * 256 + i) * 256;
          const float* wo = a->in[19] + ((size_t)l * D + 768) * D + n;
          float s = 0.f;
#pragma unroll 8
          for (int j = 0; j < 256; ++j) s += wf[j] * wo[(size_t)j * D];
          WoutT[(size_t)n * D + 768 + i] = f2bf(s);
      } }
    { bf16_t* KAS = (bf16_t*)(ws + WS_KAS); bf16_t* VAS = (bf16_t*)(ws + WS_VAS); bf16_t* KBS = (bf16_t*)(ws + WS_KBS); bf16_t* VBS = (bf16_t*)(ws + WS_VBS);
      for (int i = blockIdx.x * 512 + tid; i < 2 * 256 * 1280; i += G * 512) {
          const int e = i % 1280, bp = i / 1280, b = bp >> 8, pos = bp & 255;
          const size_t cbase = (size_t)((b * 2 + l) * 256 + pos);
          if (e < 128) { const int kvh = e >> 6, d = e & 63; KAS[((size_t)(b * 2 + kvh) * LKS + pos) * 64 + d] = f2bf(a->in[2][cbase * 128 + e]); }
          else if (e < 256) { const int e2 = e - 128, kvh = e2 >> 6, d = e2 & 63; VAS[((size_t)(b * 2 + kvh) * 64 + d) * LKS + pos] = f2bf(a->in[3][cbase * 128 + e2]); }
          else if (e < 768) { const int e2 = e - 256, s = e2 >> 6, d = e2 & 63; KBS[((size_t)(b * 8 + s) * LKS + pos) * 64 + d] = f2bf(a->in[4][cbase * 512 + e2]); }
          else { const int e2 = e - 768, hh = e2 >> 7, d = e2 & 127; VBS[((size_t)(b * 4 + hh) * 128 + d) * LKS + pos] = f2bf(a->in[5][cbase * 512 + e2]); }
      } }
    __syncthreads();
}

DI void p0_prologue(KP a, LAS unsigned char* lds) {
    unsigned char* ws = a->ws; const int tid = otid(), G = gridDim.x;
    { LAS float* sv = (LAS float*)lds; LAS float* red = (LAS float*)(lds + 16384);
      for (int i = tid; i < 3072; i += 512) { const int m = i >> 10, k = i & 1023; const float cv = (m == 0) ? a->in[7][k] : a->in[6][(m - 1) * D + k]; sv[i] = cv / (1.f + __expf(-cv)); }
      __syncthreads();
      float* MOD = (float*)(ws + WS_MOD);
      for (int it = blockIdx.x; it < 288; it += G) {
          const int l = it / 144, c0 = (it % 144) * 64, kg = tid >> 6, cc = tid & 63;
          const float* w = a->in[8] + (size_t)l * D * 9216 + c0 + cc;
          float a0 = 0.f, a1 = 0.f, a2 = 0.f;
#pragma unroll 8
          for (int k = kg; k < D; k += 8) { const float wv = w[(size_t)k * 9216]; a0 += sv[k] * wv; a1 += sv[1024 + k] * wv; a2 += sv[2048 + k] * wv; }
          red[(kg * 3 + 0) * 64 + cc] = a0; red[(kg * 3 + 1) * 64 + cc] = a1; red[(kg * 3 + 2) * 64 + cc] = a2;
          __syncthreads();
          if (tid < 192) { const int m = tid >> 6, c2 = tid & 63; float s = 0.f;
#pragma unroll
              for (int q = 0; q < 8; ++q) s += red[(q * 3 + m) * 64 + c2];
              MOD[(size_t)(l * 3 + m) * 9216 + c0 + c2] = s + a->in[9][l * 9216 + c0 + c2]; }
          __syncthreads();
      } }
    if (blockIdx.x == G - 1) {
        float* ROPE = (float*)(ws + WS_ROPE);
        for (int i = tid; i < 1024; i += 512) { const int pos = i >> 4, f = i & 15;
            const float inv = exp2f(-(float)f * (13.2877123795f / 16.f)); float rev = (float)pos * inv * 0.15915494309f; rev -= floorf(rev);
            ROPE[2 * i] = cospif(2.f * rev); ROPE[2 * i + 1] = sinpif(2.f * rev); }
    }
    { LAS float* tab = (LAS float*)lds;
      __syncthreads();
      for (int i = tid; i < 4096; i += 512) tab[i] = cospif((float)i * (1.f / 2048.f));
      __syncthreads();
      bf16_t* DS = (bf16_t*)(ws + WS_DFTS);
      for (int p = blockIdx.x; p < 4096; p += G)
          for (int ch = tid; ch < 1024; ch += 512) {
              const int k0 = ch * 8, n0 = k0 & 4095; const bool sp = k0 >= 4096; float v[8];
#pragma unroll
              for (int e = 0; e < 8; ++e) { const int idx = (p * (n0 + e)) & 4095; v[e] = (sp ? -tab[(idx - 1024) & 4095] : tab[idx]) * (1.f / 512.f); }
              u32x4 w; w.x = pk2(v[0], v[1]); w.y = pk2(v[2], v[3]); w.z = pk2(v[4], v[5]); w.w = pk2(v[6], v[7]);
              *(u32x4*)(DS + (size_t)p * 8192 + k0) = w;
          }
      bf16_t* DP = (bf16_t*)(ws + WS_DFTP);
      for (int p = blockIdx.x; p < 256; p += G)
          if (tid < 64) {
              const int k0 = tid * 8, n0 = k0 & 255; const bool sp = k0 >= 256; float v[8];
#pragma unroll
              for (int e = 0; e < 8; ++e) { const int idx = ((p * (n0 + e)) & 255) * 16; v[e] = (sp ? -tab[(idx - 1024) & 4095] : tab[idx]) * (1.f / 128.f); }
              u32x4 w; w.x = pk2(v[0], v[1]); w.y = pk2(v[2], v[3]); w.z = pk2(v[4], v[5]); w.w = pk2(v[6], v[7]);
              *(u32x4*)(DP + (size_t)p * 512 + k0) = w;
          }
      __syncthreads(); }
    convert_layer(a, 0, lds);
}

DI void p_modulate0(KP a) {
    const float* MOD = (const float*)(a->ws + WS_MOD); bf16_t* H = (bf16_t*)(a->ws + WS_H);
    for (int i = blockIdx.x * 512 + otid(); i < T * 128; i += gridDim.x * 512) {
        const int row = i >> 7, c0 = (i & 127) * 8;
        const float* sp = (row < TP) ? a->in[0] + (size_t)row * D : a->in[1] + (size_t)(row - TP) * D;
        const float* md = MOD + (size_t)(row < TP ? 0 : 1 + ((row - TP) >> 12)) * 9216;
        float v[8];
#pragma unroll
        for (int q = 0; q < 2; ++q) { const f32x4 x = *(const f32x4*)(sp + c0 + 4 * q), sh = *(const f32x4*)(md + c0 + 4 * q), sc = *(const f32x4*)(md + 1024 + c0 + 4 * q);
#pragma unroll
            for (int e = 0; e < 4; ++e) v[4 * q + e] = x[e] * (1.f + sc[e]) + sh[e]; }
        u32x4 w; w.x = pk2(v[0], v[1]); w.y = pk2(v[2], v[3]); w.z = pk2(v[4], v[5]); w.w = pk2(v[6], v[7]);
        *(u32x4*)(H + (size_t)row * D + c0) = w;
    }
}

DI void p_layernorm(const float* X, float* xo, bf16_t* H, const float* g, const float* bta, const float* modn  ) {
    const int tid = otid(), wave = tid >> 6, lane = tid & 63;
    for (int row = blockIdx.x * 8 + wave; row < T; row += gridDim.x * 8) {
        f32x4 v[4];
#pragma unroll
        for (int i = 0; i < 4; ++i) v[i] = *(const f32x4*)(X + (size_t)row * D + i * 256 + lane * 4);
        float s = 0.f;
#pragma unroll
        for (int i = 0; i < 4; ++i) s += (v[i][0] + v[i][1]) + (v[i][2] + v[i][3]);
        const float mean = wave_sum(s) * (1.f / 1024.f);
        float q = 0.f;
#pragma unroll
        for (int i = 0; i < 4; ++i) { v[i] = v[i] - mean; q += (v[i][0] * v[i][0] + v[i][1] * v[i][1]) + (v[i][2] * v[i][2] + v[i][3] * v[i][3]); }
        const float rstd = rsqrtf(wave_sum(q) * (1.f / 1024.f) + 1e-5f);
        const float* md = modn ? modn + (size_t)(row < TP ? 0 : 1 + ((row - TP) >> 12)) * 9216 : nullptr;
#pragma unroll
        for (int i = 0; i < 4; ++i) {
            const int c = i * 256 + lane * 4;
            const f32x4 y = v[i] * rstd * *(const f32x4*)(g + c) + *(const f32x4*)(bta + c);
            *(f32x4*)(xo + (size_t)row * D + c) = y;
            if (md) { const f32x4 sh = *(const f32x4*)(md + c), sc = *(const f32x4*)(md + 1024 + c);
                u32x2 w; w.x = pk2(y[0] * (1.f + sc[0]) + sh[0], y[1] * (1.f + sc[1]) + sh[1]); w.y = pk2(y[2] * (1.f + sc[2]) + sh[2], y[3] * (1.f + sc[3]) + sh[3]);
                *(u32x2*)(H + (size_t)row * D + c) = w; }
        }
    }
}

DI void p_combine(KP a, int l) {
    const int tid = otid(), wave = tid >> 6, lane = tid & 63;
    const bf16_t* OBT = (const bf16_t*)(a->ws + WS_H); bf16_t* MIX = (bf16_t*)(a->ws + WS_MIX);
    const float lam_init = (l == 0) ? 0.2f : (0.8f - 0.6f * 0.74081822068f);
    const float d1 = wave_sum(a->in[13][l * 64 + lane] * a->in[14][l * 64 + lane]), d2 = wave_sum(a->in[15][l * 64 + lane] * a->in[16][l * 64 + lane]);
    const float lam = expf(d1) - expf(d2) + lam_init;
    const float g0 = a->in[17][l * 128 + 2 * lane] * (1.f - lam_init), g1 = a->in[17][l * 128 + 2 * lane + 1] * (1.f - lam_init);
    for (int row = blockIdx.x * 8 + wave; row < T; row += gridDim.x * 8) {
#pragma unroll
        for (int hb = 0; hb < 4; ++hb) {
            const unsigned w1 = *(const unsigned*)(OBT + (size_t)row * D + hb * 256 + 2 * lane), w2 = *(const unsigned*)(OBT + (size_t)row * D + hb * 256 + 128 + 2 * lane);
            const float x0 = __uint_as_float(w1 << 16) - lam * __uint_as_float(w2 << 16), x1 = __uint_as_float(w1 & 0xffff0000u) - lam * __uint_as_float(w2 & 0xffff0000u);
            const float rs = rsqrtf(wave_sum(x0 * x0 + x1 * x1) * (1.f / 128.f) + 1e-6f);
            *(unsigned*)(MIX + (size_t)row * D + 256 + hb * 128 + 2 * lane) = pk2(x0 * rs * g0, x1 * rs * g1);
        }
    }
}


#define XB_TMO      128
#define XB_XCNT(j)  (256  + 64 * (j))
#define XB_XSUB(j)  (1280 + 64 * (j))
#define XB_XGEN(j)  (2304 + 64 * (j))
#define XB_TOP      3328
#define XB_TOPGEN   3392
#define XCD_BAR_WORDS 3456
#define XB_SPIN_CAP (1u << 18)
DI unsigned xb_ld(unsigned* p)              { return __hip_atomic_load(p, __ATOMIC_RELAXED, __HIP_MEMORY_SCOPE_AGENT); }
DI unsigned xb_add(unsigned* p, unsigned v) { return __hip_atomic_fetch_add(p, v, __ATOMIC_RELAXED, __HIP_MEMORY_SCOPE_AGENT); }
DI unsigned xb_xcc_id() { return (unsigned)__builtin_amdgcn_s_getreg((3 << 11) | 20) & 0xFu; }
#define XB_SPIN(cond, bar) do { unsigned _sp = 0; while (cond) { __builtin_amdgcn_s_sleep(1); \
    if ((++_sp & 255u) == 0u) { if (xb_ld(&(bar)[XB_TMO])) break; if (_sp > XB_SPIN_CAP) { atomicAdd(&(bar)[XB_TMO], 1u); break; } } } } while (0)
struct XcdBarrier { unsigned* bar; unsigned x; volatile LAS unsigned* st; };
DI XcdBarrier xcd_barrier_post(unsigned* bar, volatile LAS unsigned* st) {
    XcdBarrier b; b.bar = bar; b.x = xb_xcc_id(); b.st = st;
    if (threadIdx.x == 0) (void)xb_add(&bar[XB_XCNT(b.x)], 1u);
    return b;
}
DI void xcd_barrier_complete(unsigned* bar, unsigned x, unsigned& nloc, unsigned& nx) {
    const unsigned G = gridDim.x * gridDim.y * gridDim.z;
    unsigned sum, cnt, mine, sp = 0u;
    for (;;) {
        sum = 0u; cnt = 0u; mine = 0u;
#pragma unroll
        for (unsigned j = 0; j < 16; ++j) { const unsigned c = xb_ld(&bar[XB_XCNT(j)]); sum += c; cnt += (c > 0u) ? 1u : 0u; mine = (j == x) ? c : mine; }
        if (sum == G) break;
        __builtin_amdgcn_s_sleep(1);
        if ((++sp & 255u) == 0u) { if (xb_ld(&bar[XB_TMO])) break; if (sp > XB_SPIN_CAP) { atomicAdd(&bar[XB_TMO], 1u); break; } }
    }
    nloc = mine > 0u ? mine : 1u; nx = cnt > 0u ? cnt : 1u;
}
DI void xcd_barrier(const XcdBarrier& b) {
    asm volatile("s_waitcnt vmcnt(0)" ::: "memory");
    __syncthreads();
    if (threadIdx.x == 0) {
        unsigned* bar = b.bar;
        __builtin_amdgcn_s_waitcnt(0);
        unsigned nloc = b.st[0], nx = b.st[1];
        if (nloc == 0u) { xcd_barrier_complete(bar, b.x, nloc, nx); b.st[0] = nloc; b.st[1] = nx; }
        const unsigned old = xb_add(&bar[XB_XSUB(b.x)], 1u);
        const unsigned gen = old / nloc;
        if (old + 1u == (gen + 1u) * nloc) {
            __builtin_amdgcn_fence(__ATOMIC_RELEASE, "agent");
            asm volatile("s_waitcnt vmcnt(0)" ::: "memory");
            const unsigned og = xb_add(&bar[XB_TOP], 1u);
            const unsigned tg = og / nx;
            if (og + 1u == (tg + 1u) * nx) xb_add(&bar[XB_TOPGEN], 1u);
            else XB_SPIN(xb_ld(&bar[XB_TOPGEN]) == tg, bar);
            __builtin_amdgcn_fence(__ATOMIC_ACQUIRE, "agent");
            xb_add(&bar[XB_XGEN(b.x)], 1u);
            asm volatile("s_waitcnt vmcnt(0)" ::: "memory");
        } else {
            XB_SPIN(xb_ld(&bar[XB_XGEN(b.x)]) == gen, bar);
            __builtin_amdgcn_fence(__ATOMIC_ACQUIRE, "agent");
            asm volatile("s_waitcnt vmcnt(0)" ::: "memory");
        }
    }
    __syncthreads();
}

#ifndef PROBE_MASK
#define PROBE_MASK 0
#endif
constexpr int N_PHASES = 24;
#define PHM(i) ((MASK >> (i)) & 1)
template <int MASK> __global__ void __launch_bounds__(512) trunk_fwd(KArgs a_unused) {
    extern __shared__ __attribute__((aligned(16))) unsigned char lds_raw[];
    LAS unsigned char* lds = (LAS unsigned char*)lds_raw;
    cg::grid_group grid = cg::this_grid();
    const KP a0 = (KP)__builtin_amdgcn_kernarg_segment_ptr();
    unsigned char* ws = a0->ws;
    const int G = gridDim.x, c = blockIdx.x;
    float* X = (float*)(ws + WS_X); bf16_t* H = (bf16_t*)(ws + WS_H); bf16_t* ACT = (bf16_t*)(ws + WS_ACT); bf16_t* MIX = (bf16_t*)(ws + WS_MIX);
    const float* MOD = (const float*)(ws + WS_MOD);
    volatile LAS unsigned* misc = (volatile LAS unsigned*)(lds + MISC_OFF);
    if (threadIdx.x < 16) misc[threadIdx.x] = 0u;
    __syncthreads();
    XcdBarrier xbar = xcd_barrier_post((unsigned*)(ws + WS_CTL) + 64, misc + 8);
    const int ph_lo = a0->ph_lo, ph_hi = a0->ph_hi;
    int redo = 0;
    for (int ph = ph_lo; ph < ph_hi; ++ph) {
        const int tid = otid();
        KP a = a0; asm volatile("" : "+s"(a));
        int kbit; if (ph < 2) kbit = ph; else { const int k_ = (ph - 2) % 11; kbit = (k_ == 0 || k_ == 8) ? 2 : (k_ == 1 || k_ == 9 || k_ == 6) ? 3 : (k_ == 2 || k_ == 7 || k_ == 10) ? 4 : (k_ == 3) ? 5 : (k_ == 4) ? 7 : 8; }
        const int rep = redo;
        {
        if (ph == 0) { if (PHM(0)) p0_prologue(a, lds); }
        else if (ph == 1) { if (PHM(1)) p_modulate0(a); }
        else {
            const int l = (ph - 2) / 11, k = (ph - 2) % 11;
            const float* modl = MOD + (size_t)l * 3 * 9216;
            if (k == 0 || k == 8) { if (PHM(2)) {
                pg8::Gemm g{H, (const bf16_t*)(ws + (k == 0 ? WS_WGU1 : WS_WGU2)), D, D}; pg8::StaticOrder S; S.init(T, 2 * FF, G, c);
                pg8::EpiGU E{ACT};
                pg8::gemm_phase<pg8::EpiGU, pg8::StaticOrder, true, true>(lds, g, S, E); }
            } else if (k == 1 || k == 9 || k == 6) { if (PHM(3)) {
                pg8::Gemm g; pg8::EpiRes E;
                if (k == 6) { g = pg8::Gemm{MIX, (const bf16_t*)(ws + WS_WOUT), D, D}; E = pg8::EpiRes{X, X + (size_t)TP * D, X, modl + 5 * 1024, 1.0f}; }
                else { g = pg8::Gemm{ACT, (const bf16_t*)(ws + (k == 1 ? WS_WD1 : WS_WD2)), FF, FF};
                    const bool first = (l == 0 && k == 1);
                    E = pg8::EpiRes{first ? a->in[0] : X, first ? a->in[1] : X + (size_t)TP * D, X, modl + (k == 1 ? 2 : 8) * 1024, 0.5f}; }
                pg8::StaticOrder S; S.init(T, D, G, c);
                pg8::gemm_phase<pg8::EpiRes, pg8::StaticOrder, true, true>(lds, g, S, E); }
            } else if (k == 2 || k == 7 || k == 10) { if (PHM(4)) {
                const int which = (k == 2) ? 0 : (k == 7 ? 1 : 2);
                const float* lg = a->in[24] + (size_t)(l * 3 + which) * D; const float* lb = a->in[25] + (size_t)(l * 3 + which) * D;
                const bool final_ = (l == 1 && k == 10);
                const float* modn = (k == 2) ? modl + 3 * 1024 : (k == 7) ? modl + 6 * 1024 : (final_ ? nullptr : MOD + (size_t)(l + 1) * 3 * 9216);
                p_layernorm(X, final_ ? a->out : X, H, lg, lb, modn);
                if (k == 10 && l == 0) convert_layer(a, 1, lds); }
            } else if (k == 3) { if (PHM(5)) {
                pg8::Gemm g{H, (const bf16_t*)(ws + WS_WIN), D, D}; pg8::StaticOrder S; S.init(T, NIN, G, c);
                pg8::EpiIn E{l, a->in[11], a->in[12], a->out, ws};
                pg8::gemm_phase<pg8::EpiIn, pg8::StaticOrder, true, true>(lds, g, S, E); }
            } else if (k == 4) {
                if (PHM(6) && (rep == 0 || ((PROBE_MASK >> 6) & 1))) {
#pragma clang loop unroll(disable)
                    for (int pass = 0; pass < 2; ++pass) {
                        const bool sp = pass == 0;
                        pg8::Gemm g{(const bf16_t*)(ws + (sp ? WS_DFTS : WS_DFTP)), (const bf16_t*)(ws + (sp ? WS_UTS : WS_UTP)), sp ? 8192 : 512, sp ? 8192 : 512};
                        pg8::FourOrder S{G, c, sp ? 32 : 16, pass}; pg8::EpiFour E{MIX, pass};
                        pg8::gemm_phase<pg8::EpiFour, pg8::FourOrder, true, true>(lds, g, S, E);
                    }
                }
                volatile LAS int* qslot = (volatile LAS int*)(lds + MISC_OFF);
                unsigned* ctr = (unsigned*)(ws + WS_CTL) + l + 2 * rep;
                const bf16_t* QA = (const bf16_t*)(ws + WS_QA); const bf16_t* QB = (const bf16_t*)(ws + WS_QB);
                bf16_t* OBT = (bf16_t*)(ws + WS_H);
                if (PHM(7) && (rep == 0 || ((PROBE_MASK >> 7) & 1))) for (;;) {
                    __syncthreads();
                    if (tid == 0) *qslot = (int)atomicAdd(ctr, 1u);
                    __syncthreads();
                    const int idx = *qslot;
                    if (idx >= 576) break;
                    const bf16_t *Qp, *Kp, *Vp; bf16_t* Op; int qpitch, Lk; bool wide;
                    if (idx < 256) { const int b = idx >> 7, s = (idx >> 4) & 7, qb = idx & 15; const size_t tok0 = TP + b * 4096 + qb * 256; wide = true; qpitch = 512; Lk = LKS;
                        Qp = QB + tok0 * 512 + s * 64; Kp = (const bf16_t*)(ws + WS_KBS) + (size_t)(b * 8 + s) * LKS * 64; Vp = (const bf16_t*)(ws + WS_VBS) + (size_t)(b * 4 + (s >> 1)) * 128 * LKS; Op = OBT + tok0 * D + s * 128; }
                    else if (idx < 384) { const int i = idx - 256, b = i >> 6, hq = (i >> 4) & 3, qb = i & 15; const size_t tok0 = TP + b * 4096 + qb * 256; wide = false; qpitch = 256; Lk = LKS;
                        Qp = QA + tok0 * 256 + hq * 64; Kp = (const bf16_t*)(ws + WS_KAS) + (size_t)(b * 2 + (hq >> 1)) * LKS * 64; Vp = (const bf16_t*)(ws + WS_VAS) + (size_t)(b * 2 + (hq >> 1)) * 64 * LKS; Op = MIX + tok0 * D + hq * 64; }
                    else if (idx < 512) { const int i = idx - 384, b = i >> 3, s = i & 7; const size_t tok0 = b * 256; wide = true; qpitch = 512; Lk = 256;
                        Qp = QB + tok0 * 512 + s * 64; Kp = (const bf16_t*)(ws + WS_KBP) + (size_t)(b * 8 + s) * 256 * 64; Vp = (const bf16_t*)(ws + WS_VBP) + (size_t)(b * 4 + (s >> 1)) * 128 * 256; Op = OBT + tok0 * D + s * 128; }
                    else { const int i = idx - 512, b = i >> 2, hq = i & 3; const size_t tok0 = b * 256; wide = false; qpitch = 256; Lk = 256;
                        Qp = QA + tok0 * 256 + hq * 64; Kp = (const bf16_t*)(ws + WS_KAP) + (size_t)(b * 2 + (hq >> 1)) * 256 * 64; Vp = (const bf16_t*)(ws + WS_VAP) + (size_t)(b * 2 + (hq >> 1)) * 64 * 256; Op = MIX + tok0 * D + hq * 64; }
                    if (wide) attn_unit<128>(Qp, qpitch, Kp, Vp, Lk, Op, D, lds); else attn_unit<64>(Qp, qpitch, Kp, Vp, Lk, Op, D, lds);
                }
            } else if (k == 5) {
                if (PHM(8)) p_combine(a, l);
            }
        }
        }
        if (ph + 1 < ph_hi || (PROBE_MASK && redo == 0)) { if (ph == 0 && redo == 0 && !((PROBE_MASK >> 0) & 1)) grid.sync(); else if (ph == 0 && redo == 1) grid.sync(); else xcd_barrier(xbar); }
        if ((((PROBE_MASK >> kbit) & 1) || (kbit == 7 && ((PROBE_MASK >> 6) & 1))) && redo == 0) { redo = 1; --ph; } else redo = 0;
    }
}

typedef void (*kern_t)(KArgs);
extern "C" void kernel_launch(void* const* d_in, const int* in_sizes, int n_in, void* d_out, int out_size, void* d_ws, size_t ws_size, hipStream_t stream) {
    static int grid = 0;
#if MK_PER_PHASE
    static const kern_t kerns[8] = {trunk_fwd<0x1>, trunk_fwd<0x2>, trunk_fwd<0x4>, trunk_fwd<0x8>, trunk_fwd<0x10>, trunk_fwd<0x20>, trunk_fwd<0xC0>, trunk_fwd<0x100>};
    constexpr int NK = 8;
#else
    static const kern_t kerns[1] = {trunk_fwd<0x1ff>};
    constexpr int NK = 1;
#endif
    if (grid == 0) {
        if (n_in != 26 || ws_size < WS_END) { fprintf(stderr, "kernel_launch: need 26 inputs and %zu bytes of workspace; got %d, %zu\n", (size_t)WS_END, n_in, ws_size); grid = -1; return; }
        int dev = 0, cus = 0, per_cu = 0;
        if (hipGetDevice(&dev) != hipSuccess || hipDeviceGetAttribute(&cus, hipDeviceAttributeMultiprocessorCount, dev) != hipSuccess) { grid = -1; return; }
        for (int i = 0; i < NK; ++i) {
            if (hipFuncSetAttribute((const void*)kerns[i], hipFuncAttributeMaxDynamicSharedMemorySize, LDS_BYTES) != hipSuccess) { fprintf(stderr, "kernel_launch: hipFuncSetAttribute failed\n"); grid = -1; return; }
            if (hipOccupancyMaxActiveBlocksPerMultiprocessor(&per_cu, (const void*)kerns[i], 512, LDS_BYTES) != hipSuccess || per_cu < 1) { fprintf(stderr, "kernel_launch: occupancy query says %d\n", per_cu); (void)hipGetLastError(); grid = -1; return; }
        }
        grid = cus * 1;
    }
    if (grid < 0) return;
    if (hipMemsetAsync((char*)d_ws + WS_CTL, 0, 16384, stream) != hipSuccess) { fprintf(stderr, "kernel_launch: memset failed\n"); return; }
    KArgs a{};
    for (int i = 0; i < 26; ++i) a.in[i] = (const float*)d_in[i];
    a.out = (float*)d_out; a.ws = (unsigned char*)d_ws;
#if MK_PER_PHASE
    for (int ph = 0; ph < N_PHASES; ++ph) {
        a.ph_lo = ph; a.ph_hi = ph + 1;
        int ki;
        if (ph < 2) ki = ph;
        else { const int k = (ph - 2) % 11; ki = (k == 0 || k == 8) ? 2 : (k == 1 || k == 9 || k == 6) ? 3 : (k == 2 || k == 7 || k == 10) ? 4 : (k == 3) ? 5 : (k == 4) ? 6 : 7; }
        hipLaunchKernelGGL(kerns[ki], dim3(grid), dim3(512), LDS_BYTES, stream, a);
    }
#else
    a.ph_lo = 0; a.ph_hi = N_PHASES;
    void* args[] = {&a};
    hipError_t e = hipLaunchCooperativeKernel((const void*)kerns[0], dim3(grid), dim3(512), args, LDS_BYTES, stream);
    if (e != hipSuccess) fprintf(stderr, "cooperative launch failed: %s (grid %d)\n", hipGetErrorString(e), grid);
#endif
}
```

```cpp
#include <hip/hip_runtime.h>
#include <hip/hip_cooperative_groups.h>
#include <cstdio>
#include <cstdint>
namespace cg = cooperative_groups;

#ifndef MK_PER_PHASE
#define MK_PER_PHASE 0
#endif

#define DI __device__ __forceinline__
#define LAS __attribute__((address_space(3)))
typedef unsigned short bf16_t;
typedef short bf16x8 __attribute__((ext_vector_type(8)));
typedef short s16x4 __attribute__((ext_vector_type(4)));
typedef float f32x4 __attribute__((ext_vector_type(4)));
typedef float f32x16 __attribute__((ext_vector_type(16)));
typedef unsigned u32x4 __attribute__((ext_vector_type(4)));
typedef unsigned u32x2 __attribute__((ext_vector_type(2)));
typedef __bf16 bf16x2_t __attribute__((ext_vector_type(2)));
typedef float f32x2_t __attribute__((ext_vector_type(2)));

DI unsigned pk2(float lo, float hi) { f32x2_t v = {lo, hi}; bf16x2_t b = __builtin_convertvector(v, bf16x2_t); return __builtin_bit_cast(unsigned, b); }
DI bf16_t f2bf(float f) { return (bf16_t)(pk2(f, 0.f) & 0xffffu); }
DI int otid() { int t = threadIdx.x; asm volatile("" : "+v"(t)); return t; }
DI float wave_sum(float v) { v += __shfl_xor(v, 1); v += __shfl_xor(v, 2); v += __shfl_xor(v, 4); v += __shfl_xor(v, 8); v += __shfl_xor(v, 16); v += __shfl_xor(v, 32); return v; }

constexpr int T = 12288, TP = 4096, D = 1024, FF = 2816, NIN = 2560, LKS = 4352;
constexpr float ALPHA = 1.41421356237f;
constexpr float QSCALE = 0.125f * 1.44269504089f;

constexpr size_t al256(size_t x) { return (x + 255) & ~(size_t)255; }
constexpr size_t WS_CTL = 0;
constexpr size_t WS_MOD = 16384;
constexpr size_t WS_ROPE = WS_MOD + al256(2 * 3 * 9216 * 4);
constexpr size_t WS_DFTP = WS_ROPE + 8192;
constexpr size_t WS_DFTS = WS_DFTP + 256 * 512 * 2;
constexpr size_t WS_WGU1 = WS_DFTS + (size_t)4096 * 8192 * 2;
constexpr size_t WS_WD1 = WS_WGU1 + (size_t)5632 * 1024 * 2;
constexpr size_t WS_WIN = WS_WD1 + (size_t)1024 * 2816 * 2;
constexpr size_t WS_WOUT = WS_WIN + (size_t)2560 * 1024 * 2;
constexpr size_t WS_WGU2 = WS_WOUT + (size_t)1024 * 1024 * 2;
constexpr size_t WS_WD2 = WS_WGU2 + (size_t)5632 * 1024 * 2;
constexpr size_t WS_X = WS_WD2 + (size_t)1024 * 2816 * 2;
constexpr size_t WS_KAS = WS_X + (size_t)T * D * 4;
constexpr size_t WS_VAS = WS_KAS + (size_t)2 * 2 * LKS * 64 * 2;
constexpr size_t WS_KBS = WS_VAS + (size_t)2 * 2 * LKS * 64 * 2;
constexpr size_t WS_VBS = WS_KBS + (size_t)2 * 8 * LKS * 64 * 2;
constexpr size_t WS_H = WS_VBS + (size_t)2 * 4 * 128 * LKS * 2;
constexpr size_t WS_R = WS_H + (size_t)T * D * 2;
constexpr size_t WS_ACT = WS_R;
constexpr size_t WS_QA = WS_R;
constexpr size_t WS_QB = WS_QA + (size_t)T * 256 * 2;
constexpr size_t WS_KAP = WS_QB + (size_t)T * 512 * 2;
constexpr size_t WS_VAP = WS_KAP + (size_t)16 * 2 * 256 * 64 * 2;
constexpr size_t WS_KBP = WS_VAP + (size_t)16 * 2 * 256 * 64 * 2;
constexpr size_t WS_VBP = WS_KBP + (size_t)16 * 8 * 256 * 64 * 2;
constexpr size_t WS_UTP = WS_VBP + (size_t)16 * 4 * 128 * 256 * 2;
constexpr size_t WS_UTS = WS_UTP + (size_t)4096 * 512 * 2;
constexpr size_t WS_MIX = WS_UTS + (size_t)512 * 8192 * 2;
constexpr size_t WS_FACC = WS_MIX + (size_t)T * D * 2;
constexpr size_t WS_REND = WS_FACC + (size_t)T * 256 * 4;
constexpr size_t WS_END = (WS_REND > WS_ACT + (size_t)T * FF * 2) ? WS_REND : WS_ACT + (size_t)T * FF * 2;

constexpr int LDS_RING = 131072, MISC_OFF = LDS_RING, LDS_BYTES = LDS_RING + 256;

struct KArgs { const float* in[26]; float* out; unsigned char* ws; int ph_lo, ph_hi; };
typedef const KArgs __attribute__((address_space(4)))* KP;

namespace pg8 {
constexpr int BM = 256, BK = 64, HALF = 128, HTB = HALF * BK * 2, STAGE_BYTES = 8 * HTB, NXCD = 8, WGM = 8;
DI int lds_byte(int r, int c) { const int st = (r >> 4) * 2 + (c >> 5), rr = r & 15, cc = c & 31, ob = rr * 64 + cc * 2; return st * 1024 + (ob ^ (((ob >> 9) & 1) << 5)); }
DI void stage_rc(int b, int& R, int& C) { const int st = b / 1024, sb = b % 1024, swz = sb ^ (((sb >> 9) & 1) << 5); R = (st >> 1) * 16 + swz / 64; C = (st & 1) * 32 + (swz % 64) / 2; }
DI int perm32(int rho) { const int n = rho >> 4, i = rho & 15; return 8 * (i >> 2) + 4 * n + (i & 3); }

struct Unit { int pm, pn, ko; };
struct Gemm { const bf16_t* A; const bf16_t* Bt; int ld, K; };

struct StaticOrder {
    int nM, nN, nwg, G, c;
    DI void init(int M, int N, int G_, int c_) { nM = M / BM; nN = N / BM; nwg = nM * nN; G = G_; c = c_; }
    DI bool next(int i, Unit& u) const {
        const long L = (long)i * G + c; if (L >= nwg) return false;
        int wgid = (int)L; { const int q = nwg / NXCD, r = nwg % NXCD, xcd = wgid % NXCD, off = wgid / NXCD; wgid = (xcd < r ? xcd * (q + 1) : r * (q + 1) + (xcd - r) * q) + off; }
        const int nig = WGM * nN, gid = wgid / nig, fm = gid * WGM, gsz = (nM - fm) < WGM ? (nM - fm) : WGM;
        u.pm = fm + ((wgid % nig) % gsz); u.pn = (wgid % nig) / gsz; u.ko = 0; return true;
    }
};
struct FourOrder {
    int G, c, total, mode;
    DI bool next(int i, Unit& u) const {
        const int L = i * G + c - (mode ? 32 : 0); if (L < 0 || L >= total) return false;
        u.ko = 0;
        if (mode == 0) { u.pm = L >> 1; u.pn = L & 1; } else { u.pm = 0; u.pn = L; }
        return true;
    }
};

template <class Epi, class Sched, bool ALIGN_EPI, bool SP2>
DI void gemm_phase(LAS unsigned char* lds, const Gemm g, const Sched& S, const Epi& E) {
    int tid = threadIdx.x; asm volatile("" : "+v"(tid));
    const int wid = __builtin_amdgcn_readfirstlane(tid >> 6), lane = tid & 63, wr = wid >> 2, wc = wid & 3, fr = lane & 15, fq = lane >> 4;
    const int K = g.K, nt = K / BK, ld = g.ld;
    unsigned voffA[2], voffB[2];
#pragma unroll
    for (int i = 0; i < 2; ++i) { int R, C; stage_rc(tid * 16 + i * 8192, R, C); const int Rb = (R & ~31) + perm32(R & 31);
        voffA[i] = (unsigned)(R * ld + C) * 2u; voffB[i] = (unsigned)(Rb * ld + C) * 2u; }
    const size_t kstep = (size_t)(BK * 2);
    const size_t hstep = (size_t)HALF * ld * 2;
    const size_t tstep = 2 * hstep;
    const unsigned ldsw = (unsigned)wid * 1024u;
    const int aoff = lds_byte(wr * 64 + fr, fq * 8), boff = lds_byte(wc * 32 + fr, fq * 8);
#define PG8_SA(b, h) (((b) * 2 + (h)) * HTB)
#define PG8_SB(b, h) ((4 + (b) * 2 + (h)) * HTB)
#define PG8_STAGE(bufoff, gbase, voff) do { _Pragma("unroll") for (int _i = 0; _i < 2; ++_i) \
        __builtin_amdgcn_global_load_lds((const unsigned*)((const char*)(gbase) + (voff)[_i]), (LAS unsigned*)(lds + (bufoff) + ldsw + _i * 8192), 16, 0, 0); } while (0)
#define PG8_LDA(dst, b, h) do { _Pragma("unroll") for (int m = 0; m < 4; ++m) _Pragma("unroll") for (int k = 0; k < 2; ++k) dst[m][k] = *(const LAS bf16x8*)(lds + PG8_SA(b, h) + aoff + m * 2048 + k * 1024); } while (0)
#define PG8_LDB(dst, b, h) do { _Pragma("unroll") for (int n = 0; n < 2; ++n) _Pragma("unroll") for (int k = 0; k < 2; ++k) dst[n][k] = *(const LAS bf16x8*)(lds + PG8_SB(b, h) + boff + n * 2048 + k * 1024); } while (0)
#define PG8_MMA(ai, bj, At, Bt) do { __builtin_amdgcn_s_setprio(1); _Pragma("unroll") for (int m = 0; m < 4; ++m) _Pragma("unroll") for (int n = 0; n < 2; ++n) _Pragma("unroll") for (int k = 0; k < 2; ++k) \
        acc[ai][bj][m][n] = __builtin_amdgcn_mfma_f32_16x16x32_bf16(Bt[n][k], At[m][k], acc[ai][bj][m][n], 0, 0, 0); __builtin_amdgcn_s_setprio(0); } while (0)
#define PG8_WAIT_V(n) asm volatile("s_waitcnt vmcnt(" #n ")" ::: "memory")
#define PG8_WAIT_L(n) asm volatile("s_waitcnt lgkmcnt(" #n ")" ::: "memory")
#define PG8_BAR __builtin_amdgcn_s_barrier()
#define PG8_SCHED __builtin_amdgcn_sched_barrier(0)
    Unit cur, nxt; int ui = 0;
    if (!S.next(0, cur)) return;
    f32x4 acc[2][2][4][2];
#pragma unroll
    for (int a = 0; a < 2; ++a)
#pragma unroll
        for (int b = 0; b < 2; ++b)
#pragma unroll
            for (int m = 0; m < 4; ++m)
#pragma unroll
                for (int n = 0; n < 2; ++n) acc[a][b][m][n] = (f32x4){0.f, 0.f, 0.f, 0.f};
    bf16x8 At[4][2], B0[2][2], B1[2][2];
    const char* cA = (const char*)g.A + (size_t)cur.pm * tstep + (size_t)cur.ko * 2; const char* cB = (const char*)g.Bt + (size_t)cur.pn * tstep + (size_t)cur.ko * 2;
    if constexpr (SP2) {
        PG8_STAGE(PG8_SB(0, 0), cB, voffB); PG8_STAGE(PG8_SB(0, 1), cB + hstep, voffB); PG8_STAGE(PG8_SA(0, 0), cA, voffA); PG8_STAGE(PG8_SA(0, 1), cA + hstep, voffA);
        if (wr == 1) PG8_BAR;
        PG8_WAIT_V(2); PG8_BAR;
        PG8_STAGE(PG8_SB(1, 0), cB + kstep, voffB); PG8_STAGE(PG8_SA(1, 0), cA + kstep, voffA); PG8_STAGE(PG8_SB(1, 1), cB + hstep + kstep, voffB);
        PG8_WAIT_V(6); PG8_BAR;
    } else {
        PG8_STAGE(PG8_SB(0, 0), cB, voffB); PG8_STAGE(PG8_SA(0, 0), cA, voffA); PG8_STAGE(PG8_SB(0, 1), cB + hstep, voffB); PG8_STAGE(PG8_SA(0, 1), cA + hstep, voffA);
        if (wr == 1) PG8_BAR;
        PG8_WAIT_V(4); PG8_BAR;
        PG8_STAGE(PG8_SB(1, 0), cB + kstep, voffB); PG8_STAGE(PG8_SA(1, 0), cA + kstep, voffA); PG8_STAGE(PG8_SB(1, 1), cB + hstep + kstep, voffB);
        PG8_WAIT_V(6); PG8_BAR;
    }
    for (;;) {
        const bool has_next = S.next(ui + 1, nxt);
        const char* nA = has_next ? (const char*)g.A + (size_t)nxt.pm * tstep + (size_t)nxt.ko * 2 : cA; const char* nB = has_next ? (const char*)g.Bt + (size_t)nxt.pn * tstep + (size_t)nxt.ko * 2 : cB;
        for (int t = 0; t < nt; t += 2) {
            const bool last = (t == nt - 2);
            const char* a1 = cA + (size_t)(t + 1) * kstep;
            const char* a2 = last ? nA : cA + (size_t)(t + 2) * kstep; const char* b2 = last ? nB : cB + (size_t)(t + 2) * kstep;
            const char* a3 = a2 + kstep; const char* b3 = b2 + kstep;
            if constexpr (SP2) {
            PG8_LDB(B0, 0, 0); PG8_LDB(B1, 0, 1); PG8_SCHED; PG8_LDA(At, 0, 0); PG8_STAGE(PG8_SA(1, 1), a1 + hstep, voffA);
            PG8_WAIT_V(8); PG8_WAIT_L(0); PG8_BAR; PG8_MMA(0, 0, At, B0); PG8_MMA(0, 1, At, B1); PG8_BAR; PG8_SCHED;
            PG8_LDA(At, 0, 1); PG8_STAGE(PG8_SB(0, 0), b2, voffB); PG8_STAGE(PG8_SB(0, 1), b2 + hstep, voffB); PG8_STAGE(PG8_SA(0, 0), a2, voffA);
            PG8_WAIT_V(8); PG8_WAIT_L(0); PG8_BAR; PG8_MMA(1, 0, At, B0); PG8_MMA(1, 1, At, B1); PG8_BAR; PG8_SCHED;
            PG8_LDB(B0, 1, 0); PG8_LDB(B1, 1, 1); PG8_SCHED; PG8_LDA(At, 1, 0); PG8_STAGE(PG8_SA(0, 1), a2 + hstep, voffA);
            PG8_WAIT_V(8); PG8_WAIT_L(0); PG8_BAR; PG8_MMA(0, 0, At, B0); PG8_MMA(0, 1, At, B1); PG8_BAR; PG8_SCHED;
            PG8_LDA(At, 1, 1); PG8_STAGE(PG8_SB(1, 0), b3, voffB); PG8_STAGE(PG8_SB(1, 1), b3 + hstep, voffB); PG8_STAGE(PG8_SA(1, 0), a3, voffA);
            PG8_WAIT_V(8); PG8_WAIT_L(0); PG8_BAR; PG8_MMA(1, 0, At, B0); PG8_MMA(1, 1, At, B1); PG8_BAR; PG8_SCHED;
            } else {
            PG8_LDB(B0, 0, 0); PG8_SCHED; PG8_LDA(At, 0, 0); PG8_STAGE(PG8_SA(1, 1), a1 + hstep, voffA);
            PG8_WAIT_L(8); PG8_BAR; PG8_WAIT_L(0); PG8_MMA(0, 0, At, B0); PG8_BAR; PG8_SCHED;
            PG8_LDB(B1, 0, 1); PG8_STAGE(PG8_SB(0, 0), b2, voffB);
            PG8_BAR; PG8_WAIT_L(0); PG8_MMA(0, 1, At, B1); PG8_BAR;
            PG8_LDA(At, 0, 1); PG8_STAGE(PG8_SA(0, 0), a2, voffA);
            PG8_BAR; PG8_WAIT_L(0); PG8_MMA(1, 0, At, B0); PG8_BAR; PG8_SCHED;
            PG8_STAGE(PG8_SB(0, 1), b2 + hstep, voffB);
            PG8_WAIT_V(6); PG8_BAR; PG8_MMA(1, 1, At, B1); PG8_BAR;
            PG8_LDB(B0, 1, 0); PG8_SCHED; PG8_LDA(At, 1, 0); PG8_STAGE(PG8_SA(0, 1), a2 + hstep, voffA);
            PG8_WAIT_L(8); PG8_BAR; PG8_WAIT_L(0); PG8_MMA(0, 0, At, B0); PG8_BAR; PG8_SCHED;
            PG8_LDB(B1, 1, 1); PG8_STAGE(PG8_SB(1, 0), b3, voffB);
            PG8_BAR; PG8_WAIT_L(0); PG8_MMA(0, 1, At, B1); PG8_BAR;
            PG8_LDA(At, 1, 1); PG8_STAGE(PG8_SA(1, 0), a3, voffA);
            PG8_BAR; PG8_WAIT_L(0); PG8_MMA(1, 0, At, B0); PG8_BAR; PG8_SCHED;
            PG8_STAGE(PG8_SB(1, 1), b3 + hstep, voffB);
            PG8_WAIT_V(6); PG8_BAR; PG8_MMA(1, 1, At, B1); PG8_BAR;
            }
        }
        if constexpr (ALIGN_EPI) { if (wr == 0) PG8_BAR; }
        E(acc, cur, wr, wc, fr, fq);
        if (!has_next) break;
#pragma unroll
        for (int a = 0; a < 2; ++a)
#pragma unroll
            for (int b = 0; b < 2; ++b)
#pragma unroll
                for (int m = 0; m < 4; ++m)
#pragma unroll
                    for (int n = 0; n < 2; ++n) acc[a][b][m][n] = (f32x4){0.f, 0.f, 0.f, 0.f};
        cur = nxt; cA = nA; cB = nB; ++ui;
        if constexpr (ALIGN_EPI) { if (wr == 1) PG8_BAR; }
    }
    PG8_WAIT_V(0);
    if constexpr (!ALIGN_EPI) { if (wr == 0) PG8_BAR; }
    PG8_BAR;
#undef PG8_SA
#undef PG8_SB
#undef PG8_STAGE
#undef PG8_LDA
#undef PG8_LDB
#undef PG8_MMA
#undef PG8_WAIT_V
#undef PG8_WAIT_L
#undef PG8_BAR
#undef PG8_SCHED
}

DI int mod_of_row_tile(int pm) { return pm < 16 ? 0 : 1 + ((pm - 16) >> 4); }

struct EpiGU {
    bf16_t* ACT;
    DI void operator()(const f32x4 (&acc)[2][2][4][2], const Unit& u, int wr, int wc, int fr_in, int fq_in) const {
        int fr = fr_in, fq = fq_in; asm volatile("" : "+v"(fr), "+v"(fq));
#pragma unroll
        for (int ai = 0; ai < 2; ++ai)
#pragma unroll
            for (int m = 0; m < 4; ++m) {
                const int row = u.pm * 256 + ai * 128 + wr * 64 + m * 16 + fr;
                float o[8];
#pragma unroll
                for (int n = 0; n < 2; ++n)
#pragma unroll
                    for (int j = 0; j < 4; ++j) { const float gg = acc[ai][0][m][n][j], uu = acc[ai][1][m][n][j];
                        const float sg = gg * __builtin_amdgcn_rcpf(1.f + __builtin_amdgcn_exp2f(-1.44269504089f * gg)); o[n * 4 + j] = sg * uu; }
                u32x4 w; w.x = pk2(o[0], o[1]); w.y = pk2(o[2], o[3]); w.z = pk2(o[4], o[5]); w.w = pk2(o[6], o[7]);
                *(u32x4*)(ACT + (size_t)row * FF + u.pn * 128 + wc * 32 + fq * 8) = w;
            }
    }
};

struct EpiRes {
    const float* srcP; const float* srcS; float* X; const float* gate; float coef;
    DI void operator()(const f32x4 (&acc)[2][2][4][2], const Unit& u, int wr, int wc, int fr_in, int fq_in) const {
        int fr = fr_in, fq = fq_in; asm volatile("" : "+v"(fr), "+v"(fq));
        const float* gt = gate + mod_of_row_tile(u.pm) * 9216;
        f32x4 gv[2][2];
#pragma unroll
        for (int bj = 0; bj < 2; ++bj)
#pragma unroll
            for (int n = 0; n < 2; ++n) gv[bj][n] = *(const f32x4*)(gt + u.pn * 256 + bj * 128 + wc * 32 + fq * 8 + n * 4) * coef;
#pragma unroll
        for (int ai = 0; ai < 2; ++ai)
#pragma unroll
            for (int m = 0; m < 4; ++m) {
                const int row = u.pm * 256 + ai * 128 + wr * 64 + m * 16 + fr;
                const float* sp = (row < TP) ? srcP + (size_t)row * D : srcS + (size_t)(row - TP) * D;
#pragma unroll
                for (int bj = 0; bj < 2; ++bj)
#pragma unroll
                    for (int n = 0; n < 2; ++n) { const int c = u.pn * 256 + bj * 128 + wc * 32 + fq * 8 + n * 4;
                        const f32x4 xv = *(const f32x4*)(sp + c);
                        *(f32x4*)(X + (size_t)row * D + c) = xv * ALPHA + gv[bj][n] * acc[ai][bj][m][n]; }
            }
    }
};

struct EpiFour {
    bf16_t* MIX; int mode;
    DI void operator()(const f32x4 (&acc)[2][2][4][2], const Unit& u, int wr, int wc, int fr_in, int fq_in) const {
        int fr = fr_in, fq = fq_in; asm volatile("" : "+v"(fr), "+v"(fq));
        const int tok0 = ((mode == 0) ? TP + u.pn * 4096 + u.pm * 256 : u.pn * 256) + wr * 64 + fr;
        bf16_t* p0 = MIX + (size_t)tok0 * D + 768 + wc * 32 + fq * 8;
#pragma unroll
        for (int ai = 0; ai < 2; ++ai)
#pragma unroll
            for (int m = 0; m < 4; ++m) {
                bf16_t* p = p0 + (size_t)(ai * 128 + m * 16) * D;
#pragma unroll
                for (int bj = 0; bj < 2; ++bj) {
                    u32x4 w; w.x = pk2(acc[ai][bj][m][0][0], acc[ai][bj][m][0][1]); w.y = pk2(acc[ai][bj][m][0][2], acc[ai][bj][m][0][3]);
                    w.z = pk2(acc[ai][bj][m][1][0], acc[ai][bj][m][1][1]); w.w = pk2(acc[ai][bj][m][1][2], acc[ai][bj][m][1][3]);
                    *(u32x4*)(p + bj * 128) = w;
                }
            }
    }
};

struct EpiIn {
    int l; const float* g_qa; const float* g_ka; float* out; unsigned char* ws;
    DI void operator()(const f32x4 (&acc)[2][2][4][2], const Unit& u, int wr, int wc, int fr_in, int fq_in) const {
        int fr = fr_in, fq = fq_in; asm volatile("" : "+v"(fr), "+v"(fq));
        const int t = u.pn; const bool prompt = u.pm < 16;
        const float* rope = (const float*)(ws + WS_ROPE);
        bf16_t* const QA = (bf16_t*)(ws + WS_QA); bf16_t* const QB = (bf16_t*)(ws + WS_QB); bf16_t* const KAS = (bf16_t*)(ws + WS_KAS); bf16_t* const VAS = (bf16_t*)(ws + WS_VAS);
        bf16_t* const KBS = (bf16_t*)(ws + WS_KBS); bf16_t* const VBS = (bf16_t*)(ws + WS_VBS); bf16_t* const KAP = (bf16_t*)(ws + WS_KAP); bf16_t* const VAP = (bf16_t*)(ws + WS_VAP);
        bf16_t* const KBP = (bf16_t*)(ws + WS_KBP); bf16_t* const VBP = (bf16_t*)(ws + WS_VBP); bf16_t* const UTP = (bf16_t*)(ws + WS_UTP); bf16_t* const UTS = (bf16_t*)(ws + WS_UTS);
        if (t >= 8) {
            const int cs = t - 8;
#pragma unroll
            for (int ai = 0; ai < 2; ++ai)
#pragma unroll
                for (int m = 0; m < 4; ++m) {
                    const int row = u.pm * 256 + ai * 128 + wr * 64 + m * 16 + fr;
                    bf16_t* base; size_t pitch;
                    if (prompt) { base = UTP + (size_t)(row >> 8) * 256 * 512 + cs * 256 + (row & 255); pitch = 512; }
                    else { const int rs = row - TP; base = UTS + (size_t)(rs >> 12) * 256 * 8192 + cs * 4096 + (rs & 4095); pitch = 8192; }
#pragma unroll
                    for (int bj = 0; bj < 2; ++bj)
#pragma unroll
                        for (int n = 0; n < 2; ++n)
#pragma unroll
                            for (int j = 0; j < 4; ++j) base[(size_t)(bj * 128 + wc * 32 + fq * 8 + n * 4 + j) * pitch] = f2bf(acc[ai][bj][m][n][j]);
                    __builtin_amdgcn_sched_barrier(0);
                }
            return;
        }
        const bool do_norm = (t == 0) || (t == 1 && wc < 2);
        const bool is_v = (t == 1 && wc >= 2) || t >= 6;
        const bool is_q = (t == 0) || t == 2 || t == 3;
        const bool do_rope = !prompt && !is_v;
        const float* gp = (t == 0 ? g_qa : g_ka) + l * 64 + fq * 8;
#pragma unroll
        for (int ai = 0; ai < 2; ++ai)
#pragma unroll
            for (int m = 0; m < 4; ++m) {
                const int row = u.pm * 256 + ai * 128 + wr * 64 + m * 16 + fr;
                int b, pos;
                if (prompt) { b = row >> 8; pos = row & 255; } else { const int rs = row - TP; b = rs >> 12; pos = rs & 4095; }
                float v[2][8];
#pragma unroll
                for (int bj = 0; bj < 2; ++bj)
#pragma unroll
                    for (int n = 0; n < 2; ++n)
#pragma unroll
                        for (int j = 0; j < 4; ++j) v[bj][n * 4 + j] = acc[ai][bj][m][n][j];
                if (do_norm) {
                    float ss = 0.f;
#pragma unroll
                    for (int bj = 0; bj < 2; ++bj)
#pragma unroll
                        for (int e = 0; e < 8; ++e) ss += v[bj][e] * v[bj][e];
                    ss += __shfl_xor(ss, 16); ss += __shfl_xor(ss, 32);
                    const float rs_ = rsqrtf(ss * (1.f / 64.f) + 1e-6f);
#pragma unroll
                    for (int bj = 0; bj < 2; ++bj)
#pragma unroll
                        for (int e = 0; e < 8; ++e) v[bj][e] = v[bj][e] * rs_ * gp[bj * 32 + e];
                }
                if (prompt && !is_q) {
                    float* op;
                    if (t == 1) op = out + (wc < 2 ? 12582912 : 13631488) + ((size_t)((b * 2 + l) * 256 + pos)) * 128 + (wc & 1) * 64;
                    else if (t < 6) op = out + 14680064 + ((size_t)((b * 2 + l) * 256 + pos)) * 512 + ((t - 4) * 4 + wc) * 64;
                    else op = out + 18874368 + ((size_t)((b * 2 + l) * 256 + pos)) * 512 + (t - 6) * 256 + wc * 64;
#pragma unroll
                    for (int bj = 0; bj < 2; ++bj) {
                        *(f32x4*)(op + bj * 32 + fq * 8) = (f32x4){v[bj][0], v[bj][1], v[bj][2], v[bj][3]};
                        *(f32x4*)(op + bj * 32 + fq * 8 + 4) = (f32x4){v[bj][4], v[bj][5], v[bj][6], v[bj][7]};
                    }
                }
                if (do_rope) {
#pragma unroll
                    for (int bj = 0; bj < 2; ++bj) {
                        const int pv_ = bj == 0 ? (pos >> 6) : (pos & 63);
                        const float* rp = rope + (pv_ * 16 + (fq & 1) * 8) * 2;
#pragma unroll
                        for (int e = 0; e < 8; ++e) {
                            const float cc = rp[2 * e], sn = rp[2 * e + 1];
                            const float other = __shfl_xor(v[bj][e], 32);
                            v[bj][e] = v[bj][e] * cc + (fq < 2 ? -other : other) * sn;
                        }
                    }
                }
                if (is_v) {
                    bf16_t* base; size_t pitch;
                    if (t == 1) { const int kvh = wc - 2; if (prompt) { base = VAP + (size_t)(b * 2 + kvh) * 64 * 256 + pos; pitch = 256; } else { base = VAS + (size_t)(b * 2 + kvh) * 64 * LKS + 256 + pos; pitch = LKS; } }
                    else { const int hh = (t - 6) * 2 + (wc >> 1); const int d0 = (wc & 1) * 64;
                        if (prompt) { base = VBP + ((size_t)(b * 4 + hh) * 128 + d0) * 256 + pos; pitch = 256; } else { base = VBS + ((size_t)(b * 4 + hh) * 128 + d0) * LKS + 256 + pos; pitch = LKS; } }
#pragma unroll
                    for (int bj = 0; bj < 2; ++bj)
#pragma unroll
                        for (int e = 0; e < 8; ++e) base[(size_t)(bj * 32 + fq * 8 + e) * pitch] = f2bf(v[bj][e]);
                } else {
                    bf16_t* op;
                    if (t == 0) op = QA + (size_t)row * 256 + wc * 64;
                    else if (t == 1) op = prompt ? KAP + ((size_t)(b * 2 + wc) * 256 + pos) * 64 : KAS + ((size_t)(b * 2 + wc) * LKS + 256 + pos) * 64;
                    else if (t < 4) op = QB + (size_t)row * 512 + ((t - 2) * 4 + wc) * 64;
                    else { const int s = (t - 4) * 4 + wc; op = prompt ? KBP + ((size_t)(b * 8 + s) * 256 + pos) * 64 : KBS + ((size_t)(b * 8 + s) * LKS + 256 + pos) * 64; }
                    const float sc = is_q ? QSCALE : 1.f;
#pragma unroll
                    for (int bj = 0; bj < 2; ++bj) {
                        u32x4 w; w.x = pk2(v[bj][0] * sc, v[bj][1] * sc); w.y = pk2(v[bj][2] * sc, v[bj][3] * sc); w.z = pk2(v[bj][4] * sc, v[bj][5] * sc); w.w = pk2(v[bj][6] * sc, v[bj][7] * sc);
                        *(u32x4*)(op + bj * 32 + fq * 8) = w;
                    }
                }
                __builtin_amdgcn_sched_barrier(0);
            }
    }
};
}

template <int DV>
DI void attn_unit(const bf16_t* __restrict__ Q, int qpitch, const bf16_t* __restrict__ K, const bf16_t* __restrict__ VT, int Lk, bf16_t* __restrict__ O, int opitch, LAS unsigned char* lds) {
    constexpr int KROW = 144, VROW = 136, KBYTES = 64 * KROW, VBYTES = DV * VROW, BUF = KBYTES + VBYTES, NV = DV / 64, NDB = DV / 32;
    int tid = threadIdx.x; asm volatile("" : "+v"(tid));
    const int wave = tid >> 6, lane = tid & 63, r = lane & 31, h = lane >> 5;
    bf16x8 qf[4];
    { const bf16_t* qrow = Q + (size_t)(wave * 32 + r) * qpitch;
#pragma unroll
      for (int s = 0; s < 4; ++s) qf[s] = *(const bf16x8*)(qrow + 16 * s + 8 * h); }
    f32x16 o[NDB];
#pragma unroll
    for (int db = 0; db < NDB; ++db)
#pragma unroll
        for (int i = 0; i < 16; ++i) o[db][i] = 0.f;
    float mrun = -1e30f, lrun = 0.f;
    const int skey = tid >> 3, sch = tid & 7;
    const bf16_t* kg = K + (size_t)skey * 64 + sch * 8;
    const bf16_t* vg = VT + (size_t)skey * Lk + sch * 8;
    const unsigned kwoff = skey * KROW + sch * 16, vwoff = KBYTES + skey * VROW + sch * 16;
    u32x4 kreg, vreg[NV];
    kreg = *(const u32x4*)kg;
#pragma unroll
    for (int i = 0; i < NV; ++i) vreg[i] = *(const u32x4*)(vg + (size_t)(64 * i) * Lk);
    *(LAS u32x4*)(lds + kwoff) = kreg;
#pragma unroll
    for (int i = 0; i < NV; ++i) { *(LAS u32x2*)(lds + vwoff + i * 64 * VROW) = (u32x2){vreg[i].x, vreg[i].y}; *(LAS u32x2*)(lds + vwoff + i * 64 * VROW + 8) = (u32x2){vreg[i].z, vreg[i].w}; }
    __syncthreads();
    const int nt = Lk >> 6;
    for (int kt = 0; kt < nt; ++kt) {
        LAS unsigned char* cb = lds + (kt & 1) * BUF;
        LAS unsigned char* nb = lds + ((kt & 1) ^ 1) * BUF;
        const bool more = kt + 1 < nt;
        if (more) {
            kreg = *(const u32x4*)(kg + (size_t)(kt + 1) * 64 * 64);
#pragma unroll
            for (int i = 0; i < NV; ++i) vreg[i] = *(const u32x4*)(vg + (size_t)(64 * i) * Lk + (kt + 1) * 64);
        }
        f32x16 s0, s1;
#pragma unroll
        for (int i = 0; i < 16; ++i) { s0[i] = 0.f; s1[i] = 0.f; }
#pragma unroll
        for (int s = 0; s < 4; ++s) {
            const bf16x8 k0 = *(const LAS bf16x8*)(cb + r * KROW + (16 * s + 8 * h) * 2);
            const bf16x8 k1 = *(const LAS bf16x8*)(cb + (32 + r) * KROW + (16 * s + 8 * h) * 2);
            s0 = __builtin_amdgcn_mfma_f32_32x32x16_bf16(k0, qf[s], s0, 0, 0, 0);
            s1 = __builtin_amdgcn_mfma_f32_32x32x16_bf16(k1, qf[s], s1, 0, 0, 0);
        }
        float mx = s0[0];
#pragma unroll
        for (int i = 1; i < 16; ++i) mx = fmaxf(mx, s0[i]);
#pragma unroll
        for (int i = 0; i < 16; ++i) mx = fmaxf(mx, s1[i]);
        mx = fmaxf(mx, __shfl_xor(mx, 32));
        const float mnew = fmaxf(mrun, mx);
        const float alpha = __builtin_amdgcn_exp2f(mrun - mnew);
        mrun = mnew;
        float rs = 0.f;
#pragma unroll
        for (int i = 0; i < 16; ++i) { s0[i] = __builtin_amdgcn_exp2f(s0[i] - mnew); s1[i] = __builtin_amdgcn_exp2f(s1[i] - mnew); rs += s0[i] + s1[i]; }
        lrun = lrun * alpha + rs;
#pragma unroll
        for (int db = 0; db < NDB; ++db)
#pragma unroll
            for (int i = 0; i < 16; ++i) o[db][i] *= alpha;
#pragma unroll
        for (int kb = 0; kb < 2; ++kb)
#pragma unroll
            for (int s2 = 0; s2 < 2; ++s2) {
                u32x4 pw;
                if (kb == 0) { pw.x = pk2(s0[8 * s2 + 0], s0[8 * s2 + 1]); pw.y = pk2(s0[8 * s2 + 2], s0[8 * s2 + 3]); pw.z = pk2(s0[8 * s2 + 4], s0[8 * s2 + 5]); pw.w = pk2(s0[8 * s2 + 6], s0[8 * s2 + 7]); }
                else { pw.x = pk2(s1[8 * s2 + 0], s1[8 * s2 + 1]); pw.y = pk2(s1[8 * s2 + 2], s1[8 * s2 + 3]); pw.z = pk2(s1[8 * s2 + 4], s1[8 * s2 + 5]); pw.w = pk2(s1[8 * s2 + 6], s1[8 * s2 + 7]); }
                const bf16x8 pf = __builtin_bit_cast(bf16x8, pw);
#pragma unroll
                for (int db = 0; db < NDB; ++db) {
                    const LAS unsigned char* vp = cb + KBYTES + (32 * db + r) * VROW + (32 * kb + 16 * s2 + 4 * h) * 2;
                    const u32x2 lo = *(const LAS u32x2*)vp, hi = *(const LAS u32x2*)(vp + 16);
                    const u32x4 vw = {lo.x, lo.y, hi.x, hi.y};
                    o[db] = __builtin_amdgcn_mfma_f32_32x32x16_bf16(__builtin_bit_cast(bf16x8, vw), pf, o[db], 0, 0, 0);
                }
                    }
        if (more) {
            *(LAS u32x4*)(nb + kwoff) = kreg;
#pragma unroll
            for (int i = 0; i < NV; ++i) { *(LAS u32x2*)(nb + vwoff + i * 64 * VROW) = (u32x2){vreg[i].x, vreg[i].y}; *(LAS u32x2*)(nb + vwoff + i * 64 * VROW + 8) = (u32x2){vreg[i].z, vreg[i].w}; }
        }
        __syncthreads();
    }
    lrun += __shfl_xor(lrun, 32);
    const float inv = 1.f / lrun;
    bf16_t* orow = O + (size_t)(wave * 32 + r) * opitch;
#pragma unroll
    for (int db = 0; db < NDB; ++db)
#pragma unroll
        for (int g = 0; g < 4; ++g) {
            u32x2 w; w.x = pk2(o[db][4 * g] * inv, o[db][4 * g + 1] * inv); w.y = pk2(o[db][4 * g + 2] * inv, o[db][4 * g + 3] * inv);
            *(u32x2*)(orow + 32 * db + 8 * g + 4 * h) = w;
        }
}

template <int MODE> DI int srccol(int np) {
    if (MODE == 1) { const int pn = np >> 8, j = np & 255; return j < 128 ? 128 * pn + j : FF + 128 * pn + (j - 128); }
    if (MODE == 2) { const int t = np >> 8, p = np & 255; return 256 * t + 64 * ((p >> 5) & 3) + 32 * (p >> 7) + (p & 31); }
    return np;
}
DI void tr_item(const float* __restrict__ src, int Nsrc, int mode, int n0, int k0, bf16_t* __restrict__ dst, int ldd, LAS float* tile, int tid) {
    const int nn = tid & 63, kq = tid >> 6;
    int sc0, sc1;
    if (mode == 1) { sc0 = srccol<1>(n0 + nn); sc1 = srccol<1>(n0 + nn + 64); } else if (mode == 2) { sc0 = srccol<2>(n0 + nn); sc1 = srccol<2>(n0 + nn + 64); } else { sc0 = n0 + nn; sc1 = n0 + nn + 64; }
    float v0[8], v1[8];
#pragma unroll
    for (int i = 0; i < 8; ++i) { const float* rp = src + (size_t)(k0 + kq + 8 * i) * Nsrc; v0[i] = rp[sc0]; v1[i] = rp[sc1]; }
#pragma unroll
    for (int i = 0; i < 8; ++i) { tile[(kq + 8 * i) * 129 + nn] = v0[i]; tile[(kq + 8 * i) * 129 + nn + 64] = v1[i]; }
    __syncthreads();
    const int n2 = tid >> 3, kc = tid & 7;
#pragma unroll
    for (int hh = 0; hh < 2; ++hh) {
        const int nr = n2 + 64 * hh;
        u32x4 w;
        w.x = pk2(tile[(8 * kc + 0) * 129 + nr], tile[(8 * kc + 1) * 129 + nr]); w.y = pk2(tile[(8 * kc + 2) * 129 + nr], tile[(8 * kc + 3) * 129 + nr]);
        w.z = pk2(tile[(8 * kc + 4) * 129 + nr], tile[(8 * kc + 5) * 129 + nr]); w.w = pk2(tile[(8 * kc + 6) * 129 + nr], tile[(8 * kc + 7) * 129 + nr]);
        *(u32x4*)(dst + (size_t)(n0 + nr) * ldd + k0 + 8 * kc) = w;
    }
    __syncthreads();
}

DI void convert_layer(KP a, int l, LAS unsigned char* lds) {
    unsigned char* ws = a->ws; const int tid = otid(), G = gridDim.x;
    LAS float* tile = (LAS float*)(lds + 32768);
    LAS float* t64 = (LAS float*)(lds + 98304);
    __syncthreads();
    if (tid < 64) t64[tid] = cospif((float)tid * (1.f / 32.f));
    __syncthreads();
    for (int it = blockIdx.x; it < 2464; it += G) {
        const float* src; bf16_t* dst; int Nsrc, nkt, ldd, mode, j;
        if (it < 704) { j = it; src = a->in[20] + (size_t)l * D * 2 * FF; Nsrc = 2 * FF; nkt = 16; dst = (bf16_t*)(ws + WS_WGU1); ldd = D; mode = 1; }
        else if (it < 1056) { j = it - 704; src = a->in[21] + (size_t)l * FF * D; Nsrc = D; nkt = 44; dst = (bf16_t*)(ws + WS_WD1); ldd = FF; mode = 0; }
        else if (it < 1312) { j = it - 1056; src = a->in[10] + (size_t)l * D * 2304; Nsrc = 2304; nkt = 16; dst = (bf16_t*)(ws + WS_WIN); ldd = D; mode = 2; }
        else if (it < 1408) { j = it - 1312; src = a->in[19] + (size_t)l * D * D; Nsrc = D; nkt = 12; dst = (bf16_t*)(ws + WS_WOUT); ldd = D; mode = 0; }
        else if (it < 2112) { j = it - 1408; src = a->in[22] + (size_t)l * D * 2 * FF; Nsrc = 2 * FF; nkt = 16; dst = (bf16_t*)(ws + WS_WGU2); ldd = D; mode = 1; }
        else { j = it - 2112; src = a->in[23] + (size_t)l * FF * D; Nsrc = D; nkt = 44; dst = (bf16_t*)(ws + WS_WD2); ldd = FF; mode = 0; }
        tr_item(src, Nsrc, mode, (j / nkt) * 128, (j % nkt) * 64, dst, ldd, tile, tid);
    }
    { bf16_t* WinT = (bf16_t*)(ws + WS_WIN); LAS float* wt = tile;
      for (int it = blockIdx.x; it < 128; it += G) {
          const int cs = it & 1, kb = (it >> 1) & 15, g = it >> 5;
#pragma unroll
          for (int e = 0; e < 8; ++e) { const int idx = tid + 512 * e, kd = idx >> 6, cc = idx & 63; wt[kd * 65 + cc] = a->in[10][((size_t)l * D + kb * 64 + kd) * 2304 + 2048 + g * 64 + cc]; }
          __syncthreads();
          const int kd = tid & 63, kq = tid >> 6;
          float acc[8];
#pragma unroll
          for (int e = 0; e < 8; ++e) acc[e] = 0.f;
          for (int cc = 0; cc < 64; ++cc) {
              const float x = wt[kd * 65 + cc];
#pragma unroll
              for (int e = 0; e < 8; ++e) { const int idx = ((kq * 8 + e) * cc - (cs ? 16 : 0)) & 63; acc[e] += x * t64[idx]; }
          }
#pragma unroll
          for (int e = 0; e < 8; ++e) WinT[(size_t)(2048 + cs * 256 + g * 64 + kq * 8 + e) * D + kb * 64 + kd] = f2bf(acc[e]);
          __syncthreads();
      } }
    { bf16_t* WoutT = (bf16_t*)(ws + WS_WOUT); LAS float* wfs = tile; LAS float* red = (LAS float*)lds;
      for (int it = blockIdx.x; it < 256; it += G) {
          const int ib = it >> 4, nb = it & 15;
#pragma unroll
          for (int e = 0; e < 8; ++e) { const int idx = tid + 512 * e, i = idx >> 8, j = idx & 255; wfs[j * 17 + i] = a->in[18][((size_t)l * 256 + ib * 16 + i) * 256 + j]; }
          __syncthreads();
          const int w = tid >> 6, lane = tid & 63;
          const float* wo = a->in[19] + ((size_t)l * D + 768 + w * 32) * D + nb * 64 + lane;
          float acc[16];
#pragma unroll
          for (int i = 0; i < 16; ++i) acc[i] = 0.f;
#pragma unroll 8
          for (int jj = 0; jj < 32; ++jj) { const float x = wo[(size_t)jj * D];
#pragma unroll
              for (int i = 0; i < 16; ++i) acc[i] += x * wfs[(w * 32 + jj) * 17 + i]; }
#pragma unroll
          for (int i = 0; i < 16; ++i) red[(w * 16 + i) * 64 + lane] = acc[i];
          __syncthreads();
#pragma unroll
          for (int hh = 0; hh < 2; ++hh) { const int i = (tid >> 6) + 8 * hh; float sacc = 0.f;
#pragma unroll
              for (int q = 0; q < 8; ++q) sacc += red[(q * 16 + i) * 64 + lane];
              WoutT[(size_t)(nb * 64 + lane) * D + 768 + ib * 16 + i] = f2bf(sacc); }
          __syncthreads();
      } }
    { bf16_t* KAS = (bf16_t*)(ws + WS_KAS); bf16_t* VAS = (bf16_t*)(ws + WS_VAS); bf16_t* KBS = (bf16_t*)(ws + WS_KBS); bf16_t* VBS = (bf16_t*)(ws + WS_VBS);
      for (int i = blockIdx.x * 512 + tid; i < 2 * 256 * 1280; i += G * 512) {
          const int e = i % 1280, bp = i / 1280, b = bp >> 8, pos = bp & 255;
          const size_t cbase = (size_t)((b * 2 + l) * 256 + pos);
          if (e < 128) { const int kvh = e >> 6, d = e & 63; KAS[((size_t)(b * 2 + kvh) * LKS + pos) * 64 + d] = f2bf(a->in[2][cbase * 128 + e]); }
          else if (e < 256) { const int e2 = e - 128, kvh = e2 >> 6, d = e2 & 63; VAS[((size_t)(b * 2 + kvh) * 64 + d) * LKS + pos] = f2bf(a->in[3][cbase * 128 + e2]); }
          else if (e < 768) { const int e2 = e - 256, s = e2 >> 6, d = e2 & 63; KBS[((size_t)(b * 8 + s) * LKS + pos) * 64 + d] = f2bf(a->in[4][cbase * 512 + e2]); }
          else { const int e2 = e - 768, hh = e2 >> 7, d = e2 & 127; VBS[((size_t)(b * 4 + hh) * 128 + d) * LKS + pos] = f2bf(a->in[5][cbase * 512 + e2]); }
      } }
    __syncthreads();
}

DI void p0_prologue(KP a, LAS unsigned char* lds) {
    unsigned char* ws = a->ws; const int tid = otid(), G = gridDim.x;
    { LAS float* sv = (LAS float*)lds; LAS float* red = (LAS float*)(lds + 16384);
      for (int i = tid; i < 3072; i += 512) { const int m = i >> 10, k = i & 1023; const float cv = (m == 0) ? a->in[7][k] : a->in[6][(m - 1) * D + k]; sv[i] = cv / (1.f + __expf(-cv)); }
      __syncthreads();
      float* MOD = (float*)(ws + WS_MOD);
      for (int it = blockIdx.x; it < 256; it += G) {
          const int col0 = it * 72, l = col0 / 9216, c0 = col0 % 9216, kg = tid / 72, cc = tid % 72;
          float a0 = 0.f, a1 = 0.f, a2 = 0.f;
          if (kg < 7) { const float* w = a->in[8] + (size_t)l * D * 9216 + c0 + cc;
#pragma unroll 8
              for (int k = kg; k < D; k += 7) { const float wv = w[(size_t)k * 9216]; a0 += sv[k] * wv; a1 += sv[1024 + k] * wv; a2 += sv[2048 + k] * wv; }
              red[(kg * 3 + 0) * 72 + cc] = a0; red[(kg * 3 + 1) * 72 + cc] = a1; red[(kg * 3 + 2) * 72 + cc] = a2; }
          __syncthreads();
          if (tid < 216) { const int m = tid / 72, c2 = tid % 72; float s = 0.f;
#pragma unroll
              for (int q = 0; q < 7; ++q) s += red[(q * 3 + m) * 72 + c2];
              MOD[(size_t)(l * 3 + m) * 9216 + c0 + c2] = s + a->in[9][l * 9216 + c0 + c2]; }
          __syncthreads();
      } }
    if (blockIdx.x == G - 1) {
        float* ROPE = (float*)(ws + WS_ROPE);
        for (int i = tid; i < 1024; i += 512) { const int pos = i >> 4, f = i & 15;
            const float inv = exp2f(-(float)f * (13.2877123795f / 16.f)); float rev = (float)pos * inv * 0.15915494309f; rev -= floorf(rev);
            ROPE[2 * i] = cospif(2.f * rev); ROPE[2 * i + 1] = sinpif(2.f * rev); }
    }
    { LAS float* tab = (LAS float*)lds;
      __syncthreads();
      for (int i = tid; i < 4096; i += 512) tab[i] = cospif((float)i * (1.f / 2048.f));
      __syncthreads();
      bf16_t* DS = (bf16_t*)(ws + WS_DFTS);
      for (int p = blockIdx.x; p < 4096; p += G)
          for (int ch = tid; ch < 1024; ch += 512) {
              const int k0 = ch * 8, n0 = k0 & 4095; const bool sp = k0 >= 4096; float v[8];
#pragma unroll
              for (int e = 0; e < 8; ++e) { const int idx = (p * (n0 + e)) & 4095; v[e] = (sp ? -tab[(idx - 1024) & 4095] : tab[idx]) * (1.f / 512.f); }
              u32x4 w; w.x = pk2(v[0], v[1]); w.y = pk2(v[2], v[3]); w.z = pk2(v[4], v[5]); w.w = pk2(v[6], v[7]);
              *(u32x4*)(DS + (size_t)p * 8192 + k0) = w;
          }
      bf16_t* DP = (bf16_t*)(ws + WS_DFTP);
      for (int p = blockIdx.x; p < 256; p += G)
          if (tid < 64) {
              const int k0 = tid * 8, n0 = k0 & 255; const bool sp = k0 >= 256; float v[8];
#pragma unroll
              for (int e = 0; e < 8; ++e) { const int idx = ((p * (n0 + e)) & 255) * 16; v[e] = (sp ? -tab[(idx - 1024) & 4095] : tab[idx]) * (1.f / 128.f); }
              u32x4 w; w.x = pk2(v[0], v[1]); w.y = pk2(v[2], v[3]); w.z = pk2(v[4], v[5]); w.w = pk2(v[6], v[7]);
              *(u32x4*)(DP + (size_t)p * 512 + k0) = w;
          }
      __syncthreads(); }
    convert_layer(a, 0, lds);
}

DI void p_modulate0(KP a) {
    const float* MOD = (const float*)(a->ws + WS_MOD); bf16_t* H = (bf16_t*)(a->ws + WS_H);
    for (int i = blockIdx.x * 512 + otid(); i < T * 128; i += gridDim.x * 512) {
        const int row = i >> 7, c0 = (i & 127) * 8;
        const float* sp = (row < TP) ? a->in[0] + (size_t)row * D : a->in[1] + (size_t)(row - TP) * D;
        const float* md = MOD + (size_t)(row < TP ? 0 : 1 + ((row - TP) >> 12)) * 9216;
        float v[8];
#pragma unroll
        for (int q = 0; q < 2; ++q) { const f32x4 x = *(const f32x4*)(sp + c0 + 4 * q), sh = *(const f32x4*)(md + c0 + 4 * q), sc = *(const f32x4*)(md + 1024 + c0 + 4 * q);
#pragma unroll
            for (int e = 0; e < 4; ++e) v[4 * q + e] = x[e] * (1.f + sc[e]) + sh[e]; }
        u32x4 w; w.x = pk2(v[0], v[1]); w.y = pk2(v[2], v[3]); w.z = pk2(v[4], v[5]); w.w = pk2(v[6], v[7]);
        *(u32x4*)(H + (size_t)row * D + c0) = w;
    }
}

DI void p_layernorm(const float* X, float* xo, bf16_t* H, const float* g, const float* bta, const float* modn  ) {
    const int tid = otid(), wave = tid >> 6, lane = tid & 63;
    for (int row = blockIdx.x * 8 + wave; row < T; row += gridDim.x * 8) {
        f32x4 v[4];
#pragma unroll
        for (int i = 0; i < 4; ++i) v[i] = *(const f32x4*)(X + (size_t)row * D + i * 256 + lane * 4);
        float s = 0.f;
#pragma unroll
        for (int i = 0; i < 4; ++i) s += (v[i][0] + v[i][1]) + (v[i][2] + v[i][3]);
        const float mean = wave_sum(s) * (1.f / 1024.f);
        float q = 0.f;
#pragma unroll
        for (int i = 0; i < 4; ++i) { v[i] = v[i] - mean; q += (v[i][0] * v[i][0] + v[i][1] * v[i][1]) + (v[i][2] * v[i][2] + v[i][3] * v[i][3]); }
        const float rstd = rsqrtf(wave_sum(q) * (1.f / 1024.f) + 1e-5f);
        const float* md = modn ? modn + (size_t)(row < TP ? 0 : 1 + ((row - TP) >> 12)) * 9216 : nullptr;
#pragma unroll
        for (int i = 0; i < 4; ++i) {
            const int c = i * 256 + lane * 4;
            const f32x4 y = v[i] * rstd * *(const f32x4*)(g + c) + *(const f32x4*)(bta + c);
            *(f32x4*)(xo + (size_t)row * D + c) = y;
            if (md) { const f32x4 sh = *(const f32x4*)(md + c), sc = *(const f32x4*)(md + 1024 + c);
                u32x2 w; w.x = pk2(y[0] * (1.f + sc[0]) + sh[0], y[1] * (1.f + sc[1]) + sh[1]); w.y = pk2(y[2] * (1.f + sc[2]) + sh[2], y[3] * (1.f + sc[3]) + sh[3]);
                *(u32x2*)(H + (size_t)row * D + c) = w; }
        }
    }
}

DI void p_combine(KP a, int l) {
    const int tid = otid(), wave = tid >> 6, lane = tid & 63;
    const bf16_t* OBT = (const bf16_t*)(a->ws + WS_H); bf16_t* MIX = (bf16_t*)(a->ws + WS_MIX);
    const float lam_init = (l == 0) ? 0.2f : (0.8f - 0.6f * 0.74081822068f);
    const float d1 = wave_sum(a->in[13][l * 64 + lane] * a->in[14][l * 64 + lane]), d2 = wave_sum(a->in[15][l * 64 + lane] * a->in[16][l * 64 + lane]);
    const float lam = expf(d1) - expf(d2) + lam_init;
    const float g0 = a->in[17][l * 128 + 2 * lane] * (1.f - lam_init), g1 = a->in[17][l * 128 + 2 * lane + 1] * (1.f - lam_init);
    for (int row = blockIdx.x * 8 + wave; row < T; row += gridDim.x * 8) {
#pragma unroll
        for (int hb = 0; hb < 4; ++hb) {
            const unsigned w1 = *(const unsigned*)(OBT + (size_t)row * D + hb * 256 + 2 * lane), w2 = *(const unsigned*)(OBT + (size_t)row * D + hb * 256 + 128 + 2 * lane);
            const float x0 = __uint_as_float(w1 << 16) - lam * __uint_as_float(w2 << 16), x1 = __uint_as_float(w1 & 0xffff0000u) - lam * __uint_as_float(w2 & 0xffff0000u);
            const float rs = rsqrtf(wave_sum(x0 * x0 + x1 * x1) * (1.f / 128.f) + 1e-6f);
            *(unsigned*)(MIX + (size_t)row * D + 256 + hb * 128 + 2 * lane) = pk2(x0 * rs * g0, x1 * rs * g1);
        }
    }
}


#define XB_TMO      128
#define XB_XCNT(j)  (256  + 64 * (j))
#define XB_XSUB(j)  (1280 + 64 * (j))
#define XB_XGEN(j)  (2304 + 64 * (j))
#define XB_TOP      3328
#define XB_TOPGEN   3392
#define XCD_BAR_WORDS 3456
#define XB_SPIN_CAP (1u << 18)
DI unsigned xb_ld(unsigned* p)              { return __hip_atomic_load(p, __ATOMIC_RELAXED, __HIP_MEMORY_SCOPE_AGENT); }
DI unsigned xb_add(unsigned* p, unsigned v) { return __hip_atomic_fetch_add(p, v, __ATOMIC_RELAXED, __HIP_MEMORY_SCOPE_AGENT); }
DI unsigned xb_xcc_id() { return (unsigned)__builtin_amdgcn_s_getreg((3 << 11) | 20) & 0xFu; }
#define XB_SPIN(cond, bar) do { unsigned _sp = 0; while (cond) { __builtin_amdgcn_s_sleep(1); \
    if ((++_sp & 255u) == 0u) { if (xb_ld(&(bar)[XB_TMO])) break; if (_sp > XB_SPIN_CAP) { atomicAdd(&(bar)[XB_TMO], 1u); break; } } } } while (0)
struct XcdBarrier { unsigned* bar; unsigned x; volatile LAS unsigned* st; };
DI XcdBarrier xcd_barrier_post(unsigned* bar, volatile LAS unsigned* st) {
    XcdBarrier b; b.bar = bar; b.x = xb_xcc_id(); b.st = st;
    if (threadIdx.x == 0) (void)xb_add(&bar[XB_XCNT(b.x)], 1u);
    return b;
}
DI void xcd_barrier_complete(unsigned* bar, unsigned x, unsigned& nloc, unsigned& nx) {
    const unsigned G = gridDim.x * gridDim.y * gridDim.z;
    unsigned sum, cnt, mine, sp = 0u;
    for (;;) {
        sum = 0u; cnt = 0u; mine = 0u;
#pragma unroll
        for (unsigned j = 0; j < 16; ++j) { const unsigned c = xb_ld(&bar[XB_XCNT(j)]); sum += c; cnt += (c > 0u) ? 1u : 0u; mine = (j == x) ? c : mine; }
        if (sum == G) break;
        __builtin_amdgcn_s_sleep(1);
        if ((++sp & 255u) == 0u) { if (xb_ld(&bar[XB_TMO])) break; if (sp > XB_SPIN_CAP) { atomicAdd(&bar[XB_TMO], 1u); break; } }
    }
    nloc = mine > 0u ? mine : 1u; nx = cnt > 0u ? cnt : 1u;
}
DI void xcd_barrier(const XcdBarrier& b) {
    asm volatile("s_waitcnt vmcnt(0)" ::: "memory");
    __syncthreads();
    if (threadIdx.x == 0) {
        unsigned* bar = b.bar;
        __builtin_amdgcn_s_waitcnt(0);
        unsigned nloc = b.st[0], nx = b.st[1];
        if (nloc == 0u) { xcd_barrier_complete(bar, b.x, nloc, nx); b.st[0] = nloc; b.st[1] = nx; }
        const unsigned old = xb_add(&bar[XB_XSUB(b.x)], 1u);
        const unsigned gen = old / nloc;
        if (old + 1u == (gen + 1u) * nloc) {
            __builtin_amdgcn_fence(__ATOMIC_RELEASE, "agent");
            asm volatile("s_waitcnt vmcnt(0)" ::: "memory");
            const unsigned og = xb_add(&bar[XB_TOP], 1u);
            const unsigned tg = og / nx;
            if (og + 1u == (tg + 1u) * nx) xb_add(&bar[XB_TOPGEN], 1u);
            else XB_SPIN(xb_ld(&bar[XB_TOPGEN]) == tg, bar);
            __builtin_amdgcn_fence(__ATOMIC_ACQUIRE, "agent");
            xb_add(&bar[XB_XGEN(b.x)], 1u);
            asm volatile("s_waitcnt vmcnt(0)" ::: "memory");
        } else {
            XB_SPIN(xb_ld(&bar[XB_XGEN(b.x)]) == gen, bar);
            __builtin_amdgcn_fence(__ATOMIC_ACQUIRE, "agent");
            asm volatile("s_waitcnt vmcnt(0)" ::: "memory");
        }
    }
    __syncthreads();
}

#ifndef PROBE_MASK
#define PROBE_MASK 0
#endif
constexpr int N_PHASES = 24;
#define PHM(i) ((MASK >> (i)) & 1)
template <int MASK> __global__ void __launch_bounds__(512) trunk_fwd(KArgs a_unused) {
    extern __shared__ __attribute__((aligned(16))) unsigned char lds_raw[];
    LAS unsigned char* lds = (LAS unsigned char*)lds_raw;
    cg::grid_group grid = cg::this_grid();
    const KP a0 = (KP)__builtin_amdgcn_kernarg_segment_ptr();
    unsigned char* ws = a0->ws;
    const int G = gridDim.x, c = blockIdx.x;
    float* X = (float*)(ws + WS_X); bf16_t* H = (bf16_t*)(ws + WS_H); bf16_t* ACT = (bf16_t*)(ws + WS_ACT); bf16_t* MIX = (bf16_t*)(ws + WS_MIX);
    const float* MOD = (const float*)(ws + WS_MOD);
    volatile LAS unsigned* misc = (volatile LAS unsigned*)(lds + MISC_OFF);
    if (threadIdx.x < 16) misc[threadIdx.x] = 0u;
    __syncthreads();
    XcdBarrier xbar = xcd_barrier_post((unsigned*)(ws + WS_CTL) + 64, misc + 8);
    const int ph_lo = a0->ph_lo, ph_hi = a0->ph_hi;
    int redo = 0;
    for (int ph = ph_lo; ph < ph_hi; ++ph) {
        const int tid = otid();
        KP a = a0; asm volatile("" : "+s"(a));
        int kbit; if (ph < 2) kbit = ph; else { const int k_ = (ph - 2) % 11; kbit = (k_ == 0 || k_ == 8) ? 2 : (k_ == 1 || k_ == 9 || k_ == 6) ? 3 : (k_ == 2 || k_ == 7 || k_ == 10) ? 4 : (k_ == 3) ? 5 : (k_ == 4) ? 7 : 8; }
        const int rep = redo;
        {
        if (ph == 0) { if (PHM(0)) p0_prologue(a, lds); }
        else if (ph == 1) { if (PHM(1)) p_modulate0(a); }
        else {
            const int l = (ph - 2) / 11, k = (ph - 2) % 11;
            const float* modl = MOD + (size_t)l * 3 * 9216;
            if (k == 0 || k == 8) { if (PHM(2)) {
                pg8::Gemm g{H, (const bf16_t*)(ws + (k == 0 ? WS_WGU1 : WS_WGU2)), D, D}; pg8::StaticOrder S; S.init(T, 2 * FF, G, c);
                pg8::EpiGU E{ACT};
                pg8::gemm_phase<pg8::EpiGU, pg8::StaticOrder, true, true>(lds, g, S, E); }
            } else if (k == 1 || k == 9 || k == 6) { if (PHM(3)) {
                pg8::Gemm g; pg8::EpiRes E;
                if (k == 6) { g = pg8::Gemm{MIX, (const bf16_t*)(ws + WS_WOUT), D, D}; E = pg8::EpiRes{X, X + (size_t)TP * D, X, modl + 5 * 1024, 1.0f}; }
                else { g = pg8::Gemm{ACT, (const bf16_t*)(ws + (k == 1 ? WS_WD1 : WS_WD2)), FF, FF};
                    const bool first = (l == 0 && k == 1);
                    E = pg8::EpiRes{first ? a->in[0] : X, first ? a->in[1] : X + (size_t)TP * D, X, modl + (k == 1 ? 2 : 8) * 1024, 0.5f}; }
                pg8::StaticOrder S; S.init(T, D, G, c);
                pg8::gemm_phase<pg8::EpiRes, pg8::StaticOrder, true, true>(lds, g, S, E); }
            } else if (k == 2 || k == 7 || k == 10) { if (PHM(4)) {
                const int which = (k == 2) ? 0 : (k == 7 ? 1 : 2);
                const float* lg = a->in[24] + (size_t)(l * 3 + which) * D; const float* lb = a->in[25] + (size_t)(l * 3 + which) * D;
                const bool final_ = (l == 1 && k == 10);
                const float* modn = (k == 2) ? modl + 3 * 1024 : (k == 7) ? modl + 6 * 1024 : (final_ ? nullptr : MOD + (size_t)(l + 1) * 3 * 9216);
                p_layernorm(X, final_ ? a->out : X, H, lg, lb, modn);
                if (k == 10 && l == 0) convert_layer(a, 1, lds); }
            } else if (k == 3) { if (PHM(5)) {
                pg8::Gemm g{H, (const bf16_t*)(ws + WS_WIN), D, D}; pg8::StaticOrder S; S.init(T, NIN, G, c);
                pg8::EpiIn E{l, a->in[11], a->in[12], a->out, ws};
                pg8::gemm_phase<pg8::EpiIn, pg8::StaticOrder, true, true>(lds, g, S, E); }
            } else if (k == 4) {
                if (PHM(6) && (rep == 0 || ((PROBE_MASK >> 6) & 1))) {
#pragma clang loop unroll(disable)
                    for (int pass = 0; pass < 2; ++pass) {
                        const bool sp = pass == 0;
                        pg8::Gemm g{(const bf16_t*)(ws + (sp ? WS_DFTS : WS_DFTP)), (const bf16_t*)(ws + (sp ? WS_UTS : WS_UTP)), sp ? 8192 : 512, sp ? 8192 : 512};
                        pg8::FourOrder S{G, c, sp ? 32 : 16, pass}; pg8::EpiFour E{MIX, pass};
                        pg8::gemm_phase<pg8::EpiFour, pg8::FourOrder, true, true>(lds, g, S, E);
                    }
                }
                volatile LAS int* qslot = (volatile LAS int*)(lds + MISC_OFF);
                unsigned* ctr = (unsigned*)(ws + WS_CTL) + l + 2 * rep;
                const bf16_t* QA = (const bf16_t*)(ws + WS_QA); const bf16_t* QB = (const bf16_t*)(ws + WS_QB);
                bf16_t* OBT = (bf16_t*)(ws + WS_H);
                if (PHM(7) && (rep == 0 || ((PROBE_MASK >> 7) & 1))) for (;;) {
                    __syncthreads();
                    if (tid == 0) *qslot = (int)atomicAdd(ctr, 1u);
                    __syncthreads();
                    const int idx = *qslot;
                    if (idx >= 576) break;
                    const bf16_t *Qp, *Kp, *Vp; bf16_t* Op; int qpitch, Lk; bool wide;
                    if (idx < 256) { const int b = idx >> 7, s = (idx >> 4) & 7, qb = idx & 15; const size_t tok0 = TP + b * 4096 + qb * 256; wide = true; qpitch = 512; Lk = LKS;
                        Qp = QB + tok0 * 512 + s * 64; Kp = (const bf16_t*)(ws + WS_KBS) + (size_t)(b * 8 + s) * LKS * 64; Vp = (const bf16_t*)(ws + WS_VBS) + (size_t)(b * 4 + (s >> 1)) * 128 * LKS; Op = OBT + tok0 * D + s * 128; }
                    else if (idx < 384) { const int i = idx - 256, b = i >> 6, hq = (i >> 4) & 3, qb = i & 15; const size_t tok0 = TP + b * 4096 + qb * 256; wide = false; qpitch = 256; Lk = LKS;
                        Qp = QA + tok0 * 256 + hq * 64; Kp = (const bf16_t*)(ws + WS_KAS) + (size_t)(b * 2 + (hq >> 1)) * LKS * 64; Vp = (const bf16_t*)(ws + WS_VAS) + (size_t)(b * 2 + (hq >> 1)) * 64 * LKS; Op = MIX + tok0 * D + hq * 64; }
                    else if (idx < 512) { const int i = idx - 384, b = i >> 3, s = i & 7; const size_t tok0 = b * 256; wide = true; qpitch = 512; Lk = 256;
                        Qp = QB + tok0 * 512 + s * 64; Kp = (const bf16_t*)(ws + WS_KBP) + (size_t)(b * 8 + s) * 256 * 64; Vp = (const bf16_t*)(ws + WS_VBP) + (size_t)(b * 4 + (s >> 1)) * 128 * 256; Op = OBT + tok0 * D + s * 128; }
                    else { const int i = idx - 512, b = i >> 2, hq = i & 3; const size_t tok0 = b * 256; wide = false; qpitch = 256; Lk = 256;
                        Qp = QA + tok0 * 256 + hq * 64; Kp = (const bf16_t*)(ws + WS_KAP) + (size_t)(b * 2 + (hq >> 1)) * 256 * 64; Vp = (const bf16_t*)(ws + WS_VAP) + (size_t)(b * 2 + (hq >> 1)) * 64 * 256; Op = MIX + tok0 * D + hq * 64; }
                    if (wide) attn_unit<128>(Qp, qpitch, Kp, Vp, Lk, Op, D, lds); else attn_unit<64>(Qp, qpitch, Kp, Vp, Lk, Op, D, lds);
                }
            } else if (k == 5) {
                if (PHM(8)) p_combine(a, l);
            }
        }
        }
        if (ph + 1 < ph_hi || (PROBE_MASK && redo == 0)) { if (ph == 0 && redo == 0 && !((PROBE_MASK >> 0) & 1)) grid.sync(); else if (ph == 0 && redo == 1) grid.sync(); else xcd_barrier(xbar); }
        if ((((PROBE_MASK >> kbit) & 1) || (kbit == 7 && ((PROBE_MASK >> 6) & 1))) && redo == 0) { redo = 1; --ph; } else redo = 0;
    }
}

typedef void (*kern_t)(KArgs);
extern "C" void kernel_launch(void* const* d_in, const int* in_sizes, int n_in, void* d_out, int out_size, void* d_ws, size_t ws_size, hipStream_t stream) {
    static int grid = 0;
#if MK_PER_PHASE
    static const kern_t kerns[8] = {trunk_fwd<0x1>, trunk_fwd<0x2>, trunk_fwd<0x4>, trunk_fwd<0x8>, trunk_fwd<0x10>, trunk_fwd<0x20>, trunk_fwd<0xC0>, trunk_fwd<0x100>};
    constexpr int NK = 8;
#else
    static const kern_t kerns[1] = {trunk_fwd<0x1ff>};
    constexpr int NK = 1;
#endif
    if (grid == 0) {
        if (n_in != 26 || ws_size < WS_END) { fprintf(stderr, "kernel_launch: need 26 inputs and %zu bytes of workspace; got %d, %zu\n", (size_t)WS_END, n_in, ws_size); grid = -1; return; }
        int dev = 0, cus = 0, per_cu = 0;
        if (hipGetDevice(&dev) != hipSuccess || hipDeviceGetAttribute(&cus, hipDeviceAttributeMultiprocessorCount, dev) != hipSuccess) { grid = -1; return; }
        for (int i = 0; i < NK; ++i) {
            if (hipFuncSetAttribute((const void*)kerns[i], hipFuncAttributeMaxDynamicSharedMemorySize, LDS_BYTES) != hipSuccess) { fprintf(stderr, "kernel_launch: hipFuncSetAttribute failed\n"); grid = -1; return; }
            if (hipOccupancyMaxActiveBlocksPerMultiprocessor(&per_cu, (const void*)kerns[i], 512, LDS_BYTES) != hipSuccess || per_cu < 1) { fprintf(stderr, "kernel_launch: occupancy query says %d\n", per_cu); (void)hipGetLastError(); grid = -1; return; }
        }
        grid = cus * 1;
    }
    if (grid < 0) return;
    if (hipMemsetAsync((char*)d_ws + WS_CTL, 0, 16384, stream) != hipSuccess) { fprintf(stderr, "kernel_launch: memset failed\n"); return; }
    KArgs a{};
    for (int i = 0; i < 26; ++i) a.in[i] = (const float*)d_in[i];
    a.out = (float*)d_out; a.ws = (unsigned char*)d_ws;
#if MK_PER_PHASE
    for (int ph = 0; ph < N_PHASES; ++ph) {
        a.ph_lo = ph; a.ph_hi = ph + 1;
        int ki;
        if (ph < 2) ki = ph;
        else { const int k = (ph - 2) % 11; ki = (k == 0 || k == 8) ? 2 : (k == 1 || k == 9 || k == 6) ? 3 : (k == 2 || k == 7 || k == 10) ? 4 : (k == 3) ? 5 : (k == 4) ? 6 : 7; }
        hipLaunchKernelGGL(kerns[ki], dim3(grid), dim3(512), LDS_BYTES, stream, a);
    }
#else
    a.ph_lo = 0; a.ph_hi = N_PHASES;
    void* args[] = {&a};
    hipError_t e = hipLaunchCooperativeKernel((const void*)kerns[0], dim3(grid), dim3(512), args, LDS_BYTES, stream);
    if (e != hipSuccess) fprintf(stderr, "cooperative launch failed: %s (grid %d)\n", hipGetErrorString(e), grid);
#endif
}
```

```cpp
#include <hip/hip_runtime.h>
#include <hip/hip_cooperative_groups.h>
#include <cstdio>
#include <cstdint>
namespace cg = cooperative_groups;

#ifndef MK_PER_PHASE
#define MK_PER_PHASE 0
#endif

#define DI __device__ __forceinline__
#define LAS __attribute__((address_space(3)))
typedef unsigned short bf16_t;
typedef short bf16x8 __attribute__((ext_vector_type(8)));
typedef short s16x4 __attribute__((ext_vector_type(4)));
typedef float f32x4 __attribute__((ext_vector_type(4)));
typedef float f32x16 __attribute__((ext_vector_type(16)));
typedef unsigned u32x4 __attribute__((ext_vector_type(4)));
typedef unsigned u32x2 __attribute__((ext_vector_type(2)));
typedef __bf16 bf16x2_t __attribute__((ext_vector_type(2)));
typedef float f32x2_t __attribute__((ext_vector_type(2)));

DI unsigned pk2(float lo, float hi) { f32x2_t v = {lo, hi}; bf16x2_t b = __builtin_convertvector(v, bf16x2_t); return __builtin_bit_cast(unsigned, b); }
DI bf16_t f2bf(float f) { return (bf16_t)(pk2(f, 0.f) & 0xffffu); }
DI int otid() { int t = threadIdx.x; asm volatile("" : "+v"(t)); return t; }
DI float wave_sum(float v) { v += __shfl_xor(v, 1); v += __shfl_xor(v, 2); v += __shfl_xor(v, 4); v += __shfl_xor(v, 8); v += __shfl_xor(v, 16); v += __shfl_xor(v, 32); return v; }

constexpr int T = 12288, TP = 4096, D = 1024, FF = 2816, NIN = 2560, LKS = 4352;
constexpr float ALPHA = 1.41421356237f;
constexpr float QSCALE = 0.125f * 1.44269504089f;

constexpr size_t al256(size_t x) { return (x + 255) & ~(size_t)255; }
constexpr size_t WS_CTL = 0;
constexpr size_t WS_MOD = 16384;
constexpr size_t WS_ROPE = WS_MOD + al256(2 * 3 * 9216 * 4);
constexpr size_t WS_DFTP = WS_ROPE + 8192;
constexpr size_t WS_DFTS = WS_DFTP + 256 * 512 * 2;
constexpr size_t WS_WGU1 = WS_DFTS + (size_t)4096 * 8192 * 2;
constexpr size_t WS_WD1 = WS_WGU1 + (size_t)5632 * 1024 * 2;
constexpr size_t WS_WIN = WS_WD1 + (size_t)1024 * 2816 * 2;
constexpr size_t WS_WOUT = WS_WIN + (size_t)2560 * 1024 * 2;
constexpr size_t WS_WGU2 = WS_WOUT + (size_t)1024 * 1024 * 2;
constexpr size_t WS_WD2 = WS_WGU2 + (size_t)5632 * 1024 * 2;
constexpr size_t WS_X = WS_WD2 + (size_t)1024 * 2816 * 2;
constexpr size_t WS_KAS = WS_X + (size_t)T * D * 4;
constexpr size_t WS_VAS = WS_KAS + (size_t)2 * 2 * LKS * 64 * 2;
constexpr size_t WS_KBS = WS_VAS + (size_t)2 * 2 * LKS * 64 * 2;
constexpr size_t WS_VBS = WS_KBS + (size_t)2 * 8 * LKS * 64 * 2;
constexpr size_t WS_H = WS_VBS + (size_t)2 * 4 * 128 * LKS * 2;
constexpr size_t WS_R = WS_H + (size_t)T * D * 2;
constexpr size_t WS_ACT = WS_R;
constexpr size_t WS_QA = WS_R;
constexpr size_t WS_QB = WS_QA + (size_t)T * 256 * 2;
constexpr size_t WS_KAP = WS_QB + (size_t)T * 512 * 2;
constexpr size_t WS_VAP = WS_KAP + (size_t)16 * 2 * 256 * 64 * 2;
constexpr size_t WS_KBP = WS_VAP + (size_t)16 * 2 * 256 * 64 * 2;
constexpr size_t WS_VBP = WS_KBP + (size_t)16 * 8 * 256 * 64 * 2;
constexpr size_t WS_UTP = WS_VBP + (size_t)16 * 4 * 128 * 256 * 2;
constexpr size_t WS_UTS = WS_UTP + (size_t)4096 * 512 * 2;
constexpr size_t WS_MIX = WS_UTS + (size_t)512 * 8192 * 2;
constexpr size_t WS_FACC = WS_MIX + (size_t)T * D * 2;
constexpr size_t WS_REND = WS_FACC + (size_t)T * 256 * 4;
constexpr size_t WS_END = (WS_REND > WS_ACT + (size_t)T * FF * 2) ? WS_REND : WS_ACT + (size_t)T * FF * 2;

constexpr int LDS_RING = 131072, MISC_OFF = LDS_RING, LDS_BYTES = LDS_RING + 256;

struct KArgs { const float* in[26]; float* out; unsigned char* ws; int ph_lo, ph_hi; };
typedef const KArgs __attribute__((address_space(4)))* KP;

namespace pg8 {
constexpr int BM = 256, BK = 64, HALF = 128, HTB = HALF * BK * 2, STAGE_BYTES = 8 * HTB, NXCD = 8, WGM = 8;
DI int lds_byte(int r, int c) { const int st = (r >> 4) * 2 + (c >> 5), rr = r & 15, cc = c & 31, ob = rr * 64 + cc * 2; return st * 1024 + (ob ^ (((ob >> 9) & 1) << 5)); }
DI void stage_rc(int b, int& R, int& C) { const int st = b / 1024, sb = b % 1024, swz = sb ^ (((sb >> 9) & 1) << 5); R = (st >> 1) * 16 + swz / 64; C = (st & 1) * 32 + (swz % 64) / 2; }
DI int perm32(int rho) { const int n = rho >> 4, i = rho & 15; return 8 * (i >> 2) + 4 * n + (i & 3); }

struct Unit { int pm, pn, ko; };
struct Gemm { const bf16_t* A; const bf16_t* Bt; int ld, K; };

struct StaticOrder {
    int nM, nN, nwg, G, c;
    DI void init(int M, int N, int G_, int c_) { nM = M / BM; nN = N / BM; nwg = nM * nN; G = G_; c = c_; }
    DI bool next(int i, Unit& u) const {
        const long L = (long)i * G + c; if (L >= nwg) return false;
        int wgid = (int)L; { const int q = nwg / NXCD, r = nwg % NXCD, xcd = wgid % NXCD, off = wgid / NXCD; wgid = (xcd < r ? xcd * (q + 1) : r * (q + 1) + (xcd - r) * q) + off; }
        const int nig = WGM * nN, gid = wgid / nig, fm = gid * WGM, gsz = (nM - fm) < WGM ? (nM - fm) : WGM;
        u.pm = fm + ((wgid % nig) % gsz); u.pn = (wgid % nig) / gsz; u.ko = 0; return true;
    }
};
struct FourOrder {
    int G, c, total, mode;
    DI bool next(int i, Unit& u) const {
        const int L = i * G + c - (mode ? 32 : 0); if (L < 0 || L >= total) return false;
        u.ko = 0;
        if (mode == 0) { u.pm = L >> 1; u.pn = L & 1; } else { u.pm = 0; u.pn = L; }
        return true;
    }
};

template <class Epi, class Sched, bool ALIGN_EPI, bool SP2>
DI void gemm_phase(LAS unsigned char* lds, const Gemm g, const Sched& S, const Epi& E) {
    int tid = threadIdx.x; asm volatile("" : "+v"(tid));
    const int wid = __builtin_amdgcn_readfirstlane(tid >> 6), lane = tid & 63, wr = wid >> 2, wc = wid & 3, fr = lane & 15, fq = lane >> 4;
    const int K = g.K, nt = K / BK, ld = g.ld;
    unsigned voffA[2], voffB[2];
#pragma unroll
    for (int i = 0; i < 2; ++i) { int R, C; stage_rc(tid * 16 + i * 8192, R, C); const int Rb = (R & ~31) + perm32(R & 31);
        voffA[i] = (unsigned)(R * ld + C) * 2u; voffB[i] = (unsigned)(Rb * ld + C) * 2u; }
    const size_t kstep = (size_t)(BK * 2);
    const size_t hstep = (size_t)HALF * ld * 2;
    const size_t tstep = 2 * hstep;
    const unsigned ldsw = (unsigned)wid * 1024u;
    const int aoff = lds_byte(wr * 64 + fr, fq * 8), boff = lds_byte(wc * 32 + fr, fq * 8);
#define PG8_SA(b, h) (((b) * 2 + (h)) * HTB)
#define PG8_SB(b, h) ((4 + (b) * 2 + (h)) * HTB)
#define PG8_STAGE(bufoff, gbase, voff) do { _Pragma("unroll") for (int _i = 0; _i < 2; ++_i) \
        __builtin_amdgcn_global_load_lds((const unsigned*)((const char*)(gbase) + (voff)[_i]), (LAS unsigned*)(lds + (bufoff) + ldsw + _i * 8192), 16, 0, 0); } while (0)
#define PG8_LDA(dst, b, h) do { _Pragma("unroll") for (int m = 0; m < 4; ++m) _Pragma("unroll") for (int k = 0; k < 2; ++k) dst[m][k] = *(const LAS bf16x8*)(lds + PG8_SA(b, h) + aoff + m * 2048 + k * 1024); } while (0)
#define PG8_LDB(dst, b, h) do { _Pragma("unroll") for (int n = 0; n < 2; ++n) _Pragma("unroll") for (int k = 0; k < 2; ++k) dst[n][k] = *(const LAS bf16x8*)(lds + PG8_SB(b, h) + boff + n * 2048 + k * 1024); } while (0)
#define PG8_MMA(ai, bj, At, Bt) do { __builtin_amdgcn_s_setprio(1); _Pragma("unroll") for (int m = 0; m < 4; ++m) _Pragma("unroll") for (int n = 0; n < 2; ++n) _Pragma("unroll") for (int k = 0; k < 2; ++k) \
        acc[ai][bj][m][n] = __builtin_amdgcn_mfma_f32_16x16x32_bf16(Bt[n][k], At[m][k], acc[ai][bj][m][n], 0, 0, 0); __builtin_amdgcn_s_setprio(0); } while (0)
#define PG8_WAIT_V(n) asm volatile("s_waitcnt vmcnt(" #n ")" ::: "memory")
#define PG8_WAIT_L(n) asm volatile("s_waitcnt lgkmcnt(" #n ")" ::: "memory")
#define PG8_BAR __builtin_amdgcn_s_barrier()
#define PG8_SCHED __builtin_amdgcn_sched_barrier(0)
    Unit cur, nxt; int ui = 0;
    if (!S.next(0, cur)) return;
    f32x4 acc[2][2][4][2];
#pragma unroll
    for (int a = 0; a < 2; ++a)
#pragma unroll
        for (int b = 0; b < 2; ++b)
#pragma unroll
            for (int m = 0; m < 4; ++m)
#pragma unroll
                for (int n = 0; n < 2; ++n) acc[a][b][m][n] = (f32x4){0.f, 0.f, 0.f, 0.f};
    bf16x8 At[4][2], B0[2][2], B1[2][2];
    const char* cA = (const char*)g.A + (size_t)cur.pm * tstep + (size_t)cur.ko * 2; const char* cB = (const char*)g.Bt + (size_t)cur.pn * tstep + (size_t)cur.ko * 2;
    if constexpr (SP2) {
        PG8_STAGE(PG8_SB(0, 0), cB, voffB); PG8_STAGE(PG8_SB(0, 1), cB + hstep, voffB); PG8_STAGE(PG8_SA(0, 0), cA, voffA); PG8_STAGE(PG8_SA(0, 1), cA + hstep, voffA);
        if (wr == 1) PG8_BAR;
        PG8_WAIT_V(2); PG8_BAR;
        PG8_STAGE(PG8_SB(1, 0), cB + kstep, voffB); PG8_STAGE(PG8_SA(1, 0), cA + kstep, voffA); PG8_STAGE(PG8_SB(1, 1), cB + hstep + kstep, voffB);
        PG8_WAIT_V(6); PG8_BAR;
    } else {
        PG8_STAGE(PG8_SB(0, 0), cB, voffB); PG8_STAGE(PG8_SA(0, 0), cA, voffA); PG8_STAGE(PG8_SB(0, 1), cB + hstep, voffB); PG8_STAGE(PG8_SA(0, 1), cA + hstep, voffA);
        if (wr == 1) PG8_BAR;
        PG8_WAIT_V(4); PG8_BAR;
        PG8_STAGE(PG8_SB(1, 0), cB + kstep, voffB); PG8_STAGE(PG8_SA(1, 0), cA + kstep, voffA); PG8_STAGE(PG8_SB(1, 1), cB + hstep + kstep, voffB);
        PG8_WAIT_V(6); PG8_BAR;
    }
    for (;;) {
        const bool has_next = S.next(ui + 1, nxt);
        const char* nA = has_next ? (const char*)g.A + (size_t)nxt.pm * tstep + (size_t)nxt.ko * 2 : cA; const char* nB = has_next ? (const char*)g.Bt + (size_t)nxt.pn * tstep + (size_t)nxt.ko * 2 : cB;
        for (int t = 0; t < nt; t += 2) {
            const bool last = (t == nt - 2);
            const char* a1 = cA + (size_t)(t + 1) * kstep;
            const char* a2 = last ? nA : cA + (size_t)(t + 2) * kstep; const char* b2 = last ? nB : cB + (size_t)(t + 2) * kstep;
            const char* a3 = a2 + kstep; const char* b3 = b2 + kstep;
            if constexpr (SP2) {
            PG8_LDB(B0, 0, 0); PG8_LDB(B1, 0, 1); PG8_SCHED; PG8_LDA(At, 0, 0); PG8_STAGE(PG8_SA(1, 1), a1 + hstep, voffA);
            PG8_WAIT_V(8); PG8_WAIT_L(0); PG8_BAR; PG8_MMA(0, 0, At, B0); PG8_MMA(0, 1, At, B1); PG8_BAR; PG8_SCHED;
            PG8_LDA(At, 0, 1); PG8_STAGE(PG8_SB(0, 0), b2, voffB); PG8_STAGE(PG8_SB(0, 1), b2 + hstep, voffB); PG8_STAGE(PG8_SA(0, 0), a2, voffA);
            PG8_WAIT_V(8); PG8_WAIT_L(0); PG8_BAR; PG8_MMA(1, 0, At, B0); PG8_MMA(1, 1, At, B1); PG8_BAR; PG8_SCHED;
            PG8_LDB(B0, 1, 0); PG8_LDB(B1, 1, 1); PG8_SCHED; PG8_LDA(At, 1, 0); PG8_STAGE(PG8_SA(0, 1), a2 + hstep, voffA);
            PG8_WAIT_V(8); PG8_WAIT_L(0); PG8_BAR; PG8_MMA(0, 0, At, B0); PG8_MMA(0, 1, At, B1); PG8_BAR; PG8_SCHED;
            PG8_LDA(At, 1, 1); PG8_STAGE(PG8_SB(1, 0), b3, voffB); PG8_STAGE(PG8_SB(1, 1), b3 + hstep, voffB); PG8_STAGE(PG8_SA(1, 0), a3, voffA);
            PG8_WAIT_V(8); PG8_WAIT_L(0); PG8_BAR; PG8_MMA(1, 0, At, B0); PG8_MMA(1, 1, At, B1); PG8_BAR; PG8_SCHED;
            } else {
            PG8_LDB(B0, 0, 0); PG8_SCHED; PG8_LDA(At, 0, 0); PG8_STAGE(PG8_SA(1, 1), a1 + hstep, voffA);
            PG8_WAIT_L(8); PG8_BAR; PG8_WAIT_L(0); PG8_MMA(0, 0, At, B0); PG8_BAR; PG8_SCHED;
            PG8_LDB(B1, 0, 1); PG8_STAGE(PG8_SB(0, 0), b2, voffB);
            PG8_BAR; PG8_WAIT_L(0); PG8_MMA(0, 1, At, B1); PG8_BAR;
            PG8_LDA(At, 0, 1); PG8_STAGE(PG8_SA(0, 0), a2, voffA);
            PG8_BAR; PG8_WAIT_L(0); PG8_MMA(1, 0, At, B0); PG8_BAR; PG8_SCHED;
            PG8_STAGE(PG8_SB(0, 1), b2 + hstep, voffB);
            PG8_WAIT_V(6); PG8_BAR; PG8_MMA(1, 1, At, B1); PG8_BAR;
            PG8_LDB(B0, 1, 0); PG8_SCHED; PG8_LDA(At, 1, 0); PG8_STAGE(PG8_SA(0, 1), a2 + hstep, voffA);
            PG8_WAIT_L(8); PG8_BAR; PG8_WAIT_L(0); PG8_MMA(0, 0, At, B0); PG8_BAR; PG8_SCHED;
            PG8_LDB(B1, 1, 1); PG8_STAGE(PG8_SB(1, 0), b3, voffB);
            PG8_BAR; PG8_WAIT_L(0); PG8_MMA(0, 1, At, B1); PG8_BAR;
            PG8_LDA(At, 1, 1); PG8_STAGE(PG8_SA(1, 0), a3, voffA);
            PG8_BAR; PG8_WAIT_L(0); PG8_MMA(1, 0, At, B0); PG8_BAR; PG8_SCHED;
            PG8_STAGE(PG8_SB(1, 1), b3 + hstep, voffB);
            PG8_WAIT_V(6); PG8_BAR; PG8_MMA(1, 1, At, B1); PG8_BAR;
            }
        }
        if constexpr (ALIGN_EPI) { if (wr == 0) PG8_BAR; }
        E(acc, cur, wr, wc, fr, fq);
        if (!has_next) break;
#pragma unroll
        for (int a = 0; a < 2; ++a)
#pragma unroll
            for (int b = 0; b < 2; ++b)
#pragma unroll
                for (int m = 0; m < 4; ++m)
#pragma unroll
                    for (int n = 0; n < 2; ++n) acc[a][b][m][n] = (f32x4){0.f, 0.f, 0.f, 0.f};
        cur = nxt; cA = nA; cB = nB; ++ui;
        if constexpr (ALIGN_EPI) { if (wr == 1) PG8_BAR; }
    }
    PG8_WAIT_V(0);
    if constexpr (!ALIGN_EPI) { if (wr == 0) PG8_BAR; }
    PG8_BAR;
#undef PG8_SA
#undef PG8_SB
#undef PG8_STAGE
#undef PG8_LDA
#undef PG8_LDB
#undef PG8_MMA
#undef PG8_WAIT_V
#undef PG8_WAIT_L
#undef PG8_BAR
#undef PG8_SCHED
}

DI int mod_of_row_tile(int pm) { return pm < 16 ? 0 : 1 + ((pm - 16) >> 4); }

struct EpiGU {
    bf16_t* ACT;
    DI void operator()(const f32x4 (&acc)[2][2][4][2], const Unit& u, int wr, int wc, int fr_in, int fq_in) const {
        int fr = fr_in, fq = fq_in; asm volatile("" : "+v"(fr), "+v"(fq));
#pragma unroll
        for (int ai = 0; ai < 2; ++ai)
#pragma unroll
            for (int m = 0; m < 4; ++m) {
                const int row = u.pm * 256 + ai * 128 + wr * 64 + m * 16 + fr;
                float o[8];
#pragma unroll
                for (int n = 0; n < 2; ++n)
#pragma unroll
                    for (int j = 0; j < 4; ++j) { const float gg = acc[ai][0][m][n][j], uu = acc[ai][1][m][n][j];
                        const float sg = gg * __builtin_amdgcn_rcpf(1.f + __builtin_amdgcn_exp2f(-1.44269504089f * gg)); o[n * 4 + j] = sg * uu; }
                u32x4 w; w.x = pk2(o[0], o[1]); w.y = pk2(o[2], o[3]); w.z = pk2(o[4], o[5]); w.w = pk2(o[6], o[7]);
                *(u32x4*)(ACT + (size_t)row * FF + u.pn * 128 + wc * 32 + fq * 8) = w;
            }
    }
};

struct EpiRes {
    const float* srcP; const float* srcS; float* X; const float* gate; float coef;
    DI void operator()(const f32x4 (&acc)[2][2][4][2], const Unit& u, int wr, int wc, int fr_in, int fq_in) const {
        int fr = fr_in, fq = fq_in; asm volatile("" : "+v"(fr), "+v"(fq));
        const float* gt = gate + mod_of_row_tile(u.pm) * 9216;
        f32x4 gv[2][2];
#pragma unroll
        for (int bj = 0; bj < 2; ++bj)
#pragma unroll
            for (int n = 0; n < 2; ++n) gv[bj][n] = *(const f32x4*)(gt + u.pn * 256 + bj * 128 + wc * 32 + fq * 8 + n * 4) * coef;
#pragma unroll
        for (int ai = 0; ai < 2; ++ai)
#pragma unroll
            for (int m = 0; m < 4; ++m) {
                const int row = u.pm * 256 + ai * 128 + wr * 64 + m * 16 + fr;
                const float* sp = (row < TP) ? srcP + (size_t)row * D : srcS + (size_t)(row - TP) * D;
#pragma unroll
                for (int bj = 0; bj < 2; ++bj)
#pragma unroll
                    for (int n = 0; n < 2; ++n) { const int c = u.pn * 256 + bj * 128 + wc * 32 + fq * 8 + n * 4;
                        const f32x4 xv = *(const f32x4*)(sp + c);
                        *(f32x4*)(X + (size_t)row * D + c) = xv * ALPHA + gv[bj][n] * acc[ai][bj][m][n]; }
            }
    }
};

struct EpiFour {
    bf16_t* MIX; int mode;
    DI void operator()(const f32x4 (&acc)[2][2][4][2], const Unit& u, int wr, int wc, int fr_in, int fq_in) const {
        int fr = fr_in, fq = fq_in; asm volatile("" : "+v"(fr), "+v"(fq));
        const int tok0 = ((mode == 0) ? TP + u.pn * 4096 + u.pm * 256 : u.pn * 256) + wr * 64 + fr;
        bf16_t* p0 = MIX + (size_t)tok0 * D + 768 + wc * 32 + fq * 8;
#pragma unroll
        for (int ai = 0; ai < 2; ++ai)
#pragma unroll
            for (int m = 0; m < 4; ++m) {
                bf16_t* p = p0 + (size_t)(ai * 128 + m * 16) * D;
#pragma unroll
                for (int bj = 0; bj < 2; ++bj) {
                    u32x4 w; w.x = pk2(acc[ai][bj][m][0][0], acc[ai][bj][m][0][1]); w.y = pk2(acc[ai][bj][m][0][2], acc[ai][bj][m][0][3]);
                    w.z = pk2(acc[ai][bj][m][1][0], acc[ai][bj][m][1][1]); w.w = pk2(acc[ai][bj][m][1][2], acc[ai][bj][m][1][3]);
                    *(u32x4*)(p + bj * 128) = w;
                }
            }
    }
};

struct EpiIn {
    int l; const float* g_qa; const float* g_ka; float* out; unsigned char* ws;
    DI void operator()(const f32x4 (&acc)[2][2][4][2], const Unit& u, int wr, int wc, int fr_in, int fq_in) const {
        int fr = fr_in, fq = fq_in; asm volatile("" : "+v"(fr), "+v"(fq));
        const int t = u.pn; const bool prompt = u.pm < 16;
        const float* rope = (const float*)(ws + WS_ROPE);
        bf16_t* const QA = (bf16_t*)(ws + WS_QA); bf16_t* const QB = (bf16_t*)(ws + WS_QB); bf16_t* const KAS = (bf16_t*)(ws + WS_KAS); bf16_t* const VAS = (bf16_t*)(ws + WS_VAS);
        bf16_t* const KBS = (bf16_t*)(ws + WS_KBS); bf16_t* const VBS = (bf16_t*)(ws + WS_VBS); bf16_t* const KAP = (bf16_t*)(ws + WS_KAP); bf16_t* const VAP = (bf16_t*)(ws + WS_VAP);
        bf16_t* const KBP = (bf16_t*)(ws + WS_KBP); bf16_t* const VBP = (bf16_t*)(ws + WS_VBP); bf16_t* const UTP = (bf16_t*)(ws + WS_UTP); bf16_t* const UTS = (bf16_t*)(ws + WS_UTS);
        if (t >= 8) {
            const int cs = t - 8;
#pragma unroll
            for (int ai = 0; ai < 2; ++ai)
#pragma unroll
                for (int m = 0; m < 4; ++m) {
                    const int row = u.pm * 256 + ai * 128 + wr * 64 + m * 16 + fr;
                    bf16_t* base; size_t pitch;
                    if (prompt) { base = UTP + (size_t)(row >> 8) * 256 * 512 + cs * 256 + (row & 255); pitch = 512; }
                    else { const int rs = row - TP; base = UTS + (size_t)(rs >> 12) * 256 * 8192 + cs * 4096 + (rs & 4095); pitch = 8192; }
#pragma unroll
                    for (int bj = 0; bj < 2; ++bj)
#pragma unroll
                        for (int n = 0; n < 2; ++n)
#pragma unroll
                            for (int j = 0; j < 4; ++j) base[(size_t)(bj * 128 + wc * 32 + fq * 8 + n * 4 + j) * pitch] = f2bf(acc[ai][bj][m][n][j]);
                    __builtin_amdgcn_sched_barrier(0);
                }
            return;
        }
        const bool do_norm = (t == 0) || (t == 1 && wc < 2);
        const bool is_v = (t == 1 && wc >= 2) || t >= 6;
        const bool is_q = (t == 0) || t == 2 || t == 3;
        const bool do_rope = !prompt && !is_v;
        const float* gp = (t == 0 ? g_qa : g_ka) + l * 64 + fq * 8;
#pragma unroll
        for (int ai = 0; ai < 2; ++ai)
#pragma unroll
            for (int m = 0; m < 4; ++m) {
                const int row = u.pm * 256 + ai * 128 + wr * 64 + m * 16 + fr;
                int b, pos;
                if (prompt) { b = row >> 8; pos = row & 255; } else { const int rs = row - TP; b = rs >> 12; pos = rs & 4095; }
                float v[2][8];
#pragma unroll
                for (int bj = 0; bj < 2; ++bj)
#pragma unroll
                    for (int n = 0; n < 2; ++n)
#pragma unroll
                        for (int j = 0; j < 4; ++j) v[bj][n * 4 + j] = acc[ai][bj][m][n][j];
                if (do_norm) {
                    float ss = 0.f;
#pragma unroll
                    for (int bj = 0; bj < 2; ++bj)
#pragma unroll
                        for (int e = 0; e < 8; ++e) ss += v[bj][e] * v[bj][e];
                    ss += __shfl_xor(ss, 16); ss += __shfl_xor(ss, 32);
                    const float rs_ = rsqrtf(ss * (1.f / 64.f) + 1e-6f);
#pragma unroll
                    for (int bj = 0; bj < 2; ++bj)
#pragma unroll
                        for (int e = 0; e < 8; ++e) v[bj][e] = v[bj][e] * rs_ * gp[bj * 32 + e];
                }
                if (prompt && !is_q) {
                    float* op;
                    if (t == 1) op = out + (wc < 2 ? 12582912 : 13631488) + ((size_t)((b * 2 + l) * 256 + pos)) * 128 + (wc & 1) * 64;
                    else if (t < 6) op = out + 14680064 + ((size_t)((b * 2 + l) * 256 + pos)) * 512 + ((t - 4) * 4 + wc) * 64;
                    else op = out + 18874368 + ((size_t)((b * 2 + l) * 256 + pos)) * 512 + (t - 6) * 256 + wc * 64;
#pragma unroll
                    for (int bj = 0; bj < 2; ++bj) {
                        *(f32x4*)(op + bj * 32 + fq * 8) = (f32x4){v[bj][0], v[bj][1], v[bj][2], v[bj][3]};
                        *(f32x4*)(op + bj * 32 + fq * 8 + 4) = (f32x4){v[bj][4], v[bj][5], v[bj][6], v[bj][7]};
                    }
                }
                if (do_rope) {
#pragma unroll
                    for (int bj = 0; bj < 2; ++bj) {
                        const int pv_ = bj == 0 ? (pos >> 6) : (pos & 63);
                        const float* rp = rope + (pv_ * 16 + (fq & 1) * 8) * 2;
#pragma unroll
                        for (int e = 0; e < 8; ++e) {
                            const float cc = rp[2 * e], sn = rp[2 * e + 1];
                            const float other = __shfl_xor(v[bj][e], 32);
                            v[bj][e] = v[bj][e] * cc + (fq < 2 ? -other : other) * sn;
                        }
                    }
                }
                if (is_v) {
                    bf16_t* base; size_t pitch;
                    if (t == 1) { const int kvh = wc - 2; if (prompt) { base = VAP + (size_t)(b * 2 + kvh) * 64 * 256 + pos; pitch = 256; } else { base = VAS + (size_t)(b * 2 + kvh) * 64 * LKS + 256 + pos; pitch = LKS; } }
                    else { const int hh = (t - 6) * 2 + (wc >> 1); const int d0 = (wc & 1) * 64;
                        if (prompt) { base = VBP + ((size_t)(b * 4 + hh) * 128 + d0) * 256 + pos; pitch = 256; } else { base = VBS + ((size_t)(b * 4 + hh) * 128 + d0) * LKS + 256 + pos; pitch = LKS; } }
#pragma unroll
                    for (int bj = 0; bj < 2; ++bj)
#pragma unroll
                        for (int e = 0; e < 8; ++e) base[(size_t)(bj * 32 + fq * 8 + e) * pitch] = f2bf(v[bj][e]);
                } else {
                    bf16_t* op;
                    if (t == 0) op = QA + (size_t)row * 256 + wc * 64;
                    else if (t == 1) op = prompt ? KAP + ((size_t)(b * 2 + wc) * 256 + pos) * 64 : KAS + ((size_t)(b * 2 + wc) * LKS + 256 + pos) * 64;
                    else if (t < 4) op = QB + (size_t)row * 512 + ((t - 2) * 4 + wc) * 64;
                    else { const int s = (t - 4) * 4 + wc; op = prompt ? KBP + ((size_t)(b * 8 + s) * 256 + pos) * 64 : KBS + ((size_t)(b * 8 + s) * LKS + 256 + pos) * 64; }
                    const float sc = is_q ? QSCALE : 1.f;
#pragma unroll
                    for (int bj = 0; bj < 2; ++bj) {
                        u32x4 w; w.x = pk2(v[bj][0] * sc, v[bj][1] * sc); w.y = pk2(v[bj][2] * sc, v[bj][3] * sc); w.z = pk2(v[bj][4] * sc, v[bj][5] * sc); w.w = pk2(v[bj][6] * sc, v[bj][7] * sc);
                        *(u32x4*)(op + bj * 32 + fq * 8) = w;
                    }
                }
                __builtin_amdgcn_sched_barrier(0);
            }
    }
};
}

template <int DV>
DI void attn_unit(const bf16_t* __restrict__ Q, int qpitch, const bf16_t* __restrict__ K, const bf16_t* __restrict__ VT, int Lk, bf16_t* __restrict__ O, int opitch, LAS unsigned char* lds) {
    constexpr int KROW = 144, VROW = 136, KBYTES = 64 * KROW, VBYTES = DV * VROW, BUF = KBYTES + VBYTES, NV = DV / 64, NDB = DV / 32;
    int tid = threadIdx.x; asm volatile("" : "+v"(tid));
    const int wave = tid >> 6, lane = tid & 63, r = lane & 31, h = lane >> 5;
    bf16x8 qf[4];
    { const bf16_t* qrow = Q + (size_t)(wave * 32 + r) * qpitch;
#pragma unroll
      for (int s = 0; s < 4; ++s) qf[s] = *(const bf16x8*)(qrow + 16 * s + 8 * h); }
    f32x16 o[NDB];
#pragma unroll
    for (int db = 0; db < NDB; ++db)
#pragma unroll
        for (int i = 0; i < 16; ++i) o[db][i] = 0.f;
    float mrun = 0.f, lrun = 0.f;
    const int skey = tid >> 3, sch = tid & 7;
    const bf16_t* kg = K + (size_t)skey * 64 + sch * 8;
    const bf16_t* vg = VT + (size_t)skey * Lk + sch * 8;
    const unsigned kwoff = skey * KROW + sch * 16, vwoff = KBYTES + skey * VROW + sch * 16;
    u32x4 kreg, vreg[NV];
    kreg = *(const u32x4*)kg;
#pragma unroll
    for (int i = 0; i < NV; ++i) vreg[i] = *(const u32x4*)(vg + (size_t)(64 * i) * Lk);
    *(LAS u32x4*)(lds + kwoff) = kreg;
#pragma unroll
    for (int i = 0; i < NV; ++i) { *(LAS u32x2*)(lds + vwoff + i * 64 * VROW) = (u32x2){vreg[i].x, vreg[i].y}; *(LAS u32x2*)(lds + vwoff + i * 64 * VROW + 8) = (u32x2){vreg[i].z, vreg[i].w}; }
    __syncthreads();
    const int nt = Lk >> 6;
    for (int kt = 0; kt < nt; ++kt) {
        LAS unsigned char* cb = lds + (kt & 1) * BUF;
        LAS unsigned char* nb = lds + ((kt & 1) ^ 1) * BUF;
        const bool more = kt + 1 < nt;
        if (more) {
            kreg = *(const u32x4*)(kg + (size_t)(kt + 1) * 64 * 64);
#pragma unroll
            for (int i = 0; i < NV; ++i) vreg[i] = *(const u32x4*)(vg + (size_t)(64 * i) * Lk + (kt + 1) * 64);
        }
        f32x16 s0, s1;
        { const float nm = -mrun;
#pragma unroll
          for (int i = 0; i < 16; ++i) { s0[i] = nm; s1[i] = nm; } }
#pragma unroll
        for (int s = 0; s < 4; ++s) {
            const bf16x8 k0 = *(const LAS bf16x8*)(cb + r * KROW + (16 * s + 8 * h) * 2);
            const bf16x8 k1 = *(const LAS bf16x8*)(cb + (32 + r) * KROW + (16 * s + 8 * h) * 2);
            s0 = __builtin_amdgcn_mfma_f32_32x32x16_bf16(k0, qf[s], s0, 0, 0, 0);
            s1 = __builtin_amdgcn_mfma_f32_32x32x16_bf16(k1, qf[s], s1, 0, 0, 0);
        }
        float mxa[8];
#pragma unroll
        for (int i = 0; i < 8; ++i) mxa[i] = fmaxf(fmaxf(s0[2 * i], s0[2 * i + 1]), fmaxf(s1[2 * i], s1[2 * i + 1]));
        float mx = fmaxf(fmaxf(fmaxf(mxa[0], mxa[1]), fmaxf(mxa[2], mxa[3])), fmaxf(fmaxf(mxa[4], mxa[5]), fmaxf(mxa[6], mxa[7])));
        mx = fmaxf(mx, __shfl_xor(mx, 32));
        if (__builtin_amdgcn_ballot_w64(mx > 8.f) != 0ull) {
            const float dlt = fmaxf(mx, 0.f);
            const float alpha = __builtin_amdgcn_exp2f(-dlt);
            mrun += dlt; lrun *= alpha;
#pragma unroll
            for (int db = 0; db < NDB; ++db)
#pragma unroll
                for (int i = 0; i < 16; ++i) o[db][i] *= alpha;
#pragma unroll
            for (int i = 0; i < 16; ++i) { s0[i] -= dlt; s1[i] -= dlt; }
        }
        f32x2_t rs2 = {0.f, 0.f};
#pragma unroll
        for (int i = 0; i < 16; ++i) { s0[i] = __builtin_amdgcn_exp2f(s0[i]); s1[i] = __builtin_amdgcn_exp2f(s1[i]); }
#pragma unroll
        for (int i = 0; i < 8; ++i) { rs2 += (f32x2_t){s0[2 * i], s0[2 * i + 1]}; rs2 += (f32x2_t){s1[2 * i], s1[2 * i + 1]}; }
        lrun += rs2.x + rs2.y;
#pragma unroll
        for (int kb = 0; kb < 2; ++kb)
#pragma unroll
            for (int s2 = 0; s2 < 2; ++s2) {
                u32x4 pw;
                if (kb == 0) { pw.x = pk2(s0[8 * s2 + 0], s0[8 * s2 + 1]); pw.y = pk2(s0[8 * s2 + 2], s0[8 * s2 + 3]); pw.z = pk2(s0[8 * s2 + 4], s0[8 * s2 + 5]); pw.w = pk2(s0[8 * s2 + 6], s0[8 * s2 + 7]); }
                else { pw.x = pk2(s1[8 * s2 + 0], s1[8 * s2 + 1]); pw.y = pk2(s1[8 * s2 + 2], s1[8 * s2 + 3]); pw.z = pk2(s1[8 * s2 + 4], s1[8 * s2 + 5]); pw.w = pk2(s1[8 * s2 + 6], s1[8 * s2 + 7]); }
                const bf16x8 pf = __builtin_bit_cast(bf16x8, pw);
#pragma unroll
                for (int db = 0; db < NDB; ++db) {
                    const LAS unsigned char* vp = cb + KBYTES + (32 * db + r) * VROW + (32 * kb + 16 * s2 + 4 * h) * 2;
                    const u32x2 lo = *(const LAS u32x2*)vp, hi = *(const LAS u32x2*)(vp + 16);
                    const u32x4 vw = {lo.x, lo.y, hi.x, hi.y};
                    o[db] = __builtin_amdgcn_mfma_f32_32x32x16_bf16(__builtin_bit_cast(bf16x8, vw), pf, o[db], 0, 0, 0);
                }
                    }
        if (more) {
            *(LAS u32x4*)(nb + kwoff) = kreg;
#pragma unroll
            for (int i = 0; i < NV; ++i) { *(LAS u32x2*)(nb + vwoff + i * 64 * VROW) = (u32x2){vreg[i].x, vreg[i].y}; *(LAS u32x2*)(nb + vwoff + i * 64 * VROW + 8) = (u32x2){vreg[i].z, vreg[i].w}; }
        }
        __syncthreads();
    }
    lrun += __shfl_xor(lrun, 32);
    const float inv = 1.f / lrun;
    bf16_t* orow = O + (size_t)(wave * 32 + r) * opitch;
#pragma unroll
    for (int db = 0; db < NDB; ++db)
#pragma unroll
        for (int g = 0; g < 4; ++g) {
            u32x2 w; w.x = pk2(o[db][4 * g] * inv, o[db][4 * g + 1] * inv); w.y = pk2(o[db][4 * g + 2] * inv, o[db][4 * g + 3] * inv);
            *(u32x2*)(orow + 32 * db + 8 * g + 4 * h) = w;
        }
}

template <int MODE> DI int srccol(int np) {
    if (MODE == 1) { const int pn = np >> 8, j = np & 255; return j < 128 ? 128 * pn + j : FF + 128 * pn + (j - 128); }
    if (MODE == 2) { const int t = np >> 8, p = np & 255; return 256 * t + 64 * ((p >> 5) & 3) + 32 * (p >> 7) + (p & 31); }
    return np;
}
DI void tr_item(const float* __restrict__ src, int Nsrc, int mode, int n0, int k0, bf16_t* __restrict__ dst, int ldd, LAS float* tile, int tid) {
    const int nn = tid & 63, kq = tid >> 6;
    int sc0, sc1;
    if (mode == 1) { sc0 = srccol<1>(n0 + nn); sc1 = srccol<1>(n0 + nn + 64); } else if (mode == 2) { sc0 = srccol<2>(n0 + nn); sc1 = srccol<2>(n0 + nn + 64); } else { sc0 = n0 + nn; sc1 = n0 + nn + 64; }
    float v0[8], v1[8];
#pragma unroll
    for (int i = 0; i < 8; ++i) { const float* rp = src + (size_t)(k0 + kq + 8 * i) * Nsrc; v0[i] = rp[sc0]; v1[i] = rp[sc1]; }
#pragma unroll
    for (int i = 0; i < 8; ++i) { tile[(kq + 8 * i) * 129 + nn] = v0[i]; tile[(kq + 8 * i) * 129 + nn + 64] = v1[i]; }
    __syncthreads();
    const int n2 = tid >> 3, kc = tid & 7;
#pragma unroll
    for (int hh = 0; hh < 2; ++hh) {
        const int nr = n2 + 64 * hh;
        u32x4 w;
        w.x = pk2(tile[(8 * kc + 0) * 129 + nr], tile[(8 * kc + 1) * 129 + nr]); w.y = pk2(tile[(8 * kc + 2) * 129 + nr], tile[(8 * kc + 3) * 129 + nr]);
        w.z = pk2(tile[(8 * kc + 4) * 129 + nr], tile[(8 * kc + 5) * 129 + nr]); w.w = pk2(tile[(8 * kc + 6) * 129 + nr], tile[(8 * kc + 7) * 129 + nr]);
        *(u32x4*)(dst + (size_t)(n0 + nr) * ldd + k0 + 8 * kc) = w;
    }
    __syncthreads();
}

DI void convert_layer(KP a, int l, LAS unsigned char* lds) {
    unsigned char* ws = a->ws; const int tid = otid(), G = gridDim.x;
    LAS float* tile = (LAS float*)(lds + 32768);
    LAS float* t64 = (LAS float*)(lds + 98304);
    __syncthreads();
    if (tid < 64) t64[tid] = cospif((float)tid * (1.f / 32.f));
    __syncthreads();
    for (int it = blockIdx.x; it < 2464; it += G) {
        const float* src; bf16_t* dst; int Nsrc, nkt, ldd, mode, j;
        if (it < 704) { j = it; src = a->in[20] + (size_t)l * D * 2 * FF; Nsrc = 2 * FF; nkt = 16; dst = (bf16_t*)(ws + WS_WGU1); ldd = D; mode = 1; }
        else if (it < 1056) { j = it - 704; src = a->in[21] + (size_t)l * FF * D; Nsrc = D; nkt = 44; dst = (bf16_t*)(ws + WS_WD1); ldd = FF; mode = 0; }
        else if (it < 1312) { j = it - 1056; src = a->in[10] + (size_t)l * D * 2304; Nsrc = 2304; nkt = 16; dst = (bf16_t*)(ws + WS_WIN); ldd = D; mode = 2; }
        else if (it < 1408) { j = it - 1312; src = a->in[19] + (size_t)l * D * D; Nsrc = D; nkt = 12; dst = (bf16_t*)(ws + WS_WOUT); ldd = D; mode = 0; }
        else if (it < 2112) { j = it - 1408; src = a->in[22] + (size_t)l * D * 2 * FF; Nsrc = 2 * FF; nkt = 16; dst = (bf16_t*)(ws + WS_WGU2); ldd = D; mode = 1; }
        else { j = it - 2112; src = a->in[23] + (size_t)l * FF * D; Nsrc = D; nkt = 44; dst = (bf16_t*)(ws + WS_WD2); ldd = FF; mode = 0; }
        tr_item(src, Nsrc, mode, (j / nkt) * 128, (j % nkt) * 64, dst, ldd, tile, tid);
    }
    { bf16_t* WinT = (bf16_t*)(ws + WS_WIN); LAS float* wt = tile;
      for (int it = blockIdx.x; it < 128; it += G) {
          const int cs = it & 1, kb = (it >> 1) & 15, g = it >> 5;
#pragma unroll
          for (int e = 0; e < 8; ++e) { const int idx = tid + 512 * e, kd = idx >> 6, cc = idx & 63; wt[kd * 65 + cc] = a->in[10][((size_t)l * D + kb * 64 + kd) * 2304 + 2048 + g * 64 + cc]; }
          __syncthreads();
          const int kd = tid & 63, kq = tid >> 6;
          float acc[8];
#pragma unroll
          for (int e = 0; e < 8; ++e) acc[e] = 0.f;
          for (int cc = 0; cc < 64; ++cc) {
              const float x = wt[kd * 65 + cc];
#pragma unroll
              for (int e = 0; e < 8; ++e) { const int idx = ((kq * 8 + e) * cc - (cs ? 16 : 0)) & 63; acc[e] += x * t64[idx]; }
          }
#pragma unroll
          for (int e = 0; e < 8; ++e) WinT[(size_t)(2048 + cs * 256 + g * 64 + kq * 8 + e) * D + kb * 64 + kd] = f2bf(acc[e]);
          __syncthreads();
      } }
    { bf16_t* WoutT = (bf16_t*)(ws + WS_WOUT); LAS float* wfs = tile; LAS float* red = (LAS float*)lds;
      for (int it = blockIdx.x; it < 256; it += G) {
          const int ib = it >> 4, nb = it & 15;
#pragma unroll
          for (int e = 0; e < 8; ++e) { const int idx = tid + 512 * e, i = idx >> 8, j = idx & 255; wfs[j * 17 + i] = a->in[18][((size_t)l * 256 + ib * 16 + i) * 256 + j]; }
          __syncthreads();
          const int w = tid >> 6, lane = tid & 63;
          const float* wo = a->in[19] + ((size_t)l * D + 768 + w * 32) * D + nb * 64 + lane;
          float acc[16];
#pragma unroll
          for (int i = 0; i < 16; ++i) acc[i] = 0.f;
#pragma unroll 8
          for (int jj = 0; jj < 32; ++jj) { const float x = wo[(size_t)jj * D];
#pragma unroll
              for (int i = 0; i < 16; ++i) acc[i] += x * wfs[(w * 32 + jj) * 17 + i]; }
#pragma unroll
          for (int i = 0; i < 16; ++i) red[(w * 16 + i) * 64 + lane] = acc[i];
          __syncthreads();
#pragma unroll
          for (int hh = 0; hh < 2; ++hh) { const int i = (tid >> 6) + 8 * hh; float sacc = 0.f;
#pragma unroll
              for (int q = 0; q < 8; ++q) sacc += red[(q * 16 + i) * 64 + lane];
              WoutT[(size_t)(nb * 64 + lane) * D + 768 + ib * 16 + i] = f2bf(sacc); }
          __syncthreads();
      } }
    { bf16_t* KAS = (bf16_t*)(ws + WS_KAS); bf16_t* VAS = (bf16_t*)(ws + WS_VAS); bf16_t* KBS = (bf16_t*)(ws + WS_KBS); bf16_t* VBS = (bf16_t*)(ws + WS_VBS);
      for (int i = blockIdx.x * 512 + tid; i < 2 * 256 * 1280; i += G * 512) {
          const int e = i % 1280, bp = i / 1280, b = bp >> 8, pos = bp & 255;
          const size_t cbase = (size_t)((b * 2 + l) * 256 + pos);
          if (e < 128) { const int kvh = e >> 6, d = e & 63; KAS[((size_t)(b * 2 + kvh) * LKS + pos) * 64 + d] = f2bf(a->in[2][cbase * 128 + e]); }
          else if (e < 256) { const int e2 = e - 128, kvh = e2 >> 6, d = e2 & 63; VAS[((size_t)(b * 2 + kvh) * 64 + d) * LKS + pos] = f2bf(a->in[3][cbase * 128 + e2]); }
          else if (e < 768) { const int e2 = e - 256, s = e2 >> 6, d = e2 & 63; KBS[((size_t)(b * 8 + s) * LKS + pos) * 64 + d] = f2bf(a->in[4][cbase * 512 + e2]); }
          else { const int e2 = e - 768, hh = e2 >> 7, d = e2 & 127; VBS[((size_t)(b * 4 + hh) * 128 + d) * LKS + pos] = f2bf(a->in[5][cbase * 512 + e2]); }
      } }
    __syncthreads();
}

DI void p0_prologue(KP a, LAS unsigned char* lds) {
    unsigned char* ws = a->ws; const int tid = otid(), G = gridDim.x;
    { LAS float* sv = (LAS float*)lds; LAS float* red = (LAS float*)(lds + 16384);
      for (int i = tid; i < 3072; i += 512) { const int m = i >> 10, k = i & 1023; const float cv = (m == 0) ? a->in[7][k] : a->in[6][(m - 1) * D + k]; sv[i] = cv / (1.f + __expf(-cv)); }
      __syncthreads();
      float* MOD = (float*)(ws + WS_MOD);
      for (int it = blockIdx.x; it < 256; it += G) {
          const int col0 = it * 72, l = col0 / 9216, c0 = col0 % 9216, kg = tid / 72, cc = tid % 72;
          float a0 = 0.f, a1 = 0.f, a2 = 0.f;
          if (kg < 7) { const float* w = a->in[8] + (size_t)l * D * 9216 + c0 + cc;
#pragma unroll 8
              for (int k = kg; k < D; k += 7) { const float wv = w[(size_t)k * 9216]; a0 += sv[k] * wv; a1 += sv[1024 + k] * wv; a2 += sv[2048 + k] * wv; }
              red[(kg * 3 + 0) * 72 + cc] = a0; red[(kg * 3 + 1) * 72 + cc] = a1; red[(kg * 3 + 2) * 72 + cc] = a2; }
          __syncthreads();
          if (tid < 216) { const int m = tid / 72, c2 = tid % 72; float s = 0.f;
#pragma unroll
              for (int q = 0; q < 7; ++q) s += red[(q * 3 + m) * 72 + c2];
              MOD[(size_t)(l * 3 + m) * 9216 + c0 + c2] = s + a->in[9][l * 9216 + c0 + c2]; }
          __syncthreads();
      } }
    if (blockIdx.x == G - 1) {
        float* ROPE = (float*)(ws + WS_ROPE);
        for (int i = tid; i < 1024; i += 512) { const int pos = i >> 4, f = i & 15;
            const float inv = exp2f(-(float)f * (13.2877123795f / 16.f)); float rev = (float)pos * inv * 0.15915494309f; rev -= floorf(rev);
            ROPE[2 * i] = cospif(2.f * rev); ROPE[2 * i + 1] = sinpif(2.f * rev); }
    }
    { LAS float* tab = (LAS float*)lds;
      __syncthreads();
      for (int i = tid; i < 4096; i += 512) tab[i] = cospif((float)i * (1.f / 2048.f));
      __syncthreads();
      bf16_t* DS = (bf16_t*)(ws + WS_DFTS);
      for (int p = blockIdx.x; p < 4096; p += G)
          for (int ch = tid; ch < 1024; ch += 512) {
              const int k0 = ch * 8, n0 = k0 & 4095; const bool sp = k0 >= 4096; float v[8];
#pragma unroll
              for (int e = 0; e < 8; ++e) { const int idx = (p * (n0 + e)) & 4095; v[e] = (sp ? -tab[(idx - 1024) & 4095] : tab[idx]) * (1.f / 512.f); }
              u32x4 w; w.x = pk2(v[0], v[1]); w.y = pk2(v[2], v[3]); w.z = pk2(v[4], v[5]); w.w = pk2(v[6], v[7]);
              *(u32x4*)(DS + (size_t)p * 8192 + k0) = w;
          }
      bf16_t* DP = (bf16_t*)(ws + WS_DFTP);
      for (int p = blockIdx.x; p < 256; p += G)
          if (tid < 64) {
              const int k0 = tid * 8, n0 = k0 & 255; const bool sp = k0 >= 256; float v[8];
#pragma unroll
              for (int e = 0; e < 8; ++e) { const int idx = ((p * (n0 + e)) & 255) * 16; v[e] = (sp ? -tab[(idx - 1024) & 4095] : tab[idx]) * (1.f / 128.f); }
              u32x4 w; w.x = pk2(v[0], v[1]); w.y = pk2(v[2], v[3]); w.z = pk2(v[4], v[5]); w.w = pk2(v[6], v[7]);
              *(u32x4*)(DP + (size_t)p * 512 + k0) = w;
          }
      __syncthreads(); }
    convert_layer(a, 0, lds);
}

DI void p_modulate0(KP a) {
    const float* MOD = (const float*)(a->ws + WS_MOD); bf16_t* H = (bf16_t*)(a->ws + WS_H);
    for (int i = blockIdx.x * 512 + otid(); i < T * 128; i += gridDim.x * 512) {
        const int row = i >> 7, c0 = (i & 127) * 8;
        const float* sp = (row < TP) ? a->in[0] + (size_t)row * D : a->in[1] + (size_t)(row - TP) * D;
        const float* md = MOD + (size_t)(row < TP ? 0 : 1 + ((row - TP) >> 12)) * 9216;
        float v[8];
#pragma unroll
        for (int q = 0; q < 2; ++q) { const f32x4 x = *(const f32x4*)(sp + c0 + 4 * q), sh = *(const f32x4*)(md + c0 + 4 * q), sc = *(const f32x4*)(md + 1024 + c0 + 4 * q);
#pragma unroll
            for (int e = 0; e < 4; ++e) v[4 * q + e] = x[e] * (1.f + sc[e]) + sh[e]; }
        u32x4 w; w.x = pk2(v[0], v[1]); w.y = pk2(v[2], v[3]); w.z = pk2(v[4], v[5]); w.w = pk2(v[6], v[7]);
        *(u32x4*)(H + (size_t)row * D + c0) = w;
    }
}

DI void p_layernorm(const float* X, float* xo, bf16_t* H, const float* g, const float* bta, const float* modn  ) {
    const int tid = otid(), wave = tid >> 6, lane = tid & 63;
    for (int row = blockIdx.x * 8 + wave; row < T; row += gridDim.x * 8) {
        f32x4 v[4];
#pragma unroll
        for (int i = 0; i < 4; ++i) v[i] = *(const f32x4*)(X + (size_t)row * D + i * 256 + lane * 4);
        float s = 0.f;
#pragma unroll
        for (int i = 0; i < 4; ++i) s += (v[i][0] + v[i][1]) + (v[i][2] + v[i][3]);
        const float mean = wave_sum(s) * (1.f / 1024.f);
        float q = 0.f;
#pragma unroll
        for (int i = 0; i < 4; ++i) { v[i] = v[i] - mean; q += (v[i][0] * v[i][0] + v[i][1] * v[i][1]) + (v[i][2] * v[i][2] + v[i][3] * v[i][3]); }
        const float rstd = rsqrtf(wave_sum(q) * (1.f / 1024.f) + 1e-5f);
        const float* md = modn ? modn + (size_t)(row < TP ? 0 : 1 + ((row - TP) >> 12)) * 9216 : nullptr;
#pragma unroll
        for (int i = 0; i < 4; ++i) {
            const int c = i * 256 + lane * 4;
            const f32x4 y = v[i] * rstd * *(const f32x4*)(g + c) + *(const f32x4*)(bta + c);
            *(f32x4*)(xo + (size_t)row * D + c) = y;
            if (md) { const f32x4 sh = *(const f32x4*)(md + c), sc = *(const f32x4*)(md + 1024 + c);
                u32x2 w; w.x = pk2(y[0] * (1.f + sc[0]) + sh[0], y[1] * (1.f + sc[1]) + sh[1]); w.y = pk2(y[2] * (1.f + sc[2]) + sh[2], y[3] * (1.f + sc[3]) + sh[3]);
                *(u32x2*)(H + (size_t)row * D + c) = w; }
        }
    }
}

DI void p_combine(KP a, int l) {
    const int tid = otid(), wave = tid >> 6, lane = tid & 63;
    const bf16_t* OBT = (const bf16_t*)(a->ws + WS_H); bf16_t* MIX = (bf16_t*)(a->ws + WS_MIX);
    const float lam_init = (l == 0) ? 0.2f : (0.8f - 0.6f * 0.74081822068f);
    const float d1 = wave_sum(a->in[13][l * 64 + lane] * a->in[14][l * 64 + lane]), d2 = wave_sum(a->in[15][l * 64 + lane] * a->in[16][l * 64 + lane]);
    const float lam = expf(d1) - expf(d2) + lam_init;
    const float g0 = a->in[17][l * 128 + 2 * lane] * (1.f - lam_init), g1 = a->in[17][l * 128 + 2 * lane + 1] * (1.f - lam_init);
    for (int row = blockIdx.x * 8 + wave; row < T; row += gridDim.x * 8) {
#pragma unroll
        for (int hb = 0; hb < 4; ++hb) {
            const unsigned w1 = *(const unsigned*)(OBT + (size_t)row * D + hb * 256 + 2 * lane), w2 = *(const unsigned*)(OBT + (size_t)row * D + hb * 256 + 128 + 2 * lane);
            const float x0 = __uint_as_float(w1 << 16) - lam * __uint_as_float(w2 << 16), x1 = __uint_as_float(w1 & 0xffff0000u) - lam * __uint_as_float(w2 & 0xffff0000u);
            const float rs = rsqrtf(wave_sum(x0 * x0 + x1 * x1) * (1.f / 128.f) + 1e-6f);
            *(unsigned*)(MIX + (size_t)row * D + 256 + hb * 128 + 2 * lane) = pk2(x0 * rs * g0, x1 * rs * g1);
        }
    }
}


#define XB_TMO      128
#define XB_XCNT(j)  (256  + 64 * (j))
#define XB_XSUB(j)  (1280 + 64 * (j))
#define XB_XGEN(j)  (2304 + 64 * (j))
#define XB_TOP      3328
#define XB_TOPGEN   3392
#define XCD_BAR_WORDS 3456
#define XB_SPIN_CAP (1u << 18)
DI unsigned xb_ld(unsigned* p)              { return __hip_atomic_load(p, __ATOMIC_RELAXED, __HIP_MEMORY_SCOPE_AGENT); }
DI unsigned xb_add(unsigned* p, unsigned v) { return __hip_atomic_fetch_add(p, v, __ATOMIC_RELAXED, __HIP_MEMORY_SCOPE_AGENT); }
DI unsigned xb_xcc_id() { return (unsigned)__builtin_amdgcn_s_getreg((3 << 11) | 20) & 0xFu; }
#define XB_SPIN(cond, bar) do { unsigned _sp = 0; while (cond) { __builtin_amdgcn_s_sleep(1); \
    if ((++_sp & 255u) == 0u) { if (xb_ld(&(bar)[XB_TMO])) break; if (_sp > XB_SPIN_CAP) { atomicAdd(&(bar)[XB_TMO], 1u); break; } } } } while (0)
struct XcdBarrier { unsigned* bar; unsigned x; volatile LAS unsigned* st; };
DI XcdBarrier xcd_barrier_post(unsigned* bar, volatile LAS unsigned* st) {
    XcdBarrier b; b.bar = bar; b.x = xb_xcc_id(); b.st = st;
    if (threadIdx.x == 0) (void)xb_add(&bar[XB_XCNT(b.x)], 1u);
    return b;
}
DI void xcd_barrier_complete(unsigned* bar, unsigned x, unsigned& nloc, unsigned& nx) {
    const unsigned G = gridDim.x * gridDim.y * gridDim.z;
    unsigned sum, cnt, mine, sp = 0u;
    for (;;) {
        sum = 0u; cnt = 0u; mine = 0u;
#pragma unroll
        for (unsigned j = 0; j < 16; ++j) { const unsigned c = xb_ld(&bar[XB_XCNT(j)]); sum += c; cnt += (c > 0u) ? 1u : 0u; mine = (j == x) ? c : mine; }
        if (sum == G) break;
        __builtin_amdgcn_s_sleep(1);
        if ((++sp & 255u) == 0u) { if (xb_ld(&bar[XB_TMO])) break; if (sp > XB_SPIN_CAP) { atomicAdd(&bar[XB_TMO], 1u); break; } }
    }
    nloc = mine > 0u ? mine : 1u; nx = cnt > 0u ? cnt : 1u;
}
DI void xcd_barrier(const XcdBarrier& b) {
    asm volatile("s_waitcnt vmcnt(0)" ::: "memory");
    __syncthreads();
    if (threadIdx.x == 0) {
        unsigned* bar = b.bar;
        __builtin_amdgcn_s_waitcnt(0);
        unsigned nloc = b.st[0], nx = b.st[1];
        if (nloc == 0u) { xcd_barrier_complete(bar, b.x, nloc, nx); b.st[0] = nloc; b.st[1] = nx; }
        const unsigned old = xb_add(&bar[XB_XSUB(b.x)], 1u);
        const unsigned gen = old / nloc;
        if (old + 1u == (gen + 1u) * nloc) {
            __builtin_amdgcn_fence(__ATOMIC_RELEASE, "agent");
            asm volatile("s_waitcnt vmcnt(0)" ::: "memory");
            const unsigned og = xb_add(&bar[XB_TOP], 1u);
            const unsigned tg = og / nx;
            if (og + 1u == (tg + 1u) * nx) xb_add(&bar[XB_TOPGEN], 1u);
            else XB_SPIN(xb_ld(&bar[XB_TOPGEN]) == tg, bar);
            __builtin_amdgcn_fence(__ATOMIC_ACQUIRE, "agent");
            xb_add(&bar[XB_XGEN(b.x)], 1u);
            asm volatile("s_waitcnt vmcnt(0)" ::: "memory");
        } else {
            XB_SPIN(xb_ld(&bar[XB_XGEN(b.x)]) == gen, bar);
            __builtin_amdgcn_fence(__ATOMIC_ACQUIRE, "agent");
            asm volatile("s_waitcnt vmcnt(0)" ::: "memory");
        }
    }
    __syncthreads();
}

#ifndef PROBE_MASK
#define PROBE_MASK 0
#endif
constexpr int N_PHASES = 24;
#define PHM(i) ((MASK >> (i)) & 1)
template <int MASK> __global__ void __launch_bounds__(512) trunk_fwd(KArgs a_unused) {
    extern __shared__ __attribute__((aligned(16))) unsigned char lds_raw[];
    LAS unsigned char* lds = (LAS unsigned char*)lds_raw;
    cg::grid_group grid = cg::this_grid();
    const KP a0 = (KP)__builtin_amdgcn_kernarg_segment_ptr();
    unsigned char* ws = a0->ws;
    const int G = gridDim.x, c = blockIdx.x;
    float* X = (float*)(ws + WS_X); bf16_t* H = (bf16_t*)(ws + WS_H); bf16_t* ACT = (bf16_t*)(ws + WS_ACT); bf16_t* MIX = (bf16_t*)(ws + WS_MIX);
    const float* MOD = (const float*)(ws + WS_MOD);
    volatile LAS unsigned* misc = (volatile LAS unsigned*)(lds + MISC_OFF);
    if (threadIdx.x < 16) misc[threadIdx.x] = 0u;
    __syncthreads();
    XcdBarrier xbar = xcd_barrier_post((unsigned*)(ws + WS_CTL) + 64, misc + 8);
    const int ph_lo = a0->ph_lo, ph_hi = a0->ph_hi;
    int redo = 0;
    for (int ph = ph_lo; ph < ph_hi; ++ph) {
        const int tid = otid();
        KP a = a0; asm volatile("" : "+s"(a));
        int kbit; if (ph < 2) kbit = ph; else { const int k_ = (ph - 2) % 11; kbit = (k_ == 0 || k_ == 8) ? 2 : (k_ == 1 || k_ == 9 || k_ == 6) ? 3 : (k_ == 2 || k_ == 7 || k_ == 10) ? 4 : (k_ == 3) ? 5 : (k_ == 4) ? 7 : 8; }
        const int rep = redo;
        {
        if (ph == 0) { if (PHM(0)) p0_prologue(a, lds); }
        else if (ph == 1) { if (PHM(1)) p_modulate0(a); }
        else {
            const int l = (ph - 2) / 11, k = (ph - 2) % 11;
            const float* modl = MOD + (size_t)l * 3 * 9216;
            if (k == 0 || k == 8) { if (PHM(2)) {
                pg8::Gemm g{H, (const bf16_t*)(ws + (k == 0 ? WS_WGU1 : WS_WGU2)), D, D}; pg8::StaticOrder S; S.init(T, 2 * FF, G, c);
                pg8::EpiGU E{ACT};
                pg8::gemm_phase<pg8::EpiGU, pg8::StaticOrder, true, true>(lds, g, S, E); }
            } else if (k == 1 || k == 9 || k == 6) { if (PHM(3)) {
                pg8::Gemm g; pg8::EpiRes E;
                if (k == 6) { g = pg8::Gemm{MIX, (const bf16_t*)(ws + WS_WOUT), D, D}; E = pg8::EpiRes{X, X + (size_t)TP * D, X, modl + 5 * 1024, 1.0f}; }
                else { g = pg8::Gemm{ACT, (const bf16_t*)(ws + (k == 1 ? WS_WD1 : WS_WD2)), FF, FF};
                    const bool first = (l == 0 && k == 1);
                    E = pg8::EpiRes{first ? a->in[0] : X, first ? a->in[1] : X + (size_t)TP * D, X, modl + (k == 1 ? 2 : 8) * 1024, 0.5f}; }
                pg8::StaticOrder S; S.init(T, D, G, c);
                pg8::gemm_phase<pg8::EpiRes, pg8::StaticOrder, true, true>(lds, g, S, E); }
            } else if (k == 2 || k == 7 || k == 10) { if (PHM(4)) {
                const int which = (k == 2) ? 0 : (k == 7 ? 1 : 2);
                const float* lg = a->in[24] + (size_t)(l * 3 + which) * D; const float* lb = a->in[25] + (size_t)(l * 3 + which) * D;
                const bool final_ = (l == 1 && k == 10);
                const float* modn = (k == 2) ? modl + 3 * 1024 : (k == 7) ? modl + 6 * 1024 : (final_ ? nullptr : MOD + (size_t)(l + 1) * 3 * 9216);
                p_layernorm(X, final_ ? a->out : X, H, lg, lb, modn);
                if (k == 10 && l == 0) convert_layer(a, 1, lds); }
            } else if (k == 3) { if (PHM(5)) {
                pg8::Gemm g{H, (const bf16_t*)(ws + WS_WIN), D, D}; pg8::StaticOrder S; S.init(T, NIN, G, c);
                pg8::EpiIn E{l, a->in[11], a->in[12], a->out, ws};
                pg8::gemm_phase<pg8::EpiIn, pg8::StaticOrder, true, true>(lds, g, S, E); }
            } else if (k == 4) {
                if (PHM(6) && (rep == 0 || ((PROBE_MASK >> 6) & 1))) {
#pragma clang loop unroll(disable)
                    for (int pass = 0; pass < 2; ++pass) {
                        const bool sp = pass == 0;
                        pg8::Gemm g{(const bf16_t*)(ws + (sp ? WS_DFTS : WS_DFTP)), (const bf16_t*)(ws + (sp ? WS_UTS : WS_UTP)), sp ? 8192 : 512, sp ? 8192 : 512};
                        pg8::FourOrder S{G, c, sp ? 32 : 16, pass}; pg8::EpiFour E{MIX, pass};
                        pg8::gemm_phase<pg8::EpiFour, pg8::FourOrder, true, true>(lds, g, S, E);
                    }
                }
                volatile LAS int* qslot = (volatile LAS int*)(lds + MISC_OFF);
                unsigned* ctr = (unsigned*)(ws + WS_CTL) + l + 2 * rep;
                const bf16_t* QA = (const bf16_t*)(ws + WS_QA); const bf16_t* QB = (const bf16_t*)(ws + WS_QB);
                bf16_t* OBT = (bf16_t*)(ws + WS_H);
                if (PHM(7) && (rep == 0 || ((PROBE_MASK >> 7) & 1))) for (;;) {
                    __syncthreads();
                    if (tid == 0) *qslot = (int)atomicAdd(ctr, 1u);
                    __syncthreads();
                    const int idx = *qslot;
                    if (idx >= 576) break;
                    const bf16_t *Qp, *Kp, *Vp; bf16_t* Op; int qpitch, Lk; bool wide;
                    if (idx < 256) { const int b = idx >> 7, s = (idx >> 4) & 7, qb = idx & 15; const size_t tok0 = TP + b * 4096 + qb * 256; wide = true; qpitch = 512; Lk = LKS;
                        Qp = QB + tok0 * 512 + s * 64; Kp = (const bf16_t*)(ws + WS_KBS) + (size_t)(b * 8 + s) * LKS * 64; Vp = (const bf16_t*)(ws + WS_VBS) + (size_t)(b * 4 + (s >> 1)) * 128 * LKS; Op = OBT + tok0 * D + s * 128; }
                    else if (idx < 384) { const int i = idx - 256, b = i >> 6, hq = (i >> 4) & 3, qb = i & 15; const size_t tok0 = TP + b * 4096 + qb * 256; wide = false; qpitch = 256; Lk = LKS;
                        Qp = QA + tok0 * 256 + hq * 64; Kp = (const bf16_t*)(ws + WS_KAS) + (size_t)(b * 2 + (hq >> 1)) * LKS * 64; Vp = (const bf16_t*)(ws + WS_VAS) + (size_t)(b * 2 + (hq >> 1)) * 64 * LKS; Op = MIX + tok0 * D + hq * 64; }
                    else if (idx < 512) { const int i = idx - 384, b = i >> 3, s = i & 7; const size_t tok0 = b * 256; wide = true; qpitch = 512; Lk = 256;
                        Qp = QB + tok0 * 512 + s * 64; Kp = (const bf16_t*)(ws + WS_KBP) + (size_t)(b * 8 + s) * 256 * 64; Vp = (const bf16_t*)(ws + WS_VBP) + (size_t)(b * 4 + (s >> 1)) * 128 * 256; Op = OBT + tok0 * D + s * 128; }
                    else { const int i = idx - 512, b = i >> 2, hq = i & 3; const size_t tok0 = b * 256; wide = false; qpitch = 256; Lk = 256;
                        Qp = QA + tok0 * 256 + hq * 64; Kp = (const bf16_t*)(ws + WS_KAP) + (size_t)(b * 2 + (hq >> 1)) * 256 * 64; Vp = (const bf16_t*)(ws + WS_VAP) + (size_t)(b * 2 + (hq >> 1)) * 64 * 256; Op = MIX + tok0 * D + hq * 64; }
                    if (wide) attn_unit<128>(Qp, qpitch, Kp, Vp, Lk, Op, D, lds); else attn_unit<64>(Qp, qpitch, Kp, Vp, Lk, Op, D, lds);
                }
            } else if (k == 5) {
                if (PHM(8)) p_combine(a, l);
            }
        }
        }
        if (ph + 1 < ph_hi || (PROBE_MASK && redo == 0)) { if (ph == 0 && redo == 0 && !((PROBE_MASK >> 0) & 1)) grid.sync(); else if (ph == 0 && redo == 1) grid.sync(); else xcd_barrier(xbar); }
        if ((((PROBE_MASK >> kbit) & 1) || (kbit == 7 && ((PROBE_MASK >> 6) & 1))) && redo == 0) { redo = 1; --ph; } else redo = 0;
    }
}

typedef void (*kern_t)(KArgs);
extern "C" void kernel_launch(void* const* d_in, const int* in_sizes, int n_in, void* d_out, int out_size, void* d_ws, size_t ws_size, hipStream_t stream) {
    static int grid = 0;
#if MK_PER_PHASE
    static const kern_t kerns[8] = {trunk_fwd<0x1>, trunk_fwd<0x2>, trunk_fwd<0x4>, trunk_fwd<0x8>, trunk_fwd<0x10>, trunk_fwd<0x20>, trunk_fwd<0xC0>, trunk_fwd<0x100>};
    constexpr int NK = 8;
#else
    static const kern_t kerns[1] = {trunk_fwd<0x1ff>};
    constexpr int NK = 1;
#endif
    if (grid == 0) {
        if (n_in != 26 || ws_size < WS_END) { fprintf(stderr, "kernel_launch: need 26 inputs and %zu bytes of workspace; got %d, %zu\n", (size_t)WS_END, n_in, ws_size); grid = -1; return; }
        int dev = 0, cus = 0, per_cu = 0;
        if (hipGetDevice(&dev) != hipSuccess || hipDeviceGetAttribute(&cus, hipDeviceAttributeMultiprocessorCount, dev) != hipSuccess) { grid = -1; return; }
        for (int i = 0; i < NK; ++i) {
            if (hipFuncSetAttribute((const void*)kerns[i], hipFuncAttributeMaxDynamicSharedMemorySize, LDS_BYTES) != hipSuccess) { fprintf(stderr, "kernel_launch: hipFuncSetAttribute failed\n"); grid = -1; return; }
            if (hipOccupancyMaxActiveBlocksPerMultiprocessor(&per_cu, (const void*)kerns[i], 512, LDS_BYTES) != hipSuccess || per_cu < 1) { fprintf(stderr, "kernel_launch: occupancy query says %d\n", per_cu); (void)hipGetLastError(); grid = -1; return; }
        }
        grid = cus * 1;
    }
    if (grid < 0) return;
    if (hipMemsetAsync((char*)d_ws + WS_CTL, 0, 16384, stream) != hipSuccess) { fprintf(stderr, "kernel_launch: memset failed\n"); return; }
    KArgs a{};
    for (int i = 0; i < 26; ++i) a.in[i] = (const float*)d_in[i];
    a.out = (float*)d_out; a.ws = (unsigned char*)d_ws;
#if MK_PER_PHASE
    for (int ph = 0; ph < N_PHASES; ++ph) {
        a.ph_lo = ph; a.ph_hi = ph + 1;
        int ki;
        if (ph < 2) ki = ph;
        else { const int k = (ph - 2) % 11; ki = (k == 0 || k == 8) ? 2 : (k == 1 || k == 9 || k == 6) ? 3 : (k == 2 || k == 7 || k == 10) ? 4 : (k == 3) ? 5 : (k == 4) ? 6 : 7; }
        hipLaunchKernelGGL(kerns[ki], dim3(grid), dim3(512), LDS_BYTES, stream, a);
    }
#else
    a.ph_lo = 0; a.ph_hi = N_PHASES;
    void* args[] = {&a};
    hipError_t e = hipLaunchCooperativeKernel((const void*)kerns[0], dim3(grid), dim3(512), args, LDS_BYTES, stream);
    if (e != hipSuccess) fprintf(stderr, "cooperative launch failed: %s (grid %d)\n", hipGetErrorString(e), grid);
#endif
}
```

```cpp
#include <hip/hip_runtime.h>
#include <hip/hip_cooperative_groups.h>
#include <cstdio>
#include <cstdint>
namespace cg = cooperative_groups;

#ifndef MK_PER_PHASE
#define MK_PER_PHASE 0
#endif

#define DI __device__ __forceinline__
#define LAS __attribute__((address_space(3)))
typedef unsigned short bf16_t;
typedef short bf16x8 __attribute__((ext_vector_type(8)));
typedef short s16x4 __attribute__((ext_vector_type(4)));
typedef float f32x4 __attribute__((ext_vector_type(4)));
typedef float f32x16 __attribute__((ext_vector_type(16)));
typedef unsigned u32x4 __attribute__((ext_vector_type(4)));
typedef unsigned u32x2 __attribute__((ext_vector_type(2)));
typedef __bf16 bf16x2_t __attribute__((ext_vector_type(2)));
typedef int v4i_t __attribute__((ext_vector_type(4)));
typedef int v8i_t __attribute__((ext_vector_type(8)));
typedef float f32x2_t __attribute__((ext_vector_type(2)));

DI unsigned pk2(float lo, float hi) { f32x2_t v = {lo, hi}; bf16x2_t b = __builtin_convertvector(v, bf16x2_t); return __builtin_bit_cast(unsigned, b); }
DI unsigned pk4f8(float a, float b, float c, float d) { int w = 0; w = __builtin_amdgcn_cvt_pk_fp8_f32(a, b, w, false); w = __builtin_amdgcn_cvt_pk_fp8_f32(c, d, w, true); return (unsigned)w; }
DI bf16_t f2bf(float f) { return (bf16_t)(pk2(f, 0.f) & 0xffffu); }
DI int otid() { int t = threadIdx.x; asm volatile("" : "+v"(t)); return t; }
template <int M> DI float shx(float v) { return __builtin_bit_cast(float, __builtin_amdgcn_ds_swizzle(__builtin_bit_cast(int, v), 0x1f | (M << 10))); }
DI float shx32(float v) { const int l = otid() & 63; return __builtin_bit_cast(float, __builtin_amdgcn_ds_bpermute((l ^ 32) << 2, __builtin_bit_cast(int, v))); }
DI float wave_sum(float v) { v += shx<1>(v); v += shx<2>(v); v += shx<4>(v); v += shx<8>(v); v += shx<16>(v); v += shx32(v); return v; }

constexpr int T = 12288, TP = 4096, D = 1024, FF = 2816, NIN = 2560, LKS = 4352;
constexpr float ALPHA = 1.41421356237f;
constexpr float H8_SCALE = 16.f, WGU8_SCALE = 256.f;
constexpr float QSCALE = 0.125f * 1.44269504089f;

constexpr size_t al256(size_t x) { return (x + 255) & ~(size_t)255; }
constexpr size_t WS_CTL = 0;
constexpr size_t WS_MOD = 16384;
constexpr size_t WS_ROPE = WS_MOD + al256(2 * 3 * 9216 * 4);
constexpr size_t WS_DFTP = WS_ROPE + 8192;
constexpr size_t WS_DFTS = WS_DFTP + 256 * 512 * 2;
constexpr size_t WS_WGU1 = WS_DFTS + (size_t)4096 * 8192 * 2;
constexpr size_t WS_WD1 = WS_WGU1 + (size_t)5632 * 1024 * 2;
constexpr size_t WS_WIN = WS_WD1 + (size_t)1024 * 2816 * 2;
constexpr size_t WS_WOUT = WS_WIN + (size_t)2560 * 1024 * 2;
constexpr size_t WS_WGU2 = WS_WOUT + (size_t)1024 * 1024 * 2;
constexpr size_t WS_WD2 = WS_WGU2 + (size_t)5632 * 1024 * 2;
constexpr size_t WS_X = WS_WD2 + (size_t)1024 * 2816 * 2;
constexpr size_t WS_KAS = WS_X + (size_t)T * D * 4;
constexpr size_t WS_VAS = WS_KAS + (size_t)2 * 2 * LKS * 64 * 2;
constexpr size_t WS_KBS = WS_VAS + (size_t)2 * 2 * LKS * 64 * 2;
constexpr size_t WS_VBS = WS_KBS + (size_t)2 * 8 * LKS * 64 * 2;
constexpr size_t WS_H = WS_VBS + (size_t)2 * 4 * 128 * LKS * 2;
constexpr size_t WS_R = WS_H + (size_t)T * D * 2;
constexpr size_t WS_ACT = WS_R;
constexpr size_t WS_QA = WS_R;
constexpr size_t WS_QB = WS_QA + (size_t)T * 256 * 2;
constexpr size_t WS_KAP = WS_QB + (size_t)T * 512 * 2;
constexpr size_t WS_VAP = WS_KAP + (size_t)16 * 2 * 256 * 64 * 2;
constexpr size_t WS_KBP = WS_VAP + (size_t)16 * 2 * 256 * 64 * 2;
constexpr size_t WS_VBP = WS_KBP + (size_t)16 * 8 * 256 * 64 * 2;
constexpr size_t WS_UTP = WS_VBP + (size_t)16 * 4 * 128 * 256 * 2;
constexpr size_t WS_UTS = WS_UTP + (size_t)4096 * 512 * 2;
constexpr size_t WS_MIX = WS_UTS + (size_t)512 * 8192 * 2;
constexpr size_t WS_FACC = WS_MIX + (size_t)T * D * 2;
constexpr size_t WS_REND = WS_FACC + (size_t)T * 256 * 4;
constexpr size_t WS_END = (WS_REND > WS_ACT + (size_t)T * FF * 2) ? WS_REND : WS_ACT + (size_t)T * FF * 2;

constexpr int LDS_RING = 131072, MISC_OFF = LDS_RING, LDS_BYTES = LDS_RING + 256;

struct KArgs { const float* in[26]; float* out; unsigned char* ws; int ph_lo, ph_hi; };
typedef const KArgs __attribute__((address_space(4)))* KP;

namespace pg8 {
constexpr int BM = 256, BK = 64, HALF = 128, HTB = HALF * BK * 2, STAGE_BYTES = 8 * HTB, NXCD = 8, WGM = 8;
DI int lds_byte(int r, int c) { const int st = (r >> 4) * 2 + (c >> 5), rr = r & 15, cc = c & 31, ob = rr * 64 + cc * 2; return st * 1024 + (ob ^ (((ob >> 9) & 1) << 5)); }
DI void stage_rc(int b, int& R, int& C) { const int st = b / 1024, sb = b % 1024, swz = sb ^ (((sb >> 9) & 1) << 5); R = (st >> 1) * 16 + swz / 64; C = (st & 1) * 32 + (swz % 64) / 2; }
DI int perm32(int rho) { const int n = rho >> 4, i = rho & 15; return 8 * (i >> 2) + 4 * n + (i & 3); }

struct Unit { int pm, pn, ko; };
struct Gemm { const bf16_t* A; const bf16_t* Bt; int ld, K; };

struct StaticOrder {
    int nM, nN, nwg, G, c;
    DI void init(int M, int N, int G_, int c_) { nM = M / BM; nN = N / BM; nwg = nM * nN; G = G_; c = c_; }
    DI bool next(int i, Unit& u) const {
        const long L = (long)i * G + c; if (L >= nwg) return false;
        int wgid = (int)L; { const int q = nwg / NXCD, r = nwg % NXCD, xcd = wgid % NXCD, off = wgid / NXCD; wgid = (xcd < r ? xcd * (q + 1) : r * (q + 1) + (xcd - r) * q) + off; }
        const int nig = WGM * nN, gid = wgid / nig, fm = gid * WGM, gsz = (nM - fm) < WGM ? (nM - fm) : WGM;
        u.pm = fm + ((wgid % nig) % gsz); u.pn = (wgid % nig) / gsz; u.ko = 0; return true;
    }
};
struct FourOrder {
    int G, c, total, mode;
    DI bool next(int i, Unit& u) const {
        const int L = i * G + c - (mode ? 32 : 0); if (L < 0 || L >= total) return false;
        u.ko = 0;
        if (mode == 0) { u.pm = L >> 1; u.pn = L & 1; } else { u.pm = 0; u.pn = L; }
        return true;
    }
};

template <class Epi, class Sched, bool ALIGN_EPI, bool SP2, bool F8 = false>
DI void gemm_phase(LAS unsigned char* lds, const Gemm g, const Sched& S, const Epi& E) {
    int tid = threadIdx.x; asm volatile("" : "+v"(tid));
    const int wid = __builtin_amdgcn_readfirstlane(tid >> 6), lane = tid & 63, wr = wid >> 2, wc = wid & 3, fr = lane & 15, fq = lane >> 4;
    int K = g.K; asm volatile("" : "+s"(K));
    const int nt = K / BK, ld = g.ld;
    unsigned voffA[2], voffB[2];
#pragma unroll
    for (int i = 0; i < 2; ++i) { int R, C; stage_rc(tid * 16 + i * 8192, R, C); const int Rb = (R & ~31) + perm32(R & 31);
        voffA[i] = (unsigned)(R * ld + C) * 2u; voffB[i] = (unsigned)(Rb * ld + C) * 2u; }
    const size_t kstep = (size_t)(BK * 2);
    const size_t hstep = (size_t)HALF * ld * 2;
    const size_t tstep = 2 * hstep;
    const unsigned ldsw = (unsigned)wid * 1024u;
    const unsigned ldsbase = (unsigned)(size_t)lds + ldsw;
    const int aoff = lds_byte(wr * 64 + fr, fq * 8), boff = lds_byte(wc * 32 + fr, fq * 8);
#define PG8_SA(b, h) (((b) * 2 + (h)) * HTB)
#define PG8_SB(b, h) ((4 + (b) * 2 + (h)) * HTB)
#define PG8_STAGE(bufoff, gbase, voff) do { _Pragma("unroll") for (int _i = 0; _i < 2; ++_i) { unsigned _keep; \
        asm volatile("s_mov_b32 %0, m0\n\ts_mov_b32 m0, %2\n\ts_nop 0\n\tglobal_load_lds_dwordx4 %1, %3\n\ts_mov_b32 m0, %0" : "=&s"(_keep) \
                     : "v"((voff)[_i]), "s"(ldsbase + (unsigned)((bufoff) + _i * 8192)), "s"((const char*)(gbase)) : "memory"); } } while (0)
#define PG8_LDA(dst, b, h) do { _Pragma("unroll") for (int m = 0; m < 4; ++m) { if constexpr (F8) { const v4i_t lo_ = *(const LAS v4i_t*)(lds + PG8_SA(b, h) + aoff + m * 2048), hi_ = *(const LAS v4i_t*)(lds + PG8_SA(b, h) + aoff + m * 2048 + 1024); \
        dst##8[m] = __builtin_shufflevector(lo_, hi_, 0, 1, 2, 3, 4, 5, 6, 7); } else { _Pragma("unroll") for (int k = 0; k < 2; ++k) dst[m][k] = *(const LAS bf16x8*)(lds + PG8_SA(b, h) + aoff + m * 2048 + k * 1024); } } } while (0)
#define PG8_LDB(dst, b, h) do { _Pragma("unroll") for (int n = 0; n < 2; ++n) { if constexpr (F8) { const v4i_t lo_ = *(const LAS v4i_t*)(lds + PG8_SB(b, h) + boff + n * 2048), hi_ = *(const LAS v4i_t*)(lds + PG8_SB(b, h) + boff + n * 2048 + 1024); \
        dst##8[n] = __builtin_shufflevector(lo_, hi_, 0, 1, 2, 3, 4, 5, 6, 7); } else { _Pragma("unroll") for (int k = 0; k < 2; ++k) dst[n][k] = *(const LAS bf16x8*)(lds + PG8_SB(b, h) + boff + n * 2048 + k * 1024); } } } while (0)
#define PG8_MMA(ai, bj, At, Bt) do { __builtin_amdgcn_s_setprio(1); _Pragma("unroll") for (int m = 0; m < 4; ++m) _Pragma("unroll") for (int n = 0; n < 2; ++n) { \
        if constexpr (F8) { acc[ai][bj][m][n] = __builtin_amdgcn_mfma_scale_f32_16x16x128_f8f6f4(Bt##8[n], At##8[m], acc[ai][bj][m][n], 0, 0, 0, 0, 0, 0); } \
        else { _Pragma("unroll") for (int k = 0; k < 2; ++k) acc[ai][bj][m][n] = __builtin_amdgcn_mfma_f32_16x16x32_bf16(Bt[n][k], At[m][k], acc[ai][bj][m][n], 0, 0, 0); } } \
        __builtin_amdgcn_s_setprio(0); } while (0)
#define PG8_WAIT_V(n) asm volatile("s_waitcnt vmcnt(" #n ")" ::: "memory")
#define PG8_WAIT_L(n) asm volatile("s_waitcnt lgkmcnt(" #n ")" ::: "memory")
#define PG8_BAR __builtin_amdgcn_s_barrier()
#define PG8_SCHED __builtin_amdgcn_sched_barrier(0)
    Unit cur, nxt; int ui = 0;
    if (!S.next(0, cur)) return;
    f32x4 acc[2][2][4][2];
#pragma unroll
    for (int a = 0; a < 2; ++a)
#pragma unroll
        for (int b = 0; b < 2; ++b)
#pragma unroll
            for (int m = 0; m < 4; ++m)
#pragma unroll
                for (int n = 0; n < 2; ++n) acc[a][b][m][n] = (f32x4){0.f, 0.f, 0.f, 0.f};
    bf16x8 At[4][2], B0[2][2], B1[2][2];
    v8i_t At8[4], B08[2], B18[2];
    const char* cA = (const char*)g.A + (size_t)cur.pm * tstep + (size_t)cur.ko * 2; const char* cB = (const char*)g.Bt + (size_t)cur.pn * tstep + (size_t)cur.ko * 2;
    if constexpr (SP2) {
        PG8_STAGE(PG8_SB(0, 0), cB, voffB); PG8_STAGE(PG8_SB(0, 1), cB + hstep, voffB); PG8_STAGE(PG8_SA(0, 0), cA, voffA); PG8_STAGE(PG8_SA(0, 1), cA + hstep, voffA);
        if (wr == 1) PG8_BAR;
        PG8_WAIT_V(2); PG8_BAR;
        PG8_STAGE(PG8_SB(1, 0), cB + kstep, voffB); PG8_STAGE(PG8_SA(1, 0), cA + kstep, voffA); PG8_STAGE(PG8_SB(1, 1), cB + hstep + kstep, voffB);
        PG8_WAIT_V(6); PG8_BAR;
    } else {
        PG8_STAGE(PG8_SB(0, 0), cB, voffB); PG8_STAGE(PG8_SA(0, 0), cA, voffA); PG8_STAGE(PG8_SB(0, 1), cB + hstep, voffB); PG8_STAGE(PG8_SA(0, 1), cA + hstep, voffA);
        if (wr == 1) PG8_BAR;
        PG8_WAIT_V(4); PG8_BAR;
        PG8_STAGE(PG8_SB(1, 0), cB + kstep, voffB); PG8_STAGE(PG8_SA(1, 0), cA + kstep, voffA); PG8_STAGE(PG8_SB(1, 1), cB + hstep + kstep, voffB);
        PG8_WAIT_V(6); PG8_BAR;
    }
    for (;;) {
        const bool has_next = S.next(ui + 1, nxt);
        const char* nA = has_next ? (const char*)g.A + (size_t)nxt.pm * tstep + (size_t)nxt.ko * 2 : cA; const char* nB = has_next ? (const char*)g.Bt + (size_t)nxt.pn * tstep + (size_t)nxt.ko * 2 : cB;
#pragma clang loop unroll(disable)
        for (int t = 0; t < nt; t += 2) {
            const bool last = (t == nt - 2);
            const char* a1 = cA + (size_t)(t + 1) * kstep;
            const char* a2 = last ? nA : cA + (size_t)(t + 2) * kstep; const char* b2 = last ? nB : cB + (size_t)(t + 2) * kstep;
            const char* a3 = a2 + kstep; const char* b3 = b2 + kstep;
            if constexpr (SP2) {
            PG8_LDB(B0, 0, 0); PG8_LDB(B1, 0, 1); PG8_SCHED; PG8_LDA(At, 0, 0); PG8_STAGE(PG8_SA(1, 1), a1 + hstep, voffA);
            PG8_WAIT_V(8); PG8_WAIT_L(0); PG8_BAR; PG8_MMA(0, 0, At, B0); PG8_MMA(0, 1, At, B1); PG8_BAR; PG8_SCHED;
            PG8_LDA(At, 0, 1); PG8_STAGE(PG8_SB(0, 0), b2, voffB); PG8_STAGE(PG8_SB(0, 1), b2 + hstep, voffB); PG8_STAGE(PG8_SA(0, 0), a2, voffA);
            PG8_WAIT_V(8); PG8_WAIT_L(0); PG8_BAR; PG8_MMA(1, 0, At, B0); PG8_MMA(1, 1, At, B1); PG8_BAR; PG8_SCHED;
            PG8_LDB(B0, 1, 0); PG8_LDB(B1, 1, 1); PG8_SCHED; PG8_LDA(At, 1, 0); PG8_STAGE(PG8_SA(0, 1), a2 + hstep, voffA);
            PG8_WAIT_V(8); PG8_WAIT_L(0); PG8_BAR; PG8_MMA(0, 0, At, B0); PG8_MMA(0, 1, At, B1); PG8_BAR; PG8_SCHED;
            PG8_LDA(At, 1, 1); PG8_STAGE(PG8_SB(1, 0), b3, voffB); PG8_STAGE(PG8_SB(1, 1), b3 + hstep, voffB); PG8_STAGE(PG8_SA(1, 0), a3, voffA);
            PG8_WAIT_V(8); PG8_WAIT_L(0); PG8_BAR; PG8_MMA(1, 0, At, B0); PG8_MMA(1, 1, At, B1); PG8_BAR; PG8_SCHED;
            } else {
            PG8_LDB(B0, 0, 0); PG8_SCHED; PG8_LDA(At, 0, 0); PG8_STAGE(PG8_SA(1, 1), a1 + hstep, voffA);
            PG8_WAIT_L(8); PG8_BAR; PG8_WAIT_L(0); PG8_MMA(0, 0, At, B0); PG8_BAR; PG8_SCHED;
            PG8_LDB(B1, 0, 1); PG8_STAGE(PG8_SB(0, 0), b2, voffB);
            PG8_BAR; PG8_WAIT_L(0); PG8_MMA(0, 1, At, B1); PG8_BAR;
            PG8_LDA(At, 0, 1); PG8_STAGE(PG8_SA(0, 0), a2, voffA);
            PG8_BAR; PG8_WAIT_L(0); PG8_MMA(1, 0, At, B0); PG8_BAR; PG8_SCHED;
            PG8_STAGE(PG8_SB(0, 1), b2 + hstep, voffB);
            PG8_WAIT_V(6); PG8_BAR; PG8_MMA(1, 1, At, B1); PG8_BAR;
            PG8_LDB(B0, 1, 0); PG8_SCHED; PG8_LDA(At, 1, 0); PG8_STAGE(PG8_SA(0, 1), a2 + hstep, voffA);
            PG8_WAIT_L(8); PG8_BAR; PG8_WAIT_L(0); PG8_MMA(0, 0, At, B0); PG8_BAR; PG8_SCHED;
            PG8_LDB(B1, 1, 1); PG8_STAGE(PG8_SB(1, 0), b3, voffB);
            PG8_BAR; PG8_WAIT_L(0); PG8_MMA(0, 1, At, B1); PG8_BAR;
            PG8_LDA(At, 1, 1); PG8_STAGE(PG8_SA(1, 0), a3, voffA);
            PG8_BAR; PG8_WAIT_L(0); PG8_MMA(1, 0, At, B0); PG8_BAR; PG8_SCHED;
            PG8_STAGE(PG8_SB(1, 1), b3 + hstep, voffB);
            PG8_WAIT_V(6); PG8_BAR; PG8_MMA(1, 1, At, B1); PG8_BAR;
            }
        }
        if constexpr (ALIGN_EPI) { if (wr == 0) PG8_BAR; }
        E(acc, cur, wr, wc, fr, fq);
        if (!has_next) break;
#pragma unroll
        for (int a = 0; a < 2; ++a)
#pragma unroll
            for (int b = 0; b < 2; ++b)
#pragma unroll
                for (int m = 0; m < 4; ++m)
#pragma unroll
                    for (int n = 0; n < 2; ++n) acc[a][b][m][n] = (f32x4){0.f, 0.f, 0.f, 0.f};
        cur = nxt; cA = nA; cB = nB; ++ui;
        if constexpr (ALIGN_EPI) { if (wr == 1) PG8_BAR; }
    }
    PG8_WAIT_V(0);
    if constexpr (!ALIGN_EPI) { if (wr == 0) PG8_BAR; }
    PG8_BAR;
#undef PG8_SA
#undef PG8_SB
#undef PG8_STAGE
#undef PG8_LDA
#undef PG8_LDB
#undef PG8_MMA
#undef PG8_WAIT_V
#undef PG8_WAIT_L
#undef PG8_BAR
#undef PG8_SCHED
}

DI int mod_of_row_tile(int pm) { return pm < 16 ? 0 : 1 + ((pm - 16) >> 4); }

struct EpiGU {
    bf16_t* ACT; float osc;
    DI void operator()(const f32x4 (&acc)[2][2][4][2], const Unit& u, int wr, int wc, int fr_in, int fq_in) const {
        int fr = fr_in, fq = fq_in; asm volatile("" : "+v"(fr), "+v"(fq));
#pragma unroll
        for (int ai = 0; ai < 2; ++ai)
#pragma unroll
            for (int m = 0; m < 4; ++m) {
                const int row = u.pm * 256 + ai * 128 + wr * 64 + m * 16 + fr;
                float o[8];
#pragma unroll
                for (int n = 0; n < 2; ++n)
#pragma unroll
                    for (int j = 0; j < 4; ++j) { const float gg = acc[ai][0][m][n][j] * osc, uu = acc[ai][1][m][n][j] * osc;
                        const float sg = gg * __builtin_amdgcn_rcpf(1.f + __builtin_amdgcn_exp2f(-1.44269504089f * gg)); o[n * 4 + j] = sg * uu; }
                u32x4 w; w.x = pk2(o[0], o[1]); w.y = pk2(o[2], o[3]); w.z = pk2(o[4], o[5]); w.w = pk2(o[6], o[7]);
                *(u32x4*)(ACT + (size_t)row * FF + u.pn * 128 + wc * 32 + fq * 8) = w;
            }
    }
};

struct EpiRes {
    const float* srcP; const float* srcS; float* X; const float* gate; float coef;
    DI void operator()(const f32x4 (&acc)[2][2][4][2], const Unit& u, int wr, int wc, int fr_in, int fq_in) const {
        int fr = fr_in, fq = fq_in; asm volatile("" : "+v"(fr), "+v"(fq));
        const float* gt = gate + mod_of_row_tile(u.pm) * 9216;
        f32x4 gv[2][2];
#pragma unroll
        for (int bj = 0; bj < 2; ++bj)
#pragma unroll
            for (int n = 0; n < 2; ++n) gv[bj][n] = *(const f32x4*)(gt + u.pn * 256 + bj * 128 + wc * 32 + fq * 8 + n * 4) * coef;
#pragma unroll
        for (int ai = 0; ai < 2; ++ai)
#pragma unroll
            for (int m = 0; m < 4; ++m) {
                const int row = u.pm * 256 + ai * 128 + wr * 64 + m * 16 + fr;
                const float* sp = (row < TP) ? srcP + (size_t)row * D : srcS + (size_t)(row - TP) * D;
#pragma unroll
                for (int bj = 0; bj < 2; ++bj)
#pragma unroll
                    for (int n = 0; n < 2; ++n) { const int c = u.pn * 256 + bj * 128 + wc * 32 + fq * 8 + n * 4;
                        const f32x4 xv = *(const f32x4*)(sp + c);
                        *(f32x4*)(X + (size_t)row * D + c) = xv * ALPHA + gv[bj][n] * acc[ai][bj][m][n]; }
            }
    }
};

struct EpiFour {
    bf16_t* MIX; int mode;
    DI void operator()(const f32x4 (&acc)[2][2][4][2], const Unit& u, int wr, int wc, int fr_in, int fq_in) const {
        int fr = fr_in, fq = fq_in; asm volatile("" : "+v"(fr), "+v"(fq));
        const int tok0 = ((mode == 0) ? TP + u.pn * 4096 + u.pm * 256 : u.pn * 256) + wr * 64 + fr;
        bf16_t* p0 = MIX + (size_t)tok0 * D + 768 + wc * 32 + fq * 8;
#pragma unroll
        for (int ai = 0; ai < 2; ++ai)
#pragma unroll
            for (int m = 0; m < 4; ++m) {
                bf16_t* p = p0 + (size_t)(ai * 128 + m * 16) * D;
#pragma unroll
                for (int bj = 0; bj < 2; ++bj) {
                    u32x4 w; w.x = pk2(acc[ai][bj][m][0][0], acc[ai][bj][m][0][1]); w.y = pk2(acc[ai][bj][m][0][2], acc[ai][bj][m][0][3]);
                    w.z = pk2(acc[ai][bj][m][1][0], acc[ai][bj][m][1][1]); w.w = pk2(acc[ai][bj][m][1][2], acc[ai][bj][m][1][3]);
                    *(u32x4*)(p + bj * 128) = w;
                }
            }
    }
};

struct EpiIn {
    int l; const float* g_qa; const float* g_ka; float* out; unsigned char* ws;
    DI void operator()(const f32x4 (&acc)[2][2][4][2], const Unit& u, int wr, int wc, int fr_in, int fq_in) const {
        int fr = fr_in, fq = fq_in; asm volatile("" : "+v"(fr), "+v"(fq));
        const int t = u.pn; const bool prompt = u.pm < 16;
        const float* rope = (const float*)(ws + WS_ROPE);
        bf16_t* const QA = (bf16_t*)(ws + WS_QA); bf16_t* const QB = (bf16_t*)(ws + WS_QB); bf16_t* const KAS = (bf16_t*)(ws + WS_KAS); bf16_t* const VAS = (bf16_t*)(ws + WS_VAS);
        bf16_t* const KBS = (bf16_t*)(ws + WS_KBS); bf16_t* const VBS = (bf16_t*)(ws + WS_VBS); bf16_t* const KAP = (bf16_t*)(ws + WS_KAP); bf16_t* const VAP = (bf16_t*)(ws + WS_VAP);
        bf16_t* const KBP = (bf16_t*)(ws + WS_KBP); bf16_t* const VBP = (bf16_t*)(ws + WS_VBP); bf16_t* const UTP = (bf16_t*)(ws + WS_UTP); bf16_t* const UTS = (bf16_t*)(ws + WS_UTS);
        if (t >= 8) {
            const int cs = t - 8;
#pragma unroll
            for (int ai = 0; ai < 2; ++ai)
#pragma unroll
                for (int m = 0; m < 4; ++m) {
                    const int row = u.pm * 256 + ai * 128 + wr * 64 + m * 16 + fr;
                    bf16_t* base; size_t pitch;
                    if (prompt) { base = UTP + (size_t)(row >> 8) * 256 * 512 + cs * 256 + (row & 255); pitch = 512; }
                    else { const int rs = row - TP; base = UTS + (size_t)(rs >> 12) * 256 * 8192 + cs * 4096 + (rs & 4095); pitch = 8192; }
#pragma unroll
                    for (int bj = 0; bj < 2; ++bj)
#pragma unroll
                        for (int n = 0; n < 2; ++n)
#pragma unroll
                            for (int j = 0; j < 4; ++j) base[(size_t)(bj * 128 + wc * 32 + fq * 8 + n * 4 + j) * pitch] = f2bf(acc[ai][bj][m][n][j]);
                    __builtin_amdgcn_sched_barrier(0);
                }
            return;
        }
        const bool do_norm = (t == 0) || (t == 1 && wc < 2);
        const bool is_v = (t == 1 && wc >= 2) || t >= 6;
        const bool is_q = (t == 0) || t == 2 || t == 3;
        const bool do_rope = !prompt && !is_v;
        const float* gp = (t == 0 ? g_qa : g_ka) + l * 64 + fq * 8;
#pragma unroll
        for (int ai = 0; ai < 2; ++ai)
#pragma unroll
            for (int m = 0; m < 4; ++m) {
                const int row = u.pm * 256 + ai * 128 + wr * 64 + m * 16 + fr;
                int b, pos;
                if (prompt) { b = row >> 8; pos = row & 255; } else { const int rs = row - TP; b = rs >> 12; pos = rs & 4095; }
                float v[2][8];
#pragma unroll
                for (int bj = 0; bj < 2; ++bj)
#pragma unroll
                    for (int n = 0; n < 2; ++n)
#pragma unroll
                        for (int j = 0; j < 4; ++j) v[bj][n * 4 + j] = acc[ai][bj][m][n][j];
                if (do_norm) {
                    float ss = 0.f;
#pragma unroll
                    for (int bj = 0; bj < 2; ++bj)
#pragma unroll
                        for (int e = 0; e < 8; ++e) ss += v[bj][e] * v[bj][e];
                    ss += shx<16>(ss); ss += shx32(ss);
                    const float rs_ = rsqrtf(ss * (1.f / 64.f) + 1e-6f);
#pragma unroll
                    for (int bj = 0; bj < 2; ++bj)
#pragma unroll
                        for (int e = 0; e < 8; ++e) v[bj][e] = v[bj][e] * rs_ * gp[bj * 32 + e];
                }
                if (prompt && !is_q) {
                    float* op;
                    if (t == 1) op = out + (wc < 2 ? 12582912 : 13631488) + ((size_t)((b * 2 + l) * 256 + pos)) * 128 + (wc & 1) * 64;
                    else if (t < 6) op = out + 14680064 + ((size_t)((b * 2 + l) * 256 + pos)) * 512 + ((t - 4) * 4 + wc) * 64;
                    else op = out + 18874368 + ((size_t)((b * 2 + l) * 256 + pos)) * 512 + (t - 6) * 256 + wc * 64;
#pragma unroll
                    for (int bj = 0; bj < 2; ++bj) {
                        *(f32x4*)(op + bj * 32 + fq * 8) = (f32x4){v[bj][0], v[bj][1], v[bj][2], v[bj][3]};
                        *(f32x4*)(op + bj * 32 + fq * 8 + 4) = (f32x4){v[bj][4], v[bj][5], v[bj][6], v[bj][7]};
                    }
                }
                if (do_rope) {
#pragma unroll
                    for (int bj = 0; bj < 2; ++bj) {
                        const int pv_ = bj == 0 ? (pos >> 6) : (pos & 63);
                        const float* rp = rope + (pv_ * 16 + (fq & 1) * 8) * 2;
#pragma unroll
                        for (int e = 0; e < 8; ++e) {
                            const float cc = rp[2 * e], sn = rp[2 * e + 1];
                            const float other = shx32(v[bj][e]);
                            v[bj][e] = v[bj][e] * cc + (fq < 2 ? -other : other) * sn;
                        }
                    }
                }
                if (is_v) {
                    bf16_t* base; size_t pitch;
                    if (t == 1) { const int kvh = wc - 2; if (prompt) { base = VAP + (size_t)(b * 2 + kvh) * 64 * 256 + pos; pitch = 256; } else { base = VAS + (size_t)(b * 2 + kvh) * 64 * LKS + 256 + pos; pitch = LKS; } }
                    else { const int hh = (t - 6) * 2 + (wc >> 1); const int d0 = (wc & 1) * 64;
                        if (prompt) { base = VBP + ((size_t)(b * 4 + hh) * 128 + d0) * 256 + pos; pitch = 256; } else { base = VBS + ((size_t)(b * 4 + hh) * 128 + d0) * LKS + 256 + pos; pitch = LKS; } }
#pragma unroll
                    for (int bj = 0; bj < 2; ++bj)
#pragma unroll
                        for (int e = 0; e < 8; ++e) base[(size_t)(bj * 32 + fq * 8 + e) * pitch] = f2bf(v[bj][e]);
                } else {
                    bf16_t* op;
                    if (t == 0) op = QA + (size_t)row * 256 + wc * 64;
                    else if (t == 1) op = prompt ? KAP + ((size_t)(b * 2 + wc) * 256 + pos) * 64 : KAS + ((size_t)(b * 2 + wc) * LKS + 256 + pos) * 64;
                    else if (t < 4) op = QB + (size_t)row * 512 + ((t - 2) * 4 + wc) * 64;
                    else { const int s = (t - 4) * 4 + wc; op = prompt ? KBP + ((size_t)(b * 8 + s) * 256 + pos) * 64 : KBS + ((size_t)(b * 8 + s) * LKS + 256 + pos) * 64; }
                    const float sc = is_q ? QSCALE : 1.f;
#pragma unroll
                    for (int bj = 0; bj < 2; ++bj) {
                        u32x4 w; w.x = pk2(v[bj][0] * sc, v[bj][1] * sc); w.y = pk2(v[bj][2] * sc, v[bj][3] * sc); w.z = pk2(v[bj][4] * sc, v[bj][5] * sc); w.w = pk2(v[bj][6] * sc, v[bj][7] * sc);
                        *(u32x4*)(op + bj * 32 + fq * 8) = w;
                    }
                }
                __builtin_amdgcn_sched_barrier(0);
            }
    }
};
}

template <int DV>
DI void attn_unit(const bf16_t* __restrict__ Q, int qpitch, const bf16_t* __restrict__ K, const bf16_t* __restrict__ VT, int Lk, bf16_t* __restrict__ O, int opitch, LAS unsigned char* lds) {
    constexpr int KROW = 144, VROW = 136, KBYTES = 64 * KROW, VBYTES = DV * VROW, BUF = KBYTES + VBYTES, NV = DV / 64, NDB = DV / 32;
    int tid = threadIdx.x; asm volatile("" : "+v"(tid));
    const int wave = tid >> 6, lane = tid & 63, r = lane & 31, h = lane >> 5;
    bf16x8 qf[4];
    { const bf16_t* qrow = Q + (size_t)(wave * 32 + r) * qpitch;
#pragma unroll
      for (int s = 0; s < 4; ++s) qf[s] = *(const bf16x8*)(qrow + 16 * s + 8 * h); }
    f32x16 o[NDB];
#pragma unroll
    for (int db = 0; db < NDB; ++db)
#pragma unroll
        for (int i = 0; i < 16; ++i) o[db][i] = 0.f;
    float mrun = 0.f, lrun = 0.f;
    const int skey = tid >> 3, sch = tid & 7;
    const bf16_t* kg = K + (size_t)skey * 64 + sch * 8;
    const bf16_t* vg = VT + (size_t)skey * Lk + sch * 8;
    const unsigned kwoff = skey * KROW + sch * 16, vwoff = KBYTES + skey * VROW + sch * 16;
    u32x4 kreg, vreg[NV];
    kreg = *(const u32x4*)kg;
#pragma unroll
    for (int i = 0; i < NV; ++i) vreg[i] = *(const u32x4*)(vg + (size_t)(64 * i) * Lk);
    *(LAS u32x4*)(lds + kwoff) = kreg;
#pragma unroll
    for (int i = 0; i < NV; ++i) { *(LAS u32x2*)(lds + vwoff + i * 64 * VROW) = (u32x2){vreg[i].x, vreg[i].y}; *(LAS u32x2*)(lds + vwoff + i * 64 * VROW + 8) = (u32x2){vreg[i].z, vreg[i].w}; }
    __syncthreads();
    const int nt = Lk >> 6;
    for (int kt = 0; kt < nt; ++kt) {
        LAS unsigned char* cb = lds + (kt & 1) * BUF;
        LAS unsigned char* nb = lds + ((kt & 1) ^ 1) * BUF;
        const bool more = kt + 1 < nt;
        if (more) {
            kreg = *(const u32x4*)(kg + (size_t)(kt + 1) * 64 * 64);
#pragma unroll
            for (int i = 0; i < NV; ++i) vreg[i] = *(const u32x4*)(vg + (size_t)(64 * i) * Lk + (kt + 1) * 64);
        }
        f32x16 s0, s1;
        { const float nm = -mrun;
#pragma unroll
          for (int i = 0; i < 16; ++i) { s0[i] = nm; s1[i] = nm; } }
#pragma unroll
        for (int s = 0; s < 4; ++s) {
            const bf16x8 k0 = *(const LAS bf16x8*)(cb + r * KROW + (16 * s + 8 * h) * 2);
            const bf16x8 k1 = *(const LAS bf16x8*)(cb + (32 + r) * KROW + (16 * s + 8 * h) * 2);
            s0 = __builtin_amdgcn_mfma_f32_32x32x16_bf16(k0, qf[s], s0, 0, 0, 0);
            s1 = __builtin_amdgcn_mfma_f32_32x32x16_bf16(k1, qf[s], s1, 0, 0, 0);
        }
        float mxa[8];
#pragma unroll
        for (int i = 0; i < 8; ++i) mxa[i] = fmaxf(fmaxf(s0[2 * i], s0[2 * i + 1]), fmaxf(s1[2 * i], s1[2 * i + 1]));
        float mx = fmaxf(fmaxf(fmaxf(mxa[0], mxa[1]), fmaxf(mxa[2], mxa[3])), fmaxf(fmaxf(mxa[4], mxa[5]), fmaxf(mxa[6], mxa[7])));
        mx = fmaxf(mx, shx32(mx));
        if (__builtin_amdgcn_ballot_w64(mx > 8.f) != 0ull) {
            const float dlt = fmaxf(mx, 0.f);
            const float alpha = __builtin_amdgcn_exp2f(-dlt);
            mrun += dlt; lrun *= alpha;
#pragma unroll
            for (int db = 0; db < NDB; ++db)
#pragma unroll
                for (int i = 0; i < 16; ++i) o[db][i] *= alpha;
#pragma unroll
            for (int i = 0; i < 16; ++i) { s0[i] -= dlt; s1[i] -= dlt; }
        }
        f32x2_t rs2 = {0.f, 0.f};
#pragma unroll
        for (int i = 0; i < 16; ++i) { s0[i] = __builtin_amdgcn_exp2f(s0[i]); s1[i] = __builtin_amdgcn_exp2f(s1[i]); }
#pragma unroll
        for (int i = 0; i < 8; ++i) { rs2 += (f32x2_t){s0[2 * i], s0[2 * i + 1]}; rs2 += (f32x2_t){s1[2 * i], s1[2 * i + 1]}; }
        lrun += rs2.x + rs2.y;
#pragma unroll
        for (int kb = 0; kb < 2; ++kb)
#pragma unroll
            for (int s2 = 0; s2 < 2; ++s2) {
                u32x4 pw;
                if (kb == 0) { pw.x = pk2(s0[8 * s2 + 0], s0[8 * s2 + 1]); pw.y = pk2(s0[8 * s2 + 2], s0[8 * s2 + 3]); pw.z = pk2(s0[8 * s2 + 4], s0[8 * s2 + 5]); pw.w = pk2(s0[8 * s2 + 6], s0[8 * s2 + 7]); }
                else { pw.x = pk2(s1[8 * s2 + 0], s1[8 * s2 + 1]); pw.y = pk2(s1[8 * s2 + 2], s1[8 * s2 + 3]); pw.z = pk2(s1[8 * s2 + 4], s1[8 * s2 + 5]); pw.w = pk2(s1[8 * s2 + 6], s1[8 * s2 + 7]); }
                const bf16x8 pf = __builtin_bit_cast(bf16x8, pw);
#pragma unroll
                for (int db = 0; db < NDB; ++db) {
                    const LAS unsigned char* vp = cb + KBYTES + (32 * db + r) * VROW + (32 * kb + 16 * s2 + 4 * h) * 2;
                    const u32x2 lo = *(const LAS u32x2*)vp, hi = *(const LAS u32x2*)(vp + 16);
                    const u32x4 vw = {lo.x, lo.y, hi.x, hi.y};
                    o[db] = __builtin_amdgcn_mfma_f32_32x32x16_bf16(__builtin_bit_cast(bf16x8, vw), pf, o[db], 0, 0, 0);
                }
                    }
        if (more) {
            *(LAS u32x4*)(nb + kwoff) = kreg;
#pragma unroll
            for (int i = 0; i < NV; ++i) { *(LAS u32x2*)(nb + vwoff + i * 64 * VROW) = (u32x2){vreg[i].x, vreg[i].y}; *(LAS u32x2*)(nb + vwoff + i * 64 * VROW + 8) = (u32x2){vreg[i].z, vreg[i].w}; }
        }
        __syncthreads();
    }
    lrun += shx32(lrun);
    const float inv = 1.f / lrun;
    bf16_t* orow = O + (size_t)(wave * 32 + r) * opitch;
#pragma unroll
    for (int db = 0; db < NDB; ++db)
#pragma unroll
        for (int g = 0; g < 4; ++g) {
            u32x2 w; w.x = pk2(o[db][4 * g] * inv, o[db][4 * g + 1] * inv); w.y = pk2(o[db][4 * g + 2] * inv, o[db][4 * g + 3] * inv);
            *(u32x2*)(orow + 32 * db + 8 * g + 4 * h) = w;
        }
}

template <int MODE> DI int srccol(int np) {
    if (MODE == 1) { const int pn = np >> 8, j = np & 255; return j < 128 ? 128 * pn + j : FF + 128 * pn + (j - 128); }
    if (MODE == 2) { const int t = np >> 8, p = np & 255; return 256 * t + 64 * ((p >> 5) & 3) + 32 * (p >> 7) + (p & 31); }
    return np;
}
DI void tr_item(const float* __restrict__ src, int Nsrc, int mode, int n0, int k0, bf16_t* __restrict__ dst, int ldd, LAS float* tile, int tid, bool f8) {
    const int nn = tid & 63, kq = tid >> 6;
    int sc0, sc1;
    if (mode == 1) { sc0 = srccol<1>(n0 + nn); sc1 = srccol<1>(n0 + nn + 64); } else if (mode == 2) { sc0 = srccol<2>(n0 + nn); sc1 = srccol<2>(n0 + nn + 64); } else { sc0 = n0 + nn; sc1 = n0 + nn + 64; }
    float v0[8], v1[8];
#pragma unroll
    for (int i = 0; i < 8; ++i) { const float* rp = src + (size_t)(k0 + kq + 8 * i) * Nsrc; v0[i] = rp[sc0]; v1[i] = rp[sc1]; }
#pragma unroll
    for (int i = 0; i < 8; ++i) { tile[(kq + 8 * i) * 129 + nn] = v0[i]; tile[(kq + 8 * i) * 129 + nn + 64] = v1[i]; }
    __syncthreads();
    const int n2 = tid >> 3, kc = tid & 7;
#pragma unroll
    for (int hh = 0; hh < 2; ++hh) {
        const int nr = n2 + 64 * hh;
        float t8[8];
#pragma unroll
        for (int e = 0; e < 8; ++e) t8[e] = tile[(8 * kc + e) * 129 + nr];
        if (f8) {
            u32x2 w; w.x = pk4f8(t8[0] * WGU8_SCALE, t8[1] * WGU8_SCALE, t8[2] * WGU8_SCALE, t8[3] * WGU8_SCALE); w.y = pk4f8(t8[4] * WGU8_SCALE, t8[5] * WGU8_SCALE, t8[6] * WGU8_SCALE, t8[7] * WGU8_SCALE);
            *(u32x2*)((unsigned char*)dst + (size_t)(n0 + nr) * ldd + k0 + 8 * kc) = w;
        } else {
            u32x4 w; w.x = pk2(t8[0], t8[1]); w.y = pk2(t8[2], t8[3]); w.z = pk2(t8[4], t8[5]); w.w = pk2(t8[6], t8[7]);
            *(u32x4*)(dst + (size_t)(n0 + nr) * ldd + k0 + 8 * kc) = w;
        }
    }
    __syncthreads();
}

DI void convert_layer(KP a, int l, LAS unsigned char* lds) {
    unsigned char* ws = a->ws; const int tid = otid(), G = gridDim.x;
    LAS float* tile = (LAS float*)(lds + 32768);
    LAS float* t64 = (LAS float*)(lds + 98304);
    __syncthreads();
    if (tid < 64) t64[tid] = cospif((float)tid * (1.f / 32.f));
    __syncthreads();
    for (int it = blockIdx.x; it < 2464; it += G) {
        const float* src; bf16_t* dst; int Nsrc, nkt, ldd, mode, j;
        if (it < 704) { j = it; src = a->in[20] + (size_t)l * D * 2 * FF; Nsrc = 2 * FF; nkt = 16; dst = (bf16_t*)(ws + WS_WGU1); ldd = D; mode = 1; }
        else if (it < 1056) { j = it - 704; src = a->in[21] + (size_t)l * FF * D; Nsrc = D; nkt = 44; dst = (bf16_t*)(ws + WS_WD1); ldd = FF; mode = 0; }
        else if (it < 1312) { j = it - 1056; src = a->in[10] + (size_t)l * D * 2304; Nsrc = 2304; nkt = 16; dst = (bf16_t*)(ws + WS_WIN); ldd = D; mode = 2; }
        else if (it < 1408) { j = it - 1312; src = a->in[19] + (size_t)l * D * D; Nsrc = D; nkt = 12; dst = (bf16_t*)(ws + WS_WOUT); ldd = D; mode = 0; }
        else if (it < 2112) { j = it - 1408; src = a->in[22] + (size_t)l * D * 2 * FF; Nsrc = 2 * FF; nkt = 16; dst = (bf16_t*)(ws + WS_WGU2); ldd = D; mode = 1; }
        else { j = it - 2112; src = a->in[23] + (size_t)l * FF * D; Nsrc = D; nkt = 44; dst = (bf16_t*)(ws + WS_WD2); ldd = FF; mode = 0; }
        tr_item(src, Nsrc, mode, (j / nkt) * 128, (j % nkt) * 64, dst, ldd, tile, tid, mode == 1);
    }
    { bf16_t* WinT = (bf16_t*)(ws + WS_WIN); LAS float* wt = tile;
      for (int it = blockIdx.x; it < 128; it += G) {
          const int cs = it & 1, kb = (it >> 1) & 15, g = it >> 5;
#pragma unroll
          for (int e = 0; e < 8; ++e) { const int idx = tid + 512 * e, kd = idx >> 6, cc = idx & 63; wt[kd * 65 + cc] = a->in[10][((size_t)l * D + kb * 64 + kd) * 2304 + 2048 + g * 64 + cc]; }
          __syncthreads();
          const int kd = tid & 63, kq = tid >> 6;
          float acc[8];
#pragma unroll
          for (int e = 0; e < 8; ++e) acc[e] = 0.f;
          for (int cc = 0; cc < 64; ++cc) {
              const float x = wt[kd * 65 + cc];
#pragma unroll
              for (int e = 0; e < 8; ++e) { const int idx = ((kq * 8 + e) * cc - (cs ? 16 : 0)) & 63; acc[e] += x * t64[idx]; }
          }
#pragma unroll
          for (int e = 0; e < 8; ++e) WinT[(size_t)(2048 + cs * 256 + g * 64 + kq * 8 + e) * D + kb * 64 + kd] = f2bf(acc[e]);
          __syncthreads();
      } }
    { bf16_t* WoutT = (bf16_t*)(ws + WS_WOUT); LAS float* wfs = tile; LAS float* red = (LAS float*)lds;
      for (int it = blockIdx.x; it < 256; it += G) {
          const int ib = it >> 4, nb = it & 15;
#pragma unroll
          for (int e = 0; e < 8; ++e) { const int idx = tid + 512 * e, i = idx >> 8, j = idx & 255; wfs[j * 17 + i] = a->in[18][((size_t)l * 256 + ib * 16 + i) * 256 + j]; }
          __syncthreads();
          const int w = tid >> 6, lane = tid & 63;
          const float* wo = a->in[19] + ((size_t)l * D + 768 + w * 32) * D + nb * 64 + lane;
          float acc[16];
#pragma unroll
          for (int i = 0; i < 16; ++i) acc[i] = 0.f;
#pragma unroll 8
          for (int jj = 0; jj < 32; ++jj) { const float x = wo[(size_t)jj * D];
#pragma unroll
              for (int i = 0; i < 16; ++i) acc[i] += x * wfs[(w * 32 + jj) * 17 + i]; }
#pragma unroll
          for (int i = 0; i < 16; ++i) red[(w * 16 + i) * 64 + lane] = acc[i];
          __syncthreads();
#pragma unroll
          for (int hh = 0; hh < 2; ++hh) { const int i = (tid >> 6) + 8 * hh; float sacc = 0.f;
#pragma unroll
              for (int q = 0; q < 8; ++q) sacc += red[(q * 16 + i) * 64 + lane];
              WoutT[(size_t)(nb * 64 + lane) * D + 768 + ib * 16 + i] = f2bf(sacc); }
          __syncthreads();
      } }
    { bf16_t* KAS = (bf16_t*)(ws + WS_KAS); bf16_t* VAS = (bf16_t*)(ws + WS_VAS); bf16_t* KBS = (bf16_t*)(ws + WS_KBS); bf16_t* VBS = (bf16_t*)(ws + WS_VBS);
      for (int i = blockIdx.x * 512 + tid; i < 2 * 256 * 1280; i += G * 512) {
          const int e = i % 1280, bp = i / 1280, b = bp >> 8, pos = bp & 255;
          const size_t cbase = (size_t)((b * 2 + l) * 256 + pos);
          if (e < 128) { const int kvh = e >> 6, d = e & 63; KAS[((size_t)(b * 2 + kvh) * LKS + pos) * 64 + d] = f2bf(a->in[2][cbase * 128 + e]); }
          else if (e < 256) { const int e2 = e - 128, kvh = e2 >> 6, d = e2 & 63; VAS[((size_t)(b * 2 + kvh) * 64 + d) * LKS + pos] = f2bf(a->in[3][cbase * 128 + e2]); }
          else if (e < 768) { const int e2 = e - 256, s = e2 >> 6, d = e2 & 63; KBS[((size_t)(b * 8 + s) * LKS + pos) * 64 + d] = f2bf(a->in[4][cbase * 512 + e2]); }
          else { const int e2 = e - 768, hh = e2 >> 7, d = e2 & 127; VBS[((size_t)(b * 4 + hh) * 128 + d) * LKS + pos] = f2bf(a->in[5][cbase * 512 + e2]); }
      } }
    __syncthreads();
}

DI void p0_prologue(KP a, LAS unsigned char* lds) {
    unsigned char* ws = a->ws; const int tid = otid(), G = gridDim.x;
    { LAS float* sv = (LAS float*)lds; LAS float* red = (LAS float*)(lds + 16384);
      for (int i = tid; i < 3072; i += 512) { const int m = i >> 10, k = i & 1023; const float cv = (m == 0) ? a->in[7][k] : a->in[6][(m - 1) * D + k]; sv[i] = cv / (1.f + __expf(-cv)); }
      __syncthreads();
      float* MOD = (float*)(ws + WS_MOD);
      for (int it = blockIdx.x; it < 256; it += G) {
          const int col0 = it * 72, l = col0 / 9216, c0 = col0 % 9216, kg = tid / 72, cc = tid % 72;
          float a0 = 0.f, a1 = 0.f, a2 = 0.f;
          if (kg < 7) { const float* w = a->in[8] + (size_t)l * D * 9216 + c0 + cc;
#pragma unroll 8
              for (int k = kg; k < D; k += 7) { const float wv = w[(size_t)k * 9216]; a0 += sv[k] * wv; a1 += sv[1024 + k] * wv; a2 += sv[2048 + k] * wv; }
              red[(kg * 3 + 0) * 72 + cc] = a0; red[(kg * 3 + 1) * 72 + cc] = a1; red[(kg * 3 + 2) * 72 + cc] = a2; }
          __syncthreads();
          if (tid < 216) { const int m = tid / 72, c2 = tid % 72; float s = 0.f;
#pragma unroll
              for (int q = 0; q < 7; ++q) s += red[(q * 3 + m) * 72 + c2];
              MOD[(size_t)(l * 3 + m) * 9216 + c0 + c2] = s + a->in[9][l * 9216 + c0 + c2]; }
          __syncthreads();
      } }
    if (blockIdx.x == G - 1) {
        float* ROPE = (float*)(ws + WS_ROPE);
        for (int i = tid; i < 1024; i += 512) { const int pos = i >> 4, f = i & 15;
            const float inv = exp2f(-(float)f * (13.2877123795f / 16.f)); float rev = (float)pos * inv * 0.15915494309f; rev -= floorf(rev);
            ROPE[2 * i] = cospif(2.f * rev); ROPE[2 * i + 1] = sinpif(2.f * rev); }
    }
    { LAS float* tab = (LAS float*)lds;
      __syncthreads();
      for (int i = tid; i < 4096; i += 512) tab[i] = cospif((float)i * (1.f / 2048.f));
      __syncthreads();
      bf16_t* DS = (bf16_t*)(ws + WS_DFTS);
      for (int p = blockIdx.x; p < 4096; p += G)
          for (int ch = tid; ch < 1024; ch += 512) {
              const int k0 = ch * 8, n0 = k0 & 4095; const bool sp = k0 >= 4096; float v[8];
#pragma unroll
              for (int e = 0; e < 8; ++e) { const int idx = (p * (n0 + e)) & 4095; v[e] = (sp ? -tab[(idx - 1024) & 4095] : tab[idx]) * (1.f / 512.f); }
              u32x4 w; w.x = pk2(v[0], v[1]); w.y = pk2(v[2], v[3]); w.z = pk2(v[4], v[5]); w.w = pk2(v[6], v[7]);
              *(u32x4*)(DS + (size_t)p * 8192 + k0) = w;
          }
      bf16_t* DP = (bf16_t*)(ws + WS_DFTP);
      for (int p = blockIdx.x; p < 256; p += G)
          if (tid < 64) {
              const int k0 = tid * 8, n0 = k0 & 255; const bool sp = k0 >= 256; float v[8];
#pragma unroll
              for (int e = 0; e < 8; ++e) { const int idx = ((p * (n0 + e)) & 255) * 16; v[e] = (sp ? -tab[(idx - 1024) & 4095] : tab[idx]) * (1.f / 128.f); }
              u32x4 w; w.x = pk2(v[0], v[1]); w.y = pk2(v[2], v[3]); w.z = pk2(v[4], v[5]); w.w = pk2(v[6], v[7]);
              *(u32x4*)(DP + (size_t)p * 512 + k0) = w;
          }
      __syncthreads(); }
    convert_layer(a, 0, lds);
}

DI void p_modulate0(KP a) {
    const float* MOD = (const float*)(a->ws + WS_MOD); bf16_t* H = (bf16_t*)(a->ws + WS_H);
    for (int i = blockIdx.x * 512 + otid(); i < T * 128; i += gridDim.x * 512) {
        const int row = i >> 7, c0 = (i & 127) * 8;
        const float* sp = (row < TP) ? a->in[0] + (size_t)row * D : a->in[1] + (size_t)(row - TP) * D;
        const float* md = MOD + (size_t)(row < TP ? 0 : 1 + ((row - TP) >> 12)) * 9216;
        float v[8];
#pragma unroll
        for (int q = 0; q < 2; ++q) { const f32x4 x = *(const f32x4*)(sp + c0 + 4 * q), sh = *(const f32x4*)(md + c0 + 4 * q), sc = *(const f32x4*)(md + 1024 + c0 + 4 * q);
#pragma unroll
            for (int e = 0; e < 4; ++e) v[4 * q + e] = x[e] * (1.f + sc[e]) + sh[e]; }
        u32x2 w; w.x = pk4f8(v[0] * H8_SCALE, v[1] * H8_SCALE, v[2] * H8_SCALE, v[3] * H8_SCALE); w.y = pk4f8(v[4] * H8_SCALE, v[5] * H8_SCALE, v[6] * H8_SCALE, v[7] * H8_SCALE);
        *(u32x2*)((unsigned char*)H + (size_t)row * D + c0) = w;
    }
}

DI void p_layernorm(const float* X, float* xo, bf16_t* H, const float* g, const float* bta, const float* modn  , bool f8) {
    const int tid = otid(), wave = tid >> 6, lane = tid & 63;
    for (int row = blockIdx.x * 8 + wave; row < T; row += gridDim.x * 8) {
        f32x4 v[4];
#pragma unroll
        for (int i = 0; i < 4; ++i) v[i] = *(const f32x4*)(X + (size_t)row * D + i * 256 + lane * 4);
        float s = 0.f;
#pragma unroll
        for (int i = 0; i < 4; ++i) s += (v[i][0] + v[i][1]) + (v[i][2] + v[i][3]);
        const float mean = wave_sum(s) * (1.f / 1024.f);
        float q = 0.f;
#pragma unroll
        for (int i = 0; i < 4; ++i) { v[i] = v[i] - mean; q += (v[i][0] * v[i][0] + v[i][1] * v[i][1]) + (v[i][2] * v[i][2] + v[i][3] * v[i][3]); }
        const float rstd = rsqrtf(wave_sum(q) * (1.f / 1024.f) + 1e-5f);
        const float* md = modn ? modn + (size_t)(row < TP ? 0 : 1 + ((row - TP) >> 12)) * 9216 : nullptr;
#pragma unroll
        for (int i = 0; i < 4; ++i) {
            const int c = i * 256 + lane * 4;
            const f32x4 y = v[i] * rstd * *(const f32x4*)(g + c) + *(const f32x4*)(bta + c);
            *(f32x4*)(xo + (size_t)row * D + c) = y;
            if (md) { const f32x4 sh = *(const f32x4*)(md + c), sc = *(const f32x4*)(md + 1024 + c);
                const float h0 = y[0] * (1.f + sc[0]) + sh[0], h1 = y[1] * (1.f + sc[1]) + sh[1], h2 = y[2] * (1.f + sc[2]) + sh[2], h3 = y[3] * (1.f + sc[3]) + sh[3];
                if (f8) *(unsigned*)((unsigned char*)H + (size_t)row * D + c) = pk4f8(h0 * H8_SCALE, h1 * H8_SCALE, h2 * H8_SCALE, h3 * H8_SCALE);
                else { u32x2 w; w.x = pk2(h0, h1); w.y = pk2(h2, h3); *(u32x2*)(H + (size_t)row * D + c) = w; } }
        }
    }
}

DI void p_combine(KP a, int l) {
    const int tid = otid(), wave = tid >> 6, lane = tid & 63;
    const bf16_t* OBT = (const bf16_t*)(a->ws + WS_H); bf16_t* MIX = (bf16_t*)(a->ws + WS_MIX);
    const float lam_init = (l == 0) ? 0.2f : (0.8f - 0.6f * 0.74081822068f);
    const float d1 = wave_sum(a->in[13][l * 64 + lane] * a->in[14][l * 64 + lane]), d2 = wave_sum(a->in[15][l * 64 + lane] * a->in[16][l * 64 + lane]);
    const float lam = expf(d1) - expf(d2) + lam_init;
    const float g0 = a->in[17][l * 128 + 2 * lane] * (1.f - lam_init), g1 = a->in[17][l * 128 + 2 * lane + 1] * (1.f - lam_init);
    for (int row = blockIdx.x * 8 + wave; row < T; row += gridDim.x * 8) {
#pragma unroll
        for (int hb = 0; hb < 4; ++hb) {
            const unsigned w1 = *(const unsigned*)(OBT + (size_t)row * D + hb * 256 + 2 * lane), w2 = *(const unsigned*)(OBT + (size_t)row * D + hb * 256 + 128 + 2 * lane);
            const float x0 = __uint_as_float(w1 << 16) - lam * __uint_as_float(w2 << 16), x1 = __uint_as_float(w1 & 0xffff0000u) - lam * __uint_as_float(w2 & 0xffff0000u);
            const float rs = rsqrtf(wave_sum(x0 * x0 + x1 * x1) * (1.f / 128.f) + 1e-6f);
            *(unsigned*)(MIX + (size_t)row * D + 256 + hb * 128 + 2 * lane) = pk2(x0 * rs * g0, x1 * rs * g1);
        }
    }
}


#define XB_TMO      128
#define XB_XCNT(j)  (256  + 64 * (j))
#define XB_XSUB(j)  (1280 + 64 * (j))
#define XB_XGEN(j)  (2304 + 64 * (j))
#define XB_TOP      3328
#define XB_TOPGEN   3392
#define XCD_BAR_WORDS 3456
#define XB_SPIN_CAP (1u << 18)
DI unsigned xb_ld(unsigned* p)              { return __hip_atomic_load(p, __ATOMIC_RELAXED, __HIP_MEMORY_SCOPE_AGENT); }
DI unsigned xb_add(unsigned* p, unsigned v) { return __hip_atomic_fetch_add(p, v, __ATOMIC_RELAXED, __HIP_MEMORY_SCOPE_AGENT); }
DI unsigned xb_xcc_id() { return (unsigned)__builtin_amdgcn_s_getreg((3 << 11) | 20) & 0xFu; }
#define XB_SPIN(cond, bar) do { unsigned _sp = 0; while (cond) { __builtin_amdgcn_s_sleep(1); \
    if ((++_sp & 255u) == 0u) { if (xb_ld(&(bar)[XB_TMO])) break; if (_sp > XB_SPIN_CAP) { atomicAdd(&(bar)[XB_TMO], 1u); break; } } } } while (0)
struct XcdBarrier { unsigned* bar; unsigned x; volatile LAS unsigned* st; };
DI XcdBarrier xcd_barrier_post(unsigned* bar, volatile LAS unsigned* st) {
    XcdBarrier b; b.bar = bar; b.x = xb_xcc_id(); b.st = st;
    if (threadIdx.x == 0) (void)xb_add(&bar[XB_XCNT(b.x)], 1u);
    return b;
}
DI void xcd_barrier_complete(unsigned* bar, unsigned x, unsigned& nloc, unsigned& nx) {
    const unsigned G = gridDim.x * gridDim.y * gridDim.z;
    unsigned sum, cnt, mine, sp = 0u;
    for (;;) {
        sum = 0u; cnt = 0u; mine = 0u;
#pragma unroll
        for (unsigned j = 0; j < 16; ++j) { const unsigned c = xb_ld(&bar[XB_XCNT(j)]); sum += c; cnt += (c > 0u) ? 1u : 0u; mine = (j == x) ? c : mine; }
        if (sum == G) break;
        __builtin_amdgcn_s_sleep(1);
        if ((++sp & 255u) == 0u) { if (xb_ld(&bar[XB_TMO])) break; if (sp > XB_SPIN_CAP) { atomicAdd(&bar[XB_TMO], 1u); break; } }
    }
    nloc = mine > 0u ? mine : 1u; nx = cnt > 0u ? cnt : 1u;
}
DI void xcd_barrier(const XcdBarrier& b) {
    asm volatile("s_waitcnt vmcnt(0)" ::: "memory");
    __syncthreads();
    if (threadIdx.x == 0) {
        unsigned* bar = b.bar;
        __builtin_amdgcn_s_waitcnt(0);
        unsigned nloc = b.st[0], nx = b.st[1];
        if (nloc == 0u) { xcd_barrier_complete(bar, b.x, nloc, nx); b.st[0] = nloc; b.st[1] = nx; }
        const unsigned old = xb_add(&bar[XB_XSUB(b.x)], 1u);
        const unsigned gen = old / nloc;
        if (old + 1u == (gen + 1u) * nloc) {
            __builtin_amdgcn_fence(__ATOMIC_RELEASE, "agent");
            asm volatile("s_waitcnt vmcnt(0)" ::: "memory");
            const unsigned og = xb_add(&bar[XB_TOP], 1u);
            const unsigned tg = og / nx;
            if (og + 1u == (tg + 1u) * nx) xb_add(&bar[XB_TOPGEN], 1u);
            else XB_SPIN(xb_ld(&bar[XB_TOPGEN]) == tg, bar);
            __builtin_amdgcn_fence(__ATOMIC_ACQUIRE, "agent");
            xb_add(&bar[XB_XGEN(b.x)], 1u);
            asm volatile("s_waitcnt vmcnt(0)" ::: "memory");
        } else {
            XB_SPIN(xb_ld(&bar[XB_XGEN(b.x)]) == gen, bar);
            __builtin_amdgcn_fence(__ATOMIC_ACQUIRE, "agent");
            asm volatile("s_waitcnt vmcnt(0)" ::: "memory");
        }
    }
    __syncthreads();
}

#ifndef PROBE_MASK
#define PROBE_MASK 0
#endif
constexpr int N_PHASES = 24;
#define PHM(i) ((MASK >> (i)) & 1)
template <int MASK> __global__ void __launch_bounds__(512) trunk_fwd(KArgs a_unused) {
    extern __shared__ __attribute__((aligned(16))) unsigned char lds_raw[];
    LAS unsigned char* lds = (LAS unsigned char*)lds_raw;
    cg::grid_group grid = cg::this_grid();
    const KP a0 = (KP)__builtin_amdgcn_kernarg_segment_ptr();
    unsigned char* ws = a0->ws;
    const int G = gridDim.x, c = blockIdx.x;
    float* X = (float*)(ws + WS_X); bf16_t* H = (bf16_t*)(ws + WS_H); bf16_t* ACT = (bf16_t*)(ws + WS_ACT); bf16_t* MIX = (bf16_t*)(ws + WS_MIX);
    const float* MOD = (const float*)(ws + WS_MOD);
    volatile LAS unsigned* misc = (volatile LAS unsigned*)(lds + MISC_OFF);
    if (threadIdx.x < 16) misc[threadIdx.x] = 0u;
    __syncthreads();
    XcdBarrier xbar = xcd_barrier_post((unsigned*)(ws + WS_CTL) + 64, misc + 8);
    const int ph_lo = a0->ph_lo, ph_hi = a0->ph_hi;
    int redo = 0;
    for (int ph = ph_lo; ph < ph_hi; ++ph) {
        const int tid = otid();
        KP a = a0; asm volatile("" : "+s"(a));
        int kbit; if (ph < 2) kbit = ph; else { const int k_ = (ph - 2) % 11; kbit = (k_ == 0 || k_ == 8) ? 2 : (k_ == 1 || k_ == 9 || k_ == 6) ? 3 : (k_ == 2 || k_ == 7 || k_ == 10) ? 4 : (k_ == 3) ? 5 : (k_ == 4) ? 7 : 8; }
        const int rep = redo;
        {
        if (ph == 0) { if (PHM(0)) p0_prologue(a, lds); }
        else if (ph == 1) { if (PHM(1)) p_modulate0(a); }
        else {
            const int l = (ph - 2) / 11, k = (ph - 2) % 11;
            const float* modl = MOD + (size_t)l * 3 * 9216;
            if (k == 0 || k == 8) { if (PHM(2)) {
                pg8::Gemm g{H, (const bf16_t*)(ws + (k == 0 ? WS_WGU1 : WS_WGU2)), D / 2, D / 2}; pg8::StaticOrder S; S.init(T, 2 * FF, G, c);
                pg8::EpiGU E{ACT, 1.f / (H8_SCALE * WGU8_SCALE)};
                pg8::gemm_phase<pg8::EpiGU, pg8::StaticOrder, true, true, true>(lds, g, S, E); }
            } else if (k == 1 || k == 9 || k == 6) { if (PHM(3)) {
                pg8::Gemm g; pg8::EpiRes E;
                if (k == 6) { g = pg8::Gemm{MIX, (const bf16_t*)(ws + WS_WOUT), D, D}; E = pg8::EpiRes{X, X + (size_t)TP * D, X, modl + 5 * 1024, 1.0f}; }
                else { g = pg8::Gemm{ACT, (const bf16_t*)(ws + (k == 1 ? WS_WD1 : WS_WD2)), FF, FF};
                    const bool first = (l == 0 && k == 1);
                    E = pg8::EpiRes{first ? a->in[0] : X, first ? a->in[1] : X + (size_t)TP * D, X, modl + (k == 1 ? 2 : 8) * 1024, 0.5f}; }
                pg8::StaticOrder S; S.init(T, D, G, c);
                pg8::gemm_phase<pg8::EpiRes, pg8::StaticOrder, true, true>(lds, g, S, E); }
            } else if (k == 2 || k == 7 || k == 10) { if (PHM(4)) {
                const int which = (k == 2) ? 0 : (k == 7 ? 1 : 2);
                const float* lg = a->in[24] + (size_t)(l * 3 + which) * D; const float* lb = a->in[25] + (size_t)(l * 3 + which) * D;
                const bool final_ = (l == 1 && k == 10);
                const float* modn = (k == 2) ? modl + 3 * 1024 : (k == 7) ? modl + 6 * 1024 : (final_ ? nullptr : MOD + (size_t)(l + 1) * 3 * 9216);
                p_layernorm(X, final_ ? a->out : X, H, lg, lb, modn, which != 0);
                if (k == 10 && l == 0) convert_layer(a, 1, lds); }
            } else if (k == 3) { if (PHM(5)) {
                pg8::Gemm g{H, (const bf16_t*)(ws + WS_WIN), D, D}; pg8::StaticOrder S; S.init(T, NIN, G, c);
                pg8::EpiIn E{l, a->in[11], a->in[12], a->out, ws};
                pg8::gemm_phase<pg8::EpiIn, pg8::StaticOrder, true, true>(lds, g, S, E); }
            } else if (k == 4) {
                if (PHM(6) && (rep == 0 || ((PROBE_MASK >> 6) & 1))) {
#pragma clang loop unroll(disable)
                    for (int pass = 0; pass < 2; ++pass) {
                        const bool sp = pass == 0;
                        pg8::Gemm g{(const bf16_t*)(ws + (sp ? WS_DFTS : WS_DFTP)), (const bf16_t*)(ws + (sp ? WS_UTS : WS_UTP)), sp ? 8192 : 512, sp ? 8192 : 512};
                        pg8::FourOrder S{G, c, sp ? 32 : 16, pass}; pg8::EpiFour E{MIX, pass};
                        pg8::gemm_phase<pg8::EpiFour, pg8::FourOrder, true, true>(lds, g, S, E);
                    }
                }
                volatile LAS int* qslot = (volatile LAS int*)(lds + MISC_OFF);
                unsigned* ctr = (unsigned*)(ws + WS_CTL) + l + 2 * rep;
                const bf16_t* QA = (const bf16_t*)(ws + WS_QA); const bf16_t* QB = (const bf16_t*)(ws + WS_QB);
                bf16_t* OBT = (bf16_t*)(ws + WS_H);
                if (PHM(7) && (rep == 0 || ((PROBE_MASK >> 7) & 1))) for (;;) {
                    __syncthreads();
                    if (tid == 0) *qslot = (int)atomicAdd(ctr, 1u);
                    __syncthreads();
                    const int idx = *qslot;
                    if (idx >= 576) break;
                    const bf16_t *Qp, *Kp, *Vp; bf16_t* Op; int qpitch, Lk; bool wide;
                    if (idx < 256) { const int b = idx >> 7, s = (idx >> 4) & 7, qb = idx & 15; const size_t tok0 = TP + b * 4096 + qb * 256; wide = true; qpitch = 512; Lk = LKS;
                        Qp = QB + tok0 * 512 + s * 64; Kp = (const bf16_t*)(ws + WS_KBS) + (size_t)(b * 8 + s) * LKS * 64; Vp = (const bf16_t*)(ws + WS_VBS) + (size_t)(b * 4 + (s >> 1)) * 128 * LKS; Op = OBT + tok0 * D + s * 128; }
                    else if (idx < 384) { const int i = idx - 256, b = i >> 6, hq = (i >> 4) & 3, qb = i & 15; const size_t tok0 = TP + b * 4096 + qb * 256; wide = false; qpitch = 256; Lk = LKS;
                        Qp = QA + tok0 * 256 + hq * 64; Kp = (const bf16_t*)(ws + WS_KAS) + (size_t)(b * 2 + (hq >> 1)) * LKS * 64; Vp = (const bf16_t*)(ws + WS_VAS) + (size_t)(b * 2 + (hq >> 1)) * 64 * LKS; Op = MIX + tok0 * D + hq * 64; }
                    else if (idx < 512) { const int i = idx - 384, b = i >> 3, s = i & 7; const size_t tok0 = b * 256; wide = true; qpitch = 512; Lk = 256;
                        Qp = QB + tok0 * 512 + s * 64; Kp = (const bf16_t*)(ws + WS_KBP) + (size_t)(b * 8 + s) * 256 * 64; Vp = (const bf16_t*)(ws + WS_VBP) + (size_t)(b * 4 + (s >> 1)) * 128 * 256; Op = OBT + tok0 * D + s * 128; }
                    else { const int i = idx - 512, b = i >> 2, hq = i & 3; const size_t tok0 = b * 256; wide = false; qpitch = 256; Lk = 256;
                        Qp = QA + tok0 * 256 + hq * 64; Kp = (const bf16_t*)(ws + WS_KAP) + (size_t)(b * 2 + (hq >> 1)) * 256 * 64; Vp = (const bf16_t*)(ws + WS_VAP) + (size_t)(b * 2 + (hq >> 1)) * 64 * 256; Op = MIX + tok0 * D + hq * 64; }
                    if (wide) attn_unit<128>(Qp, qpitch, Kp, Vp, Lk, Op, D, lds); else attn_unit<64>(Qp, qpitch, Kp, Vp, Lk, Op, D, lds);
                }
            } else if (k == 5) {
                if (PHM(8)) p_combine(a, l);
            }
        }
        }
        if (ph + 1 < ph_hi || (PROBE_MASK && redo == 0)) { if (ph == 0 && redo == 0 && !((PROBE_MASK >> 0) & 1)) grid.sync(); else if (ph == 0 && redo == 1) grid.sync(); else xcd_barrier(xbar); }
        if ((((PROBE_MASK >> kbit) & 1) || (kbit == 7 && ((PROBE_MASK >> 6) & 1))) && redo == 0) { redo = 1; --ph; } else redo = 0;
    }
}

typedef void (*kern_t)(KArgs);
extern "C" void kernel_launch(void* const* d_in, const int* in_sizes, int n_in, void* d_out, int out_size, void* d_ws, size_t ws_size, hipStream_t stream) {
    static int grid = 0;
#if MK_PER_PHASE
    static const kern_t kerns[8] = {trunk_fwd<0x1>, trunk_fwd<0x2>, trunk_fwd<0x4>, trunk_fwd<0x8>, trunk_fwd<0x10>, trunk_fwd<0x20>, trunk_fwd<0xC0>, trunk_fwd<0x100>};
    constexpr int NK = 8;
#else
    static const kern_t kerns[1] = {trunk_fwd<0x1ff>};
    constexpr int NK = 1;
#endif
    if (grid == 0) {
        if (n_in != 26 || ws_size < WS_END) { fprintf(stderr, "kernel_launch: need 26 inputs and %zu bytes of workspace; got %d, %zu\n", (size_t)WS_END, n_in, ws_size); grid = -1; return; }
        int dev = 0, cus = 0, per_cu = 0;
        if (hipGetDevice(&dev) != hipSuccess || hipDeviceGetAttribute(&cus, hipDeviceAttributeMultiprocessorCount, dev) != hipSuccess) { grid = -1; return; }
        for (int i = 0; i < NK; ++i) {
            if (hipFuncSetAttribute((const void*)kerns[i], hipFuncAttributeMaxDynamicSharedMemorySize, LDS_BYTES) != hipSuccess) { fprintf(stderr, "kernel_launch: hipFuncSetAttribute failed\n"); grid = -1; return; }
            if (hipOccupancyMaxActiveBlocksPerMultiprocessor(&per_cu, (const void*)kerns[i], 512, LDS_BYTES) != hipSuccess || per_cu < 1) { fprintf(stderr, "kernel_launch: occupancy query says %d\n", per_cu); (void)hipGetLastError(); grid = -1; return; }
        }
        grid = cus * 1;
    }
    if (grid < 0) return;
    if (hipMemsetAsync((char*)d_ws + WS_CTL, 0, 16384, stream) != hipSuccess) { fprintf(stderr, "kernel_launch: memset failed\n"); return; }
    KArgs a{};
    for (int i = 0; i < 26; ++i) a.in[i] = (const float*)d_in[i];
    a.out = (float*)d_out; a.ws = (unsigned char*)d_ws;
#if MK_PER_PHASE
    for (int ph = 0; ph < N_PHASES; ++ph) {
        a.ph_lo = ph; a.ph_hi = ph + 1;
        int ki;
        if (ph < 2) ki = ph;
        else { const int k = (ph - 2) % 11; ki = (k == 0 || k == 8) ? 2 : (k == 1 || k == 9 || k == 6) ? 3 : (k == 2 || k == 7 || k == 10) ? 4 : (k == 3) ? 5 : (k == 4) ? 6 : 7; }
        hipLaunchKernelGGL(kerns[ki], dim3(grid), dim3(512), LDS_BYTES, stream, a);
    }
#else
    a.ph_lo = 0; a.ph_hi = N_PHASES;
    void* args[] = {&a};
    hipError_t e = hipLaunchCooperativeKernel((const void*)kerns[0], dim3(grid), dim3(512), args, LDS_BYTES, stream);
    if (e != hipSuccess) fprintf(stderr, "cooperative launch failed: %s (grid %d)\n", hipGetErrorString(e), grid);
#endif
}
```

```cpp
#include <hip/hip_runtime.h>
#include <hip/hip_cooperative_groups.h>
#include <cstdio>
#include <cstdint>
namespace cg = cooperative_groups;

#ifndef MK_PER_PHASE
#define MK_PER_PHASE 0
#endif

#define DI __device__ __forceinline__
#define LAS __attribute__((address_space(3)))
typedef unsigned short bf16_t;
typedef short bf16x8 __attribute__((ext_vector_type(8)));
typedef short s16x4 __attribute__((ext_vector_type(4)));
typedef float f32x4 __attribute__((ext_vector_type(4)));
typedef float f32x16 __attribute__((ext_vector_type(16)));
typedef unsigned u32x4 __attribute__((ext_vector_type(4)));
typedef unsigned u32x2 __attribute__((ext_vector_type(2)));
typedef __bf16 bf16x2_t __attribute__((ext_vector_type(2)));
typedef int v4i_t __attribute__((ext_vector_type(4)));
typedef int v8i_t __attribute__((ext_vector_type(8)));
typedef float f32x2_t __attribute__((ext_vector_type(2)));

DI unsigned pk2(float lo, float hi) { f32x2_t v = {lo, hi}; bf16x2_t b = __builtin_convertvector(v, bf16x2_t); return __builtin_bit_cast(unsigned, b); }
DI unsigned pk4f8(float a, float b, float c, float d) { int w = 0; w = __builtin_amdgcn_cvt_pk_fp8_f32(a, b, w, false); w = __builtin_amdgcn_cvt_pk_fp8_f32(c, d, w, true); return (unsigned)w; }
DI bf16_t f2bf(float f) { return (bf16_t)(pk2(f, 0.f) & 0xffffu); }
DI int otid() { int t = threadIdx.x; asm volatile("" : "+v"(t)); return t; }
template <int M> DI float shx(float v) { return __builtin_bit_cast(float, __builtin_amdgcn_ds_swizzle(__builtin_bit_cast(int, v), 0x1f | (M << 10))); }
DI float shx32(float v) { const int l = otid() & 63; return __builtin_bit_cast(float, __builtin_amdgcn_ds_bpermute((l ^ 32) << 2, __builtin_bit_cast(int, v))); }
DI float wave_sum(float v) { v += shx<1>(v); v += shx<2>(v); v += shx<4>(v); v += shx<8>(v); v += shx<16>(v); v += shx32(v); return v; }

constexpr int T = 12288, TP = 4096, D = 1024, FF = 2816, NIN = 2560, LKS = 4352;
constexpr float ALPHA = 1.41421356237f;
constexpr float H8_SCALE = 16.f, WGU8_SCALE = 256.f, ACT8_SCALE = 4.f, WD8_SCALE = 2048.f;
constexpr float QSCALE = 0.125f * 1.44269504089f;

constexpr size_t al256(size_t x) { return (x + 255) & ~(size_t)255; }
constexpr size_t WS_CTL = 0;
constexpr size_t WS_MOD = 16384;
constexpr size_t WS_ROPE = WS_MOD + al256(2 * 3 * 9216 * 4);
constexpr size_t WS_DFTP = WS_ROPE + 8192;
constexpr size_t WS_DFTS = WS_DFTP + 256 * 512 * 2;
constexpr size_t WS_WGU1 = WS_DFTS + (size_t)4096 * 8192 * 2;
constexpr size_t WS_WD1 = WS_WGU1 + (size_t)5632 * 1024 * 2;
constexpr size_t WS_WIN = WS_WD1 + (size_t)1024 * 2816 * 2;
constexpr size_t WS_WOUT = WS_WIN + (size_t)2560 * 1024 * 2;
constexpr size_t WS_WGU2 = WS_WOUT + (size_t)1024 * 1024 * 2;
constexpr size_t WS_WD2 = WS_WGU2 + (size_t)5632 * 1024 * 2;
constexpr size_t WS_X = WS_WD2 + (size_t)1024 * 2816 * 2;
constexpr size_t WS_KAS = WS_X + (size_t)T * D * 4;
constexpr size_t WS_VAS = WS_KAS + (size_t)2 * 2 * LKS * 64 * 2;
constexpr size_t WS_KBS = WS_VAS + (size_t)2 * 2 * LKS * 64 * 2;
constexpr size_t WS_VBS = WS_KBS + (size_t)2 * 8 * LKS * 64 * 2;
constexpr size_t WS_H = WS_VBS + (size_t)2 * 4 * 128 * LKS * 2;
constexpr size_t WS_R = WS_H + (size_t)T * D * 2;
constexpr size_t WS_ACT = WS_R;
constexpr size_t WS_QA = WS_R;
constexpr size_t WS_QB = WS_QA + (size_t)T * 256 * 2;
constexpr size_t WS_KAP = WS_QB + (size_t)T * 512 * 2;
constexpr size_t WS_VAP = WS_KAP + (size_t)16 * 2 * 256 * 64 * 2;
constexpr size_t WS_KBP = WS_VAP + (size_t)16 * 2 * 256 * 64 * 2;
constexpr size_t WS_VBP = WS_KBP + (size_t)16 * 8 * 256 * 64 * 2;
constexpr size_t WS_UTP = WS_VBP + (size_t)16 * 4 * 128 * 256 * 2;
constexpr size_t WS_UTS = WS_UTP + (size_t)4096 * 512 * 2;
constexpr size_t WS_MIX = WS_UTS + (size_t)512 * 8192 * 2;
constexpr size_t WS_FACC = WS_MIX + (size_t)T * D * 2;
constexpr size_t WS_REND = WS_FACC + (size_t)T * 256 * 4;
constexpr size_t WS_END = (WS_REND > WS_ACT + (size_t)T * FF * 2) ? WS_REND : WS_ACT + (size_t)T * FF * 2;

constexpr int LDS_RING = 131072, MISC_OFF = LDS_RING, LDS_BYTES = LDS_RING + 256;

struct KArgs { const float* in[26]; float* out; unsigned char* ws; int ph_lo, ph_hi; };
typedef const KArgs __attribute__((address_space(4)))* KP;

namespace pg8 {
constexpr int BM = 256, BK = 64, HALF = 128, HTB = HALF * BK * 2, STAGE_BYTES = 8 * HTB, NXCD = 8, WGM = 8;
DI int lds_byte(int r, int c) { const int st = (r >> 4) * 2 + (c >> 5), rr = r & 15, cc = c & 31, ob = rr * 64 + cc * 2; return st * 1024 + (ob ^ (((ob >> 9) & 1) << 5)); }
DI void stage_rc(int b, int& R, int& C) { const int st = b / 1024, sb = b % 1024, swz = sb ^ (((sb >> 9) & 1) << 5); R = (st >> 1) * 16 + swz / 64; C = (st & 1) * 32 + (swz % 64) / 2; }
DI int perm32(int rho) { const int n = rho >> 4, i = rho & 15; return 8 * (i >> 2) + 4 * n + (i & 3); }

struct Unit { int pm, pn, ko; };
struct Gemm { const bf16_t* A; const bf16_t* Bt; int ld, K; };

struct StaticOrder {
    int nM, nN, nwg, G, c;
    DI void init(int M, int N, int G_, int c_) { nM = M / BM; nN = N / BM; nwg = nM * nN; G = G_; c = c_; }
    DI bool next(int i, Unit& u) const {
        const long L = (long)i * G + c; if (L >= nwg) return false;
        int wgid = (int)L; { const int q = nwg / NXCD, r = nwg % NXCD, xcd = wgid % NXCD, off = wgid / NXCD; wgid = (xcd < r ? xcd * (q + 1) : r * (q + 1) + (xcd - r) * q) + off; }
        const int nig = WGM * nN, gid = wgid / nig, fm = gid * WGM, gsz = (nM - fm) < WGM ? (nM - fm) : WGM;
        u.pm = fm + ((wgid % nig) % gsz); u.pn = (wgid % nig) / gsz; u.ko = 0; return true;
    }
};
struct FourOrder {
    int G, c, total, mode;
    DI bool next(int i, Unit& u) const {
        const int L = i * G + c - (mode ? 32 : 0); if (L < 0 || L >= total) return false;
        u.ko = 0;
        if (mode == 0) { u.pm = L >> 1; u.pn = L & 1; } else { u.pm = 0; u.pn = L; }
        return true;
    }
};

template <class Epi, class Sched, bool ALIGN_EPI, bool SP2, bool F8 = false>
DI void gemm_phase(LAS unsigned char* lds, const Gemm g, const Sched& S, const Epi& E) {
    int tid = threadIdx.x; asm volatile("" : "+v"(tid));
    const int wid = __builtin_amdgcn_readfirstlane(tid >> 6), lane = tid & 63, wr = wid >> 2, wc = wid & 3, fr = lane & 15, fq = lane >> 4;
    int K = g.K; asm volatile("" : "+s"(K));
    const int nt = K / BK, ld = g.ld;
    unsigned voffA[2], voffB[2];
#pragma unroll
    for (int i = 0; i < 2; ++i) { int R, C; stage_rc(tid * 16 + i * 8192, R, C); const int Rb = (R & ~31) + perm32(R & 31);
        voffA[i] = (unsigned)(R * ld + C) * 2u; voffB[i] = (unsigned)(Rb * ld + C) * 2u; }
    const size_t kstep = (size_t)(BK * 2);
    const size_t hstep = (size_t)HALF * ld * 2;
    const size_t tstep = 2 * hstep;
    const unsigned ldsw = (unsigned)wid * 1024u;
    const unsigned ldsbase = (unsigned)(size_t)lds + ldsw;
    const int aoff = lds_byte(wr * 64 + fr, fq * 8), boff = lds_byte(wc * 32 + fr, fq * 8);
#define PG8_SA(b, h) (((b) * 2 + (h)) * HTB)
#define PG8_SB(b, h) ((4 + (b) * 2 + (h)) * HTB)
#define PG8_STAGE(bufoff, gbase, voff) do { _Pragma("unroll") for (int _i = 0; _i < 2; ++_i) { unsigned _keep; \
        asm volatile("s_mov_b32 %0, m0\n\ts_mov_b32 m0, %2\n\ts_nop 0\n\tglobal_load_lds_dwordx4 %1, %3\n\ts_mov_b32 m0, %0" : "=&s"(_keep) \
                     : "v"((voff)[_i]), "s"(ldsbase + (unsigned)((bufoff) + _i * 8192)), "s"((const char*)(gbase)) : "memory"); } } while (0)
#define PG8_LDA(dst, b, h) do { _Pragma("unroll") for (int m = 0; m < 4; ++m) { if constexpr (F8) { const v4i_t lo_ = *(const LAS v4i_t*)(lds + PG8_SA(b, h) + aoff + m * 2048), hi_ = *(const LAS v4i_t*)(lds + PG8_SA(b, h) + aoff + m * 2048 + 1024); \
        dst##8[m] = __builtin_shufflevector(lo_, hi_, 0, 1, 2, 3, 4, 5, 6, 7); } else { _Pragma("unroll") for (int k = 0; k < 2; ++k) dst[m][k] = *(const LAS bf16x8*)(lds + PG8_SA(b, h) + aoff + m * 2048 + k * 1024); } } } while (0)
#define PG8_LDB(dst, b, h) do { _Pragma("unroll") for (int n = 0; n < 2; ++n) { if constexpr (F8) { const v4i_t lo_ = *(const LAS v4i_t*)(lds + PG8_SB(b, h) + boff + n * 2048), hi_ = *(const LAS v4i_t*)(lds + PG8_SB(b, h) + boff + n * 2048 + 1024); \
        dst##8[n] = __builtin_shufflevector(lo_, hi_, 0, 1, 2, 3, 4, 5, 6, 7); } else { _Pragma("unroll") for (int k = 0; k < 2; ++k) dst[n][k] = *(const LAS bf16x8*)(lds + PG8_SB(b, h) + boff + n * 2048 + k * 1024); } } } while (0)
#define PG8_MMA(ai, bj, At, Bt) do { __builtin_amdgcn_s_setprio(1); _Pragma("unroll") for (int m = 0; m < 4; ++m) _Pragma("unroll") for (int n = 0; n < 2; ++n) { \
        if constexpr (F8) { acc[ai][bj][m][n] = __builtin_amdgcn_mfma_scale_f32_16x16x128_f8f6f4(Bt##8[n], At##8[m], acc[ai][bj][m][n], 0, 0, 0, 0, 0, 0); } \
        else { _Pragma("unroll") for (int k = 0; k < 2; ++k) acc[ai][bj][m][n] = __builtin_amdgcn_mfma_f32_16x16x32_bf16(Bt[n][k], At[m][k], acc[ai][bj][m][n], 0, 0, 0); } } \
        __builtin_amdgcn_s_setprio(0); } while (0)
#define PG8_WAIT_V(n) asm volatile("s_waitcnt vmcnt(" #n ")" ::: "memory")
#define PG8_WAIT_L(n) asm volatile("s_waitcnt lgkmcnt(" #n ")" ::: "memory")
#define PG8_BAR __builtin_amdgcn_s_barrier()
#define PG8_SCHED __builtin_amdgcn_sched_barrier(0)
    Unit cur, nxt; int ui = 0;
    if (!S.next(0, cur)) return;
    f32x4 acc[2][2][4][2];
#pragma unroll
    for (int a = 0; a < 2; ++a)
#pragma unroll
        for (int b = 0; b < 2; ++b)
#pragma unroll
            for (int m = 0; m < 4; ++m)
#pragma unroll
                for (int n = 0; n < 2; ++n) acc[a][b][m][n] = (f32x4){0.f, 0.f, 0.f, 0.f};
    bf16x8 At[4][2], B0[2][2], B1[2][2];
    v8i_t At8[4], B08[2], B18[2];
    const char* cA = (const char*)g.A + (size_t)cur.pm * tstep + (size_t)cur.ko * 2; const char* cB = (const char*)g.Bt + (size_t)cur.pn * tstep + (size_t)cur.ko * 2;
    if constexpr (SP2) {
        PG8_STAGE(PG8_SB(0, 0), cB, voffB); PG8_STAGE(PG8_SB(0, 1), cB + hstep, voffB); PG8_STAGE(PG8_SA(0, 0), cA, voffA); PG8_STAGE(PG8_SA(0, 1), cA + hstep, voffA);
        if (wr == 1) PG8_BAR;
        PG8_WAIT_V(2); PG8_BAR;
        PG8_STAGE(PG8_SB(1, 0), cB + kstep, voffB); PG8_STAGE(PG8_SA(1, 0), cA + kstep, voffA); PG8_STAGE(PG8_SB(1, 1), cB + hstep + kstep, voffB);
        PG8_WAIT_V(6); PG8_BAR;
    } else {
        PG8_STAGE(PG8_SB(0, 0), cB, voffB); PG8_STAGE(PG8_SA(0, 0), cA, voffA); PG8_STAGE(PG8_SB(0, 1), cB + hstep, voffB); PG8_STAGE(PG8_SA(0, 1), cA + hstep, voffA);
        if (wr == 1) PG8_BAR;
        PG8_WAIT_V(4); PG8_BAR;
        PG8_STAGE(PG8_SB(1, 0), cB + kstep, voffB); PG8_STAGE(PG8_SA(1, 0), cA + kstep, voffA); PG8_STAGE(PG8_SB(1, 1), cB + hstep + kstep, voffB);
        PG8_WAIT_V(6); PG8_BAR;
    }
    for (;;) {
        const bool has_next = S.next(ui + 1, nxt);
        const char* nA = has_next ? (const char*)g.A + (size_t)nxt.pm * tstep + (size_t)nxt.ko * 2 : cA; const char* nB = has_next ? (const char*)g.Bt + (size_t)nxt.pn * tstep + (size_t)nxt.ko * 2 : cB;
#pragma clang loop unroll(disable)
        for (int t = 0; t < nt; t += 2) {
            const bool last = (t == nt - 2);
            const char* a1 = cA + (size_t)(t + 1) * kstep;
            const char* a2 = last ? nA : cA + (size_t)(t + 2) * kstep; const char* b2 = last ? nB : cB + (size_t)(t + 2) * kstep;
            const char* a3 = a2 + kstep; const char* b3 = b2 + kstep;
            if constexpr (SP2) {
            PG8_LDB(B0, 0, 0); PG8_LDB(B1, 0, 1); PG8_SCHED; PG8_LDA(At, 0, 0); PG8_STAGE(PG8_SA(1, 1), a1 + hstep, voffA);
            PG8_WAIT_V(8); PG8_WAIT_L(0); PG8_BAR; PG8_MMA(0, 0, At, B0); PG8_MMA(0, 1, At, B1); PG8_BAR; PG8_SCHED;
            PG8_LDA(At, 0, 1); PG8_STAGE(PG8_SB(0, 0), b2, voffB); PG8_STAGE(PG8_SB(0, 1), b2 + hstep, voffB); PG8_STAGE(PG8_SA(0, 0), a2, voffA);
            PG8_WAIT_V(8); PG8_WAIT_L(0); PG8_BAR; PG8_MMA(1, 0, At, B0); PG8_MMA(1, 1, At, B1); PG8_BAR; PG8_SCHED;
            PG8_LDB(B0, 1, 0); PG8_LDB(B1, 1, 1); PG8_SCHED; PG8_LDA(At, 1, 0); PG8_STAGE(PG8_SA(0, 1), a2 + hstep, voffA);
            PG8_WAIT_V(8); PG8_WAIT_L(0); PG8_BAR; PG8_MMA(0, 0, At, B0); PG8_MMA(0, 1, At, B1); PG8_BAR; PG8_SCHED;
            PG8_LDA(At, 1, 1); PG8_STAGE(PG8_SB(1, 0), b3, voffB); PG8_STAGE(PG8_SB(1, 1), b3 + hstep, voffB); PG8_STAGE(PG8_SA(1, 0), a3, voffA);
            PG8_WAIT_V(8); PG8_WAIT_L(0); PG8_BAR; PG8_MMA(1, 0, At, B0); PG8_MMA(1, 1, At, B1); PG8_BAR; PG8_SCHED;
            } else {
            PG8_LDB(B0, 0, 0); PG8_SCHED; PG8_LDA(At, 0, 0); PG8_STAGE(PG8_SA(1, 1), a1 + hstep, voffA);
            PG8_WAIT_L(8); PG8_BAR; PG8_WAIT_L(0); PG8_MMA(0, 0, At, B0); PG8_BAR; PG8_SCHED;
            PG8_LDB(B1, 0, 1); PG8_STAGE(PG8_SB(0, 0), b2, voffB);
            PG8_BAR; PG8_WAIT_L(0); PG8_MMA(0, 1, At, B1); PG8_BAR;
            PG8_LDA(At, 0, 1); PG8_STAGE(PG8_SA(0, 0), a2, voffA);
            PG8_BAR; PG8_WAIT_L(0); PG8_MMA(1, 0, At, B0); PG8_BAR; PG8_SCHED;
            PG8_STAGE(PG8_SB(0, 1), b2 + hstep, voffB);
            PG8_WAIT_V(6); PG8_BAR; PG8_MMA(1, 1, At, B1); PG8_BAR;
            PG8_LDB(B0, 1, 0); PG8_SCHED; PG8_LDA(At, 1, 0); PG8_STAGE(PG8_SA(0, 1), a2 + hstep, voffA);
            PG8_WAIT_L(8); PG8_BAR; PG8_WAIT_L(0); PG8_MMA(0, 0, At, B0); PG8_BAR; PG8_SCHED;
            PG8_LDB(B1, 1, 1); PG8_STAGE(PG8_SB(1, 0), b3, voffB);
            PG8_BAR; PG8_WAIT_L(0); PG8_MMA(0, 1, At, B1); PG8_BAR;
            PG8_LDA(At, 1, 1); PG8_STAGE(PG8_SA(1, 0), a3, voffA);
            PG8_BAR; PG8_WAIT_L(0); PG8_MMA(1, 0, At, B0); PG8_BAR; PG8_SCHED;
            PG8_STAGE(PG8_SB(1, 1), b3 + hstep, voffB);
            PG8_WAIT_V(6); PG8_BAR; PG8_MMA(1, 1, At, B1); PG8_BAR;
            }
        }
        if constexpr (ALIGN_EPI) { if (wr == 0) PG8_BAR; }
        E(acc, cur, wr, wc, 0, 0);
        if (!has_next) break;
#pragma unroll
        for (int a = 0; a < 2; ++a)
#pragma unroll
            for (int b = 0; b < 2; ++b)
#pragma unroll
                for (int m = 0; m < 4; ++m)
#pragma unroll
                    for (int n = 0; n < 2; ++n) acc[a][b][m][n] = (f32x4){0.f, 0.f, 0.f, 0.f};
        cur = nxt; cA = nA; cB = nB; ++ui;
        if constexpr (ALIGN_EPI) { if (wr == 1) PG8_BAR; }
    }
    PG8_WAIT_V(0);
    if constexpr (!ALIGN_EPI) { if (wr == 0) PG8_BAR; }
    PG8_BAR;
#undef PG8_SA
#undef PG8_SB
#undef PG8_STAGE
#undef PG8_LDA
#undef PG8_LDB
#undef PG8_MMA
#undef PG8_WAIT_V
#undef PG8_WAIT_L
#undef PG8_BAR
#undef PG8_SCHED
}

DI int mod_of_row_tile(int pm) { return pm < 16 ? 0 : 1 + ((pm - 16) >> 4); }

struct EpiGU {
    bf16_t* ACT; float osc;
    DI void operator()(const f32x4 (&acc)[2][2][4][2], const Unit& u, int wr, int wc, int fr_in, int fq_in) const {
        (void)fr_in; (void)fq_in; const int ln_ = otid() & 63; const int fr = ln_ & 15, fq = ln_ >> 4;
#pragma unroll
        for (int ai = 0; ai < 2; ++ai)
#pragma unroll
            for (int m = 0; m < 4; ++m) {
                const int row = u.pm * 256 + ai * 128 + wr * 64 + m * 16 + fr;
                float o[8];
#pragma unroll
                for (int n = 0; n < 2; ++n)
#pragma unroll
                    for (int j = 0; j < 4; ++j) { const float gg = acc[ai][0][m][n][j] * osc, uu = acc[ai][1][m][n][j] * osc;
                        const float sg = gg * __builtin_amdgcn_rcpf(1.f + __builtin_amdgcn_exp2f(-1.44269504089f * gg)); o[n * 4 + j] = sg * uu; }
                u32x2 w; w.x = pk4f8(o[0] * ACT8_SCALE, o[1] * ACT8_SCALE, o[2] * ACT8_SCALE, o[3] * ACT8_SCALE); w.y = pk4f8(o[4] * ACT8_SCALE, o[5] * ACT8_SCALE, o[6] * ACT8_SCALE, o[7] * ACT8_SCALE);
                *(u32x2*)((unsigned char*)ACT + (size_t)row * FF + u.pn * 128 + wc * 32 + fq * 8) = w;
            }
    }
};

struct EpiRes {
    const float* srcP; const float* srcS; float* X; const float* gate; float coef;
    DI void operator()(const f32x4 (&acc)[2][2][4][2], const Unit& u, int wr, int wc, int fr_in, int fq_in) const {
        (void)fr_in; (void)fq_in; const int ln_ = otid() & 63; const int fr = ln_ & 15, fq = ln_ >> 4;
        const float* gt = gate + mod_of_row_tile(u.pm) * 9216;
        f32x4 gv[2][2];
#pragma unroll
        for (int bj = 0; bj < 2; ++bj)
#pragma unroll
            for (int n = 0; n < 2; ++n) gv[bj][n] = *(const f32x4*)(gt + u.pn * 256 + bj * 128 + wc * 32 + fq * 8 + n * 4) * coef;
#pragma unroll
        for (int ai = 0; ai < 2; ++ai)
#pragma unroll
            for (int m = 0; m < 4; ++m) {
                const int row = u.pm * 256 + ai * 128 + wr * 64 + m * 16 + fr;
                const float* sp = (row < TP) ? srcP + (size_t)row * D : srcS + (size_t)(row - TP) * D;
#pragma unroll
                for (int bj = 0; bj < 2; ++bj)
#pragma unroll
                    for (int n = 0; n < 2; ++n) { const int c = u.pn * 256 + bj * 128 + wc * 32 + fq * 8 + n * 4;
                        const f32x4 xv = *(const f32x4*)(sp + c);
                        *(f32x4*)(X + (size_t)row * D + c) = xv * ALPHA + gv[bj][n] * acc[ai][bj][m][n]; }
            }
    }
};

struct EpiFour {
    bf16_t* MIX; int mode;
    DI void operator()(const f32x4 (&acc)[2][2][4][2], const Unit& u, int wr, int wc, int fr_in, int fq_in) const {
        (void)fr_in; (void)fq_in; const int ln_ = otid() & 63; const int fr = ln_ & 15, fq = ln_ >> 4;
        const int tok0 = ((mode == 0) ? TP + u.pn * 4096 + u.pm * 256 : u.pn * 256) + wr * 64 + fr;
        bf16_t* p0 = MIX + (size_t)tok0 * D + 768 + wc * 32 + fq * 8;
#pragma unroll
        for (int ai = 0; ai < 2; ++ai)
#pragma unroll
            for (int m = 0; m < 4; ++m) {
                bf16_t* p = p0 + (size_t)(ai * 128 + m * 16) * D;
#pragma unroll
                for (int bj = 0; bj < 2; ++bj) {
                    u32x4 w; w.x = pk2(acc[ai][bj][m][0][0], acc[ai][bj][m][0][1]); w.y = pk2(acc[ai][bj][m][0][2], acc[ai][bj][m][0][3]);
                    w.z = pk2(acc[ai][bj][m][1][0], acc[ai][bj][m][1][1]); w.w = pk2(acc[ai][bj][m][1][2], acc[ai][bj][m][1][3]);
                    *(u32x4*)(p + bj * 128) = w;
                }
            }
    }
};

struct EpiIn {
    int l; const float* g_qa; const float* g_ka; float* out; unsigned char* ws;
    DI void operator()(const f32x4 (&acc)[2][2][4][2], const Unit& u, int wr, int wc, int fr_in, int fq_in) const {
        (void)fr_in; (void)fq_in; const int ln_ = otid() & 63; const int fr = ln_ & 15, fq = ln_ >> 4;
        const int t = u.pn; const bool prompt = u.pm < 16;
        const float* rope = (const float*)(ws + WS_ROPE);
        bf16_t* const QA = (bf16_t*)(ws + WS_QA); bf16_t* const QB = (bf16_t*)(ws + WS_QB); bf16_t* const KAS = (bf16_t*)(ws + WS_KAS); bf16_t* const VAS = (bf16_t*)(ws + WS_VAS);
        bf16_t* const KBS = (bf16_t*)(ws + WS_KBS); bf16_t* const VBS = (bf16_t*)(ws + WS_VBS); bf16_t* const KAP = (bf16_t*)(ws + WS_KAP); bf16_t* const VAP = (bf16_t*)(ws + WS_VAP);
        bf16_t* const KBP = (bf16_t*)(ws + WS_KBP); bf16_t* const VBP = (bf16_t*)(ws + WS_VBP); bf16_t* const UTP = (bf16_t*)(ws + WS_UTP); bf16_t* const UTS = (bf16_t*)(ws + WS_UTS);
        if (t >= 8) {
            const int cs = t - 8;
#pragma unroll
            for (int ai = 0; ai < 2; ++ai)
#pragma unroll
                for (int m = 0; m < 4; ++m) {
                    const int row = u.pm * 256 + ai * 128 + wr * 64 + m * 16 + fr;
                    bf16_t* base; size_t pitch;
                    if (prompt) { base = UTP + (size_t)(row >> 8) * 256 * 512 + cs * 256 + (row & 255); pitch = 512; }
                    else { const int rs = row - TP; base = UTS + (size_t)(rs >> 12) * 256 * 8192 + cs * 4096 + (rs & 4095); pitch = 8192; }
#pragma unroll
                    for (int bj = 0; bj < 2; ++bj)
#pragma unroll
                        for (int n = 0; n < 2; ++n)
#pragma unroll
                            for (int j = 0; j < 4; ++j) base[(size_t)(bj * 128 + wc * 32 + fq * 8 + n * 4 + j) * pitch] = f2bf(acc[ai][bj][m][n][j]);
                    __builtin_amdgcn_sched_barrier(0);
                }
            return;
        }
        const bool do_norm = (t == 0) || (t == 1 && wc < 2);
        const bool is_v = (t == 1 && wc >= 2) || t >= 6;
        const bool is_q = (t == 0) || t == 2 || t == 3;
        const bool do_rope = !prompt && !is_v;
        const float* gp = (t == 0 ? g_qa : g_ka) + l * 64 + fq * 8;
#pragma unroll
        for (int ai = 0; ai < 2; ++ai)
#pragma unroll
            for (int m = 0; m < 4; ++m) {
                const int row = u.pm * 256 + ai * 128 + wr * 64 + m * 16 + fr;
                int b, pos;
                if (prompt) { b = row >> 8; pos = row & 255; } else { const int rs = row - TP; b = rs >> 12; pos = rs & 4095; }
                float v[2][8];
#pragma unroll
                for (int bj = 0; bj < 2; ++bj)
#pragma unroll
                    for (int n = 0; n < 2; ++n)
#pragma unroll
                        for (int j = 0; j < 4; ++j) v[bj][n * 4 + j] = acc[ai][bj][m][n][j];
                if (do_norm) {
                    float ss = 0.f;
#pragma unroll
                    for (int bj = 0; bj < 2; ++bj)
#pragma unroll
                        for (int e = 0; e < 8; ++e) ss += v[bj][e] * v[bj][e];
                    ss += shx<16>(ss); ss += shx32(ss);
                    const float rs_ = rsqrtf(ss * (1.f / 64.f) + 1e-6f);
#pragma unroll
                    for (int bj = 0; bj < 2; ++bj)
#pragma unroll
                        for (int e = 0; e < 8; ++e) v[bj][e] = v[bj][e] * rs_ * gp[bj * 32 + e];
                }
                if (prompt && !is_q) {
                    float* op;
                    if (t == 1) op = out + (wc < 2 ? 12582912 : 13631488) + ((size_t)((b * 2 + l) * 256 + pos)) * 128 + (wc & 1) * 64;
                    else if (t < 6) op = out + 14680064 + ((size_t)((b * 2 + l) * 256 + pos)) * 512 + ((t - 4) * 4 + wc) * 64;
                    else op = out + 18874368 + ((size_t)((b * 2 + l) * 256 + pos)) * 512 + (t - 6) * 256 + wc * 64;
#pragma unroll
                    for (int bj = 0; bj < 2; ++bj) {
                        *(f32x4*)(op + bj * 32 + fq * 8) = (f32x4){v[bj][0], v[bj][1], v[bj][2], v[bj][3]};
                        *(f32x4*)(op + bj * 32 + fq * 8 + 4) = (f32x4){v[bj][4], v[bj][5], v[bj][6], v[bj][7]};
                    }
                }
                if (do_rope) {
#pragma unroll
                    for (int bj = 0; bj < 2; ++bj) {
                        const int pv_ = bj == 0 ? (pos >> 6) : (pos & 63);
                        const float* rp = rope + (pv_ * 16 + (fq & 1) * 8) * 2;
#pragma unroll
                        for (int e = 0; e < 8; ++e) {
                            const float cc = rp[2 * e], sn = rp[2 * e + 1];
                            const float other = shx32(v[bj][e]);
                            v[bj][e] = v[bj][e] * cc + (fq < 2 ? -other : other) * sn;
                        }
                    }
                }
                if (is_v) {
                    bf16_t* base; size_t pitch;
                    if (t == 1) { const int kvh = wc - 2; if (prompt) { base = VAP + (size_t)(b * 2 + kvh) * 64 * 256 + pos; pitch = 256; } else { base = VAS + (size_t)(b * 2 + kvh) * 64 * LKS + 256 + pos; pitch = LKS; } }
                    else { const int hh = (t - 6) * 2 + (wc >> 1); const int d0 = (wc & 1) * 64;
                        if (prompt) { base = VBP + ((size_t)(b * 4 + hh) * 128 + d0) * 256 + pos; pitch = 256; } else { base = VBS + ((size_t)(b * 4 + hh) * 128 + d0) * LKS + 256 + pos; pitch = LKS; } }
#pragma unroll
                    for (int bj = 0; bj < 2; ++bj)
#pragma unroll
                        for (int e = 0; e < 8; ++e) base[(size_t)(bj * 32 + fq * 8 + e) * pitch] = f2bf(v[bj][e]);
                } else {
                    bf16_t* op;
                    if (t == 0) op = QA + (size_t)row * 256 + wc * 64;
                    else if (t == 1) op = prompt ? KAP + ((size_t)(b * 2 + wc) * 256 + pos) * 64 : KAS + ((size_t)(b * 2 + wc) * LKS + 256 + pos) * 64;
                    else if (t < 4) op = QB + (size_t)row * 512 + ((t - 2) * 4 + wc) * 64;
                    else { const int s = (t - 4) * 4 + wc; op = prompt ? KBP + ((size_t)(b * 8 + s) * 256 + pos) * 64 : KBS + ((size_t)(b * 8 + s) * LKS + 256 + pos) * 64; }
                    const float sc = is_q ? QSCALE : 1.f;
#pragma unroll
                    for (int bj = 0; bj < 2; ++bj) {
                        u32x4 w; w.x = pk2(v[bj][0] * sc, v[bj][1] * sc); w.y = pk2(v[bj][2] * sc, v[bj][3] * sc); w.z = pk2(v[bj][4] * sc, v[bj][5] * sc); w.w = pk2(v[bj][6] * sc, v[bj][7] * sc);
                        *(u32x4*)(op + bj * 32 + fq * 8) = w;
                    }
                }
                __builtin_amdgcn_sched_barrier(0);
            }
    }
};
}

template <int DV>
DI void attn_unit(const bf16_t* __restrict__ Q, int qpitch, const bf16_t* __restrict__ K, const bf16_t* __restrict__ VT, int Lk, bf16_t* __restrict__ O, int opitch, LAS unsigned char* lds) {
    constexpr int KROW = 144, VROW = 136, KBYTES = 64 * KROW, VBYTES = DV * VROW, BUF = KBYTES + VBYTES, NV = DV / 64, NDB = DV / 32;
    int tid = threadIdx.x; asm volatile("" : "+v"(tid));
    const int wave = tid >> 6, lane = tid & 63, r = lane & 31, h = lane >> 5;
    bf16x8 qf[4];
    { const bf16_t* qrow = Q + (size_t)(wave * 32 + r) * qpitch;
#pragma unroll
      for (int s = 0; s < 4; ++s) qf[s] = *(const bf16x8*)(qrow + 16 * s + 8 * h); }
    f32x16 o[NDB];
#pragma unroll
    for (int db = 0; db < NDB; ++db)
#pragma unroll
        for (int i = 0; i < 16; ++i) o[db][i] = 0.f;
    float mrun = 0.f, lrun = 0.f;
    const int skey = tid >> 3, sch = tid & 7;
    const bf16_t* kg = K + (size_t)skey * 64 + sch * 8;
    const bf16_t* vg = VT + (size_t)skey * Lk + sch * 8;
    const unsigned kwoff = skey * KROW + sch * 16, vwoff = KBYTES + skey * VROW + sch * 16;
    u32x4 kreg, vreg[NV];
    kreg = *(const u32x4*)kg;
#pragma unroll
    for (int i = 0; i < NV; ++i) vreg[i] = *(const u32x4*)(vg + (size_t)(64 * i) * Lk);
    *(LAS u32x4*)(lds + kwoff) = kreg;
#pragma unroll
    for (int i = 0; i < NV; ++i) { *(LAS u32x2*)(lds + vwoff + i * 64 * VROW) = (u32x2){vreg[i].x, vreg[i].y}; *(LAS u32x2*)(lds + vwoff + i * 64 * VROW + 8) = (u32x2){vreg[i].z, vreg[i].w}; }
    __syncthreads();
    const int nt = Lk >> 6;
    for (int kt = 0; kt < nt; ++kt) {
        LAS unsigned char* cb = lds + (kt & 1) * BUF;
        LAS unsigned char* nb = lds + ((kt & 1) ^ 1) * BUF;
        const bool more = kt + 1 < nt;
        if (more) {
            kreg = *(const u32x4*)(kg + (size_t)(kt + 1) * 64 * 64);
#pragma unroll
            for (int i = 0; i < NV; ++i) vreg[i] = *(const u32x4*)(vg + (size_t)(64 * i) * Lk + (kt + 1) * 64);
        }
        f32x16 s0, s1;
        { const float nm = -mrun;
#pragma unroll
          for (int i = 0; i < 16; ++i) { s0[i] = nm; s1[i] = nm; } }
#pragma unroll
        for (int s = 0; s < 4; ++s) {
            const bf16x8 k0 = *(const LAS bf16x8*)(cb + r * KROW + (16 * s + 8 * h) * 2);
            const bf16x8 k1 = *(const LAS bf16x8*)(cb + (32 + r) * KROW + (16 * s + 8 * h) * 2);
            s0 = __builtin_amdgcn_mfma_f32_32x32x16_bf16(k0, qf[s], s0, 0, 0, 0);
            s1 = __builtin_amdgcn_mfma_f32_32x32x16_bf16(k1, qf[s], s1, 0, 0, 0);
        }
        float mxa[8];
#pragma unroll
        for (int i = 0; i < 8; ++i) mxa[i] = fmaxf(fmaxf(s0[2 * i], s0[2 * i + 1]), fmaxf(s1[2 * i], s1[2 * i + 1]));
        float mx = fmaxf(fmaxf(fmaxf(mxa[0], mxa[1]), fmaxf(mxa[2], mxa[3])), fmaxf(fmaxf(mxa[4], mxa[5]), fmaxf(mxa[6], mxa[7])));
        mx = fmaxf(mx, shx32(mx));
        if (__builtin_amdgcn_ballot_w64(mx > 8.f) != 0ull) {
            const float dlt = fmaxf(mx, 0.f);
            const float alpha = __builtin_amdgcn_exp2f(-dlt);
            mrun += dlt; lrun *= alpha;
#pragma unroll
            for (int db = 0; db < NDB; ++db)
#pragma unroll
                for (int i = 0; i < 16; ++i) o[db][i] *= alpha;
#pragma unroll
            for (int i = 0; i < 16; ++i) { s0[i] -= dlt; s1[i] -= dlt; }
        }
        f32x2_t rs2 = {0.f, 0.f};
#pragma unroll
        for (int i = 0; i < 16; ++i) { s0[i] = __builtin_amdgcn_exp2f(s0[i]); s1[i] = __builtin_amdgcn_exp2f(s1[i]); }
#pragma unroll
        for (int i = 0; i < 8; ++i) { rs2 += (f32x2_t){s0[2 * i], s0[2 * i + 1]}; rs2 += (f32x2_t){s1[2 * i], s1[2 * i + 1]}; }
        lrun += rs2.x + rs2.y;
#pragma unroll
        for (int kb = 0; kb < 2; ++kb)
#pragma unroll
            for (int s2 = 0; s2 < 2; ++s2) {
                u32x4 pw;
                if (kb == 0) { pw.x = pk2(s0[8 * s2 + 0], s0[8 * s2 + 1]); pw.y = pk2(s0[8 * s2 + 2], s0[8 * s2 + 3]); pw.z = pk2(s0[8 * s2 + 4], s0[8 * s2 + 5]); pw.w = pk2(s0[8 * s2 + 6], s0[8 * s2 + 7]); }
                else { pw.x = pk2(s1[8 * s2 + 0], s1[8 * s2 + 1]); pw.y = pk2(s1[8 * s2 + 2], s1[8 * s2 + 3]); pw.z = pk2(s1[8 * s2 + 4], s1[8 * s2 + 5]); pw.w = pk2(s1[8 * s2 + 6], s1[8 * s2 + 7]); }
                const bf16x8 pf = __builtin_bit_cast(bf16x8, pw);
#pragma unroll
                for (int db = 0; db < NDB; ++db) {
                    const LAS unsigned char* vp = cb + KBYTES + (32 * db + r) * VROW + (32 * kb + 16 * s2 + 4 * h) * 2;
                    const u32x2 lo = *(const LAS u32x2*)vp, hi = *(const LAS u32x2*)(vp + 16);
                    const u32x4 vw = {lo.x, lo.y, hi.x, hi.y};
                    o[db] = __builtin_amdgcn_mfma_f32_32x32x16_bf16(__builtin_bit_cast(bf16x8, vw), pf, o[db], 0, 0, 0);
                }
                    }
        if (more) {
            *(LAS u32x4*)(nb + kwoff) = kreg;
#pragma unroll
            for (int i = 0; i < NV; ++i) { *(LAS u32x2*)(nb + vwoff + i * 64 * VROW) = (u32x2){vreg[i].x, vreg[i].y}; *(LAS u32x2*)(nb + vwoff + i * 64 * VROW + 8) = (u32x2){vreg[i].z, vreg[i].w}; }
        }
        __syncthreads();
    }
    lrun += shx32(lrun);
    const float inv = 1.f / lrun;
    bf16_t* orow = O + (size_t)(wave * 32 + r) * opitch;
#pragma unroll
    for (int db = 0; db < NDB; ++db)
#pragma unroll
        for (int g = 0; g < 4; ++g) {
            u32x2 w; w.x = pk2(o[db][4 * g] * inv, o[db][4 * g + 1] * inv); w.y = pk2(o[db][4 * g + 2] * inv, o[db][4 * g + 3] * inv);
            *(u32x2*)(orow + 32 * db + 8 * g + 4 * h) = w;
        }
}

template <int MODE> DI int srccol(int np) {
    if (MODE == 1) { const int pn = np >> 8, j = np & 255; return j < 128 ? 128 * pn + j : FF + 128 * pn + (j - 128); }
    if (MODE == 2) { const int t = np >> 8, p = np & 255; return 256 * t + 64 * ((p >> 5) & 3) + 32 * (p >> 7) + (p & 31); }
    return np;
}
DI void tr_item(const float* __restrict__ src, int Nsrc, int mode, int n0, int k0, bf16_t* __restrict__ dst, int ldd, LAS float* tile, int tid, bool f8, float f8s) {
    const int nn = tid & 63, kq = tid >> 6;
    int sc0, sc1;
    if (mode == 1) { sc0 = srccol<1>(n0 + nn); sc1 = srccol<1>(n0 + nn + 64); } else if (mode == 2) { sc0 = srccol<2>(n0 + nn); sc1 = srccol<2>(n0 + nn + 64); } else { sc0 = n0 + nn; sc1 = n0 + nn + 64; }
    float v0[8], v1[8];
#pragma unroll
    for (int i = 0; i < 8; ++i) { const float* rp = src + (size_t)(k0 + kq + 8 * i) * Nsrc; v0[i] = rp[sc0]; v1[i] = rp[sc1]; }
#pragma unroll
    for (int i = 0; i < 8; ++i) { tile[(kq + 8 * i) * 129 + nn] = v0[i]; tile[(kq + 8 * i) * 129 + nn + 64] = v1[i]; }
    __syncthreads();
    const int n2 = tid >> 3, kc = tid & 7;
#pragma unroll
    for (int hh = 0; hh < 2; ++hh) {
        const int nr = n2 + 64 * hh;
        float t8[8];
#pragma unroll
        for (int e = 0; e < 8; ++e) t8[e] = tile[(8 * kc + e) * 129 + nr];
        if (f8) {
            u32x2 w; w.x = pk4f8(t8[0] * f8s, t8[1] * f8s, t8[2] * f8s, t8[3] * f8s); w.y = pk4f8(t8[4] * f8s, t8[5] * f8s, t8[6] * f8s, t8[7] * f8s);
            *(u32x2*)((unsigned char*)dst + (size_t)(n0 + nr) * ldd + k0 + 8 * kc) = w;
        } else {
            u32x4 w; w.x = pk2(t8[0], t8[1]); w.y = pk2(t8[2], t8[3]); w.z = pk2(t8[4], t8[5]); w.w = pk2(t8[6], t8[7]);
            *(u32x4*)(dst + (size_t)(n0 + nr) * ldd + k0 + 8 * kc) = w;
        }
    }
    __syncthreads();
}

DI void convert_layer(KP a, int l, LAS unsigned char* lds) {
    unsigned char* ws = a->ws; const int tid = otid(), G = gridDim.x;
    LAS float* tile = (LAS float*)(lds + 32768);
    LAS float* t64 = (LAS float*)(lds + 98304);
    __syncthreads();
    if (tid < 64) t64[tid] = cospif((float)tid * (1.f / 32.f));
    __syncthreads();
    for (int it = blockIdx.x; it < 2464; it += G) {
        const float* src; bf16_t* dst; int Nsrc, nkt, ldd, mode, j; bool f8 = true;
        if (it < 704) { j = it; src = a->in[20] + (size_t)l * D * 2 * FF; Nsrc = 2 * FF; nkt = 16; dst = (bf16_t*)(ws + WS_WGU1); ldd = D; mode = 1; }
        else if (it < 1056) { j = it - 704; src = a->in[21] + (size_t)l * FF * D; Nsrc = D; nkt = 44; dst = (bf16_t*)(ws + WS_WD1); ldd = FF; mode = 0; }
        else if (it < 1312) { j = it - 1056; src = a->in[10] + (size_t)l * D * 2304; Nsrc = 2304; nkt = 16; dst = (bf16_t*)(ws + WS_WIN); ldd = D; mode = 2; f8 = false; }
        else if (it < 1408) { j = it - 1312; src = a->in[19] + (size_t)l * D * D; Nsrc = D; nkt = 12; dst = (bf16_t*)(ws + WS_WOUT); ldd = D; mode = 0; f8 = false; }
        else if (it < 2112) { j = it - 1408; src = a->in[22] + (size_t)l * D * 2 * FF; Nsrc = 2 * FF; nkt = 16; dst = (bf16_t*)(ws + WS_WGU2); ldd = D; mode = 1; }
        else { j = it - 2112; src = a->in[23] + (size_t)l * FF * D; Nsrc = D; nkt = 44; dst = (bf16_t*)(ws + WS_WD2); ldd = FF; mode = 0; }
        tr_item(src, Nsrc, mode, (j / nkt) * 128, (j % nkt) * 64, dst, ldd, tile, tid, f8, f8 ? (mode == 1 ? WGU8_SCALE : WD8_SCALE) : 1.f);
    }
    { bf16_t* WinT = (bf16_t*)(ws + WS_WIN); LAS float* wt = tile;
      for (int it = blockIdx.x; it < 128; it += G) {
          const int cs = it & 1, kb = (it >> 1) & 15, g = it >> 5;
#pragma unroll
          for (int e = 0; e < 8; ++e) { const int idx = tid + 512 * e, kd = idx >> 6, cc = idx & 63; wt[kd * 65 + cc] = a->in[10][((size_t)l * D + kb * 64 + kd) * 2304 + 2048 + g * 64 + cc]; }
          __syncthreads();
          const int kd = tid & 63, kq = tid >> 6;
          float acc[8];
#pragma unroll
          for (int e = 0; e < 8; ++e) acc[e] = 0.f;
          for (int cc = 0; cc < 64; ++cc) {
              const float x = wt[kd * 65 + cc];
#pragma unroll
              for (int e = 0; e < 8; ++e) { const int idx = ((kq * 8 + e) * cc - (cs ? 16 : 0)) & 63; acc[e] += x * t64[idx]; }
          }
#pragma unroll
          for (int e = 0; e < 8; ++e) WinT[(size_t)(2048 + cs * 256 + g * 64 + kq * 8 + e) * D + kb * 64 + kd] = f2bf(acc[e]);
          __syncthreads();
      } }
    { bf16_t* WoutT = (bf16_t*)(ws + WS_WOUT); LAS float* wfs = tile; LAS float* red = (LAS float*)lds;
      for (int it = blockIdx.x; it < 256; it += G) {
          const int ib = it >> 4, nb = it & 15;
#pragma unroll
          for (int e = 0; e < 8; ++e) { const int idx = tid + 512 * e, i = idx >> 8, j = idx & 255; wfs[j * 17 + i] = a->in[18][((size_t)l * 256 + ib * 16 + i) * 256 + j]; }
          __syncthreads();
          const int w = tid >> 6, lane = tid & 63;
          const float* wo = a->in[19] + ((size_t)l * D + 768 + w * 32) * D + nb * 64 + lane;
          float acc[16];
#pragma unroll
          for (int i = 0; i < 16; ++i) acc[i] = 0.f;
#pragma unroll 8
          for (int jj = 0; jj < 32; ++jj) { const float x = wo[(size_t)jj * D];
#pragma unroll
              for (int i = 0; i < 16; ++i) acc[i] += x * wfs[(w * 32 + jj) * 17 + i]; }
#pragma unroll
          for (int i = 0; i < 16; ++i) red[(w * 16 + i) * 64 + lane] = acc[i];
          __syncthreads();
#pragma unroll
          for (int hh = 0; hh < 2; ++hh) { const int i = (tid >> 6) + 8 * hh; float sacc = 0.f;
#pragma unroll
              for (int q = 0; q < 8; ++q) sacc += red[(q * 16 + i) * 64 + lane];
              WoutT[(size_t)(nb * 64 + lane) * D + 768 + ib * 16 + i] = f2bf(sacc); }
          __syncthreads();
      } }
    { bf16_t* KAS = (bf16_t*)(ws + WS_KAS); bf16_t* VAS = (bf16_t*)(ws + WS_VAS); bf16_t* KBS = (bf16_t*)(ws + WS_KBS); bf16_t* VBS = (bf16_t*)(ws + WS_VBS);
      for (int i = blockIdx.x * 512 + tid; i < 2 * 256 * 1280; i += G * 512) {
          const int e = i % 1280, bp = i / 1280, b = bp >> 8, pos = bp & 255;
          const size_t cbase = (size_t)((b * 2 + l) * 256 + pos);
          if (e < 128) { const int kvh = e >> 6, d = e & 63; KAS[((size_t)(b * 2 + kvh) * LKS + pos) * 64 + d] = f2bf(a->in[2][cbase * 128 + e]); }
          else if (e < 256) { const int e2 = e - 128, kvh = e2 >> 6, d = e2 & 63; VAS[((size_t)(b * 2 + kvh) * 64 + d) * LKS + pos] = f2bf(a->in[3][cbase * 128 + e2]); }
          else if (e < 768) { const int e2 = e - 256, s = e2 >> 6, d = e2 & 63; KBS[((size_t)(b * 8 + s) * LKS + pos) * 64 + d] = f2bf(a->in[4][cbase * 512 + e2]); }
          else { const int e2 = e - 768, hh = e2 >> 7, d = e2 & 127; VBS[((size_t)(b * 4 + hh) * 128 + d) * LKS + pos] = f2bf(a->in[5][cbase * 512 + e2]); }
      } }
    __syncthreads();
}

DI void p0_prologue(KP a, LAS unsigned char* lds) {
    unsigned char* ws = a->ws; const int tid = otid(), G = gridDim.x;
    { LAS float* sv = (LAS float*)lds; LAS float* red = (LAS float*)(lds + 16384);
      for (int i = tid; i < 3072; i += 512) { const int m = i >> 10, k = i & 1023; const float cv = (m == 0) ? a->in[7][k] : a->in[6][(m - 1) * D + k]; sv[i] = cv / (1.f + __expf(-cv)); }
      __syncthreads();
      float* MOD = (float*)(ws + WS_MOD);
      for (int it = blockIdx.x; it < 256; it += G) {
          const int col0 = it * 72, l = col0 / 9216, c0 = col0 % 9216, kg = tid / 72, cc = tid % 72;
          float a0 = 0.f, a1 = 0.f, a2 = 0.f;
          if (kg < 7) { const float* w = a->in[8] + (size_t)l * D * 9216 + c0 + cc;
#pragma unroll 8
              for (int k = kg; k < D; k += 7) { const float wv = w[(size_t)k * 9216]; a0 += sv[k] * wv; a1 += sv[1024 + k] * wv; a2 += sv[2048 + k] * wv; }
              red[(kg * 3 + 0) * 72 + cc] = a0; red[(kg * 3 + 1) * 72 + cc] = a1; red[(kg * 3 + 2) * 72 + cc] = a2; }
          __syncthreads();
          if (tid < 216) { const int m = tid / 72, c2 = tid % 72; float s = 0.f;
#pragma unroll
              for (int q = 0; q < 7; ++q) s += red[(q * 3 + m) * 72 + c2];
              MOD[(size_t)(l * 3 + m) * 9216 + c0 + c2] = s + a->in[9][l * 9216 + c0 + c2]; }
          __syncthreads();
      } }
    if (blockIdx.x == G - 1) {
        float* ROPE = (float*)(ws + WS_ROPE);
        for (int i = tid; i < 1024; i += 512) { const int pos = i >> 4, f = i & 15;
            const float inv = exp2f(-(float)f * (13.2877123795f / 16.f)); float rev = (float)pos * inv * 0.15915494309f; rev -= floorf(rev);
            ROPE[2 * i] = cospif(2.f * rev); ROPE[2 * i + 1] = sinpif(2.f * rev); }
    }
    { LAS float* tab = (LAS float*)lds;
      __syncthreads();
      for (int i = tid; i < 4096; i += 512) tab[i] = cospif((float)i * (1.f / 2048.f));
      __syncthreads();
      bf16_t* DS = (bf16_t*)(ws + WS_DFTS);
      for (int p = blockIdx.x; p < 4096; p += G)
          for (int ch = tid; ch < 1024; ch += 512) {
              const int k0 = ch * 8, n0 = k0 & 4095; const bool sp = k0 >= 4096; float v[8];
#pragma unroll
              for (int e = 0; e < 8; ++e) { const int idx = (p * (n0 + e)) & 4095; v[e] = (sp ? -tab[(idx - 1024) & 4095] : tab[idx]) * (1.f / 512.f); }
              u32x4 w; w.x = pk2(v[0], v[1]); w.y = pk2(v[2], v[3]); w.z = pk2(v[4], v[5]); w.w = pk2(v[6], v[7]);
              *(u32x4*)(DS + (size_t)p * 8192 + k0) = w;
          }
      bf16_t* DP = (bf16_t*)(ws + WS_DFTP);
      for (int p = blockIdx.x; p < 256; p += G)
          if (tid < 64) {
              const int k0 = tid * 8, n0 = k0 & 255; const bool sp = k0 >= 256; float v[8];
#pragma unroll
              for (int e = 0; e < 8; ++e) { const int idx = ((p * (n0 + e)) & 255) * 16; v[e] = (sp ? -tab[(idx - 1024) & 4095] : tab[idx]) * (1.f / 128.f); }
              u32x4 w; w.x = pk2(v[0], v[1]); w.y = pk2(v[2], v[3]); w.z = pk2(v[4], v[5]); w.w = pk2(v[6], v[7]);
              *(u32x4*)(DP + (size_t)p * 512 + k0) = w;
          }
      __syncthreads(); }
    convert_layer(a, 0, lds);
}

DI void p_modulate0(KP a) {
    const float* MOD = (const float*)(a->ws + WS_MOD); bf16_t* H = (bf16_t*)(a->ws + WS_H);
    for (int i = blockIdx.x * 512 + otid(); i < T * 128; i += gridDim.x * 512) {
        const int row = i >> 7, c0 = (i & 127) * 8;
        const float* sp = (row < TP) ? a->in[0] + (size_t)row * D : a->in[1] + (size_t)(row - TP) * D;
        const float* md = MOD + (size_t)(row < TP ? 0 : 1 + ((row - TP) >> 12)) * 9216;
        float v[8];
#pragma unroll
        for (int q = 0; q < 2; ++q) { const f32x4 x = *(const f32x4*)(sp + c0 + 4 * q), sh = *(const f32x4*)(md + c0 + 4 * q), sc = *(const f32x4*)(md + 1024 + c0 + 4 * q);
#pragma unroll
            for (int e = 0; e < 4; ++e) v[4 * q + e] = x[e] * (1.f + sc[e]) + sh[e]; }
        u32x2 w; w.x = pk4f8(v[0] * H8_SCALE, v[1] * H8_SCALE, v[2] * H8_SCALE, v[3] * H8_SCALE); w.y = pk4f8(v[4] * H8_SCALE, v[5] * H8_SCALE, v[6] * H8_SCALE, v[7] * H8_SCALE);
        *(u32x2*)((unsigned char*)H + (size_t)row * D + c0) = w;
    }
}

DI void p_layernorm(const float* X, float* xo, bf16_t* H, const float* g, const float* bta, const float* modn  , bool f8) {
    const int tid = otid(), wave = tid >> 6, lane = tid & 63;
    for (int row = blockIdx.x * 8 + wave; row < T; row += gridDim.x * 8) {
        f32x4 v[4];
#pragma unroll
        for (int i = 0; i < 4; ++i) v[i] = *(const f32x4*)(X + (size_t)row * D + i * 256 + lane * 4);
        float s = 0.f;
#pragma unroll
        for (int i = 0; i < 4; ++i) s += (v[i][0] + v[i][1]) + (v[i][2] + v[i][3]);
        const float mean = wave_sum(s) * (1.f / 1024.f);
        float q = 0.f;
#pragma unroll
        for (int i = 0; i < 4; ++i) { v[i] = v[i] - mean; q += (v[i][0] * v[i][0] + v[i][1] * v[i][1]) + (v[i][2] * v[i][2] + v[i][3] * v[i][3]); }
        const float rstd = rsqrtf(wave_sum(q) * (1.f / 1024.f) + 1e-5f);
        const float* md = modn ? modn + (size_t)(row < TP ? 0 : 1 + ((row - TP) >> 12)) * 9216 : nullptr;
#pragma unroll
        for (int i = 0; i < 4; ++i) {
            const int c = i * 256 + lane * 4;
            const f32x4 y = v[i] * rstd * *(const f32x4*)(g + c) + *(const f32x4*)(bta + c);
            *(f32x4*)(xo + (size_t)row * D + c) = y;
            if (md) { const f32x4 sh = *(const f32x4*)(md + c), sc = *(const f32x4*)(md + 1024 + c);
                const float h0 = y[0] * (1.f + sc[0]) + sh[0], h1 = y[1] * (1.f + sc[1]) + sh[1], h2 = y[2] * (1.f + sc[2]) + sh[2], h3 = y[3] * (1.f + sc[3]) + sh[3];
                if (f8) *(unsigned*)((unsigned char*)H + (size_t)row * D + c) = pk4f8(h0 * H8_SCALE, h1 * H8_SCALE, h2 * H8_SCALE, h3 * H8_SCALE);
                else { u32x2 w; w.x = pk2(h0, h1); w.y = pk2(h2, h3); *(u32x2*)(H + (size_t)row * D + c) = w; } }
        }
    }
}

DI void p_combine(KP a, int l) {
    const int tid = otid(), wave = tid >> 6, lane = tid & 63;
    const bf16_t* OBT = (const bf16_t*)(a->ws + WS_H); bf16_t* MIX = (bf16_t*)(a->ws + WS_MIX);
    const float lam_init = (l == 0) ? 0.2f : (0.8f - 0.6f * 0.74081822068f);
    const float d1 = wave_sum(a->in[13][l * 64 + lane] * a->in[14][l * 64 + lane]), d2 = wave_sum(a->in[15][l * 64 + lane] * a->in[16][l * 64 + lane]);
    const float lam = expf(d1) - expf(d2) + lam_init;
    const float g0 = a->in[17][l * 128 + 2 * lane] * (1.f - lam_init), g1 = a->in[17][l * 128 + 2 * lane + 1] * (1.f - lam_init);
    for (int row = blockIdx.x * 8 + wave; row < T; row += gridDim.x * 8) {
#pragma unroll
        for (int hb = 0; hb < 4; ++hb) {
            const unsigned w1 = *(const unsigned*)(OBT + (size_t)row * D + hb * 256 + 2 * lane), w2 = *(const unsigned*)(OBT + (size_t)row * D + hb * 256 + 128 + 2 * lane);
            const float x0 = __uint_as_float(w1 << 16) - lam * __uint_as_float(w2 << 16), x1 = __uint_as_float(w1 & 0xffff0000u) - lam * __uint_as_float(w2 & 0xffff0000u);
            const float rs = rsqrtf(wave_sum(x0 * x0 + x1 * x1) * (1.f / 128.f) + 1e-6f);
            *(unsigned*)(MIX + (size_t)row * D + 256 + hb * 128 + 2 * lane) = pk2(x0 * rs * g0, x1 * rs * g1);
        }
    }
}


#define XB_TMO      128
#define XB_XCNT(j)  (256  + 64 * (j))
#define XB_XSUB(j)  (1280 + 64 * (j))
#define XB_XGEN(j)  (2304 + 64 * (j))
#define XB_TOP      3328
#define XB_TOPGEN   3392
#define XCD_BAR_WORDS 3456
#define XB_SPIN_CAP (1u << 18)
DI unsigned xb_ld(unsigned* p)              { return __hip_atomic_load(p, __ATOMIC_RELAXED, __HIP_MEMORY_SCOPE_AGENT); }
DI unsigned xb_add(unsigned* p, unsigned v) { return __hip_atomic_fetch_add(p, v, __ATOMIC_RELAXED, __HIP_MEMORY_SCOPE_AGENT); }
DI unsigned xb_xcc_id() { return (unsigned)__builtin_amdgcn_s_getreg((3 << 11) | 20) & 0xFu; }
#define XB_SPIN(cond, bar) do { unsigned _sp = 0; while (cond) { __builtin_amdgcn_s_sleep(1); \
    if ((++_sp & 255u) == 0u) { if (xb_ld(&(bar)[XB_TMO])) break; if (_sp > XB_SPIN_CAP) { atomicAdd(&(bar)[XB_TMO], 1u); break; } } } } while (0)
struct XcdBarrier { unsigned* bar; unsigned x; volatile LAS unsigned* st; };
DI XcdBarrier xcd_barrier_post(unsigned* bar, volatile LAS unsigned* st) {
    XcdBarrier b; b.bar = bar; b.x = xb_xcc_id(); b.st = st;
    if (threadIdx.x == 0) (void)xb_add(&bar[XB_XCNT(b.x)], 1u);
    return b;
}
DI void xcd_barrier_complete(unsigned* bar, unsigned x, unsigned& nloc, unsigned& nx) {
    const unsigned G = gridDim.x * gridDim.y * gridDim.z;
    unsigned sum, cnt, mine, sp = 0u;
    for (;;) {
        sum = 0u; cnt = 0u; mine = 0u;
#pragma unroll
        for (unsigned j = 0; j < 16; ++j) { const unsigned c = xb_ld(&bar[XB_XCNT(j)]); sum += c; cnt += (c > 0u) ? 1u : 0u; mine = (j == x) ? c : mine; }
        if (sum == G) break;
        __builtin_amdgcn_s_sleep(1);
        if ((++sp & 255u) == 0u) { if (xb_ld(&bar[XB_TMO])) break; if (sp > XB_SPIN_CAP) { atomicAdd(&bar[XB_TMO], 1u); break; } }
    }
    nloc = mine > 0u ? mine : 1u; nx = cnt > 0u ? cnt : 1u;
}
DI void xcd_barrier(const XcdBarrier& b) {
    asm volatile("s_waitcnt vmcnt(0)" ::: "memory");
    __syncthreads();
    if (threadIdx.x == 0) {
        unsigned* bar = b.bar;
        __builtin_amdgcn_s_waitcnt(0);
        unsigned nloc = b.st[0], nx = b.st[1];
        if (nloc == 0u) { xcd_barrier_complete(bar, b.x, nloc, nx); b.st[0] = nloc; b.st[1] = nx; }
        const unsigned old = xb_add(&bar[XB_XSUB(b.x)], 1u);
        const unsigned gen = old / nloc;
        if (old + 1u == (gen + 1u) * nloc) {
            __builtin_amdgcn_fence(__ATOMIC_RELEASE, "agent");
            asm volatile("s_waitcnt vmcnt(0)" ::: "memory");
            const unsigned og = xb_add(&bar[XB_TOP], 1u);
            const unsigned tg = og / nx;
            if (og + 1u == (tg + 1u) * nx) xb_add(&bar[XB_TOPGEN], 1u);
            else XB_SPIN(xb_ld(&bar[XB_TOPGEN]) == tg, bar);
            __builtin_amdgcn_fence(__ATOMIC_ACQUIRE, "agent");
            xb_add(&bar[XB_XGEN(b.x)], 1u);
            asm volatile("s_waitcnt vmcnt(0)" ::: "memory");
        } else {
            XB_SPIN(xb_ld(&bar[XB_XGEN(b.x)]) == gen, bar);
            __builtin_amdgcn_fence(__ATOMIC_ACQUIRE, "agent");
            asm volatile("s_waitcnt vmcnt(0)" ::: "memory");
        }
    }
    __syncthreads();
}

#ifndef PROBE_MASK
#define PROBE_MASK 0
#endif
constexpr int N_PHASES = 24;
#define PHM(i) ((MASK >> (i)) & 1)
template <int MASK> __global__ void __launch_bounds__(512) trunk_fwd(KArgs a_unused) {
    extern __shared__ __attribute__((aligned(16))) unsigned char lds_raw[];
    LAS unsigned char* lds = (LAS unsigned char*)lds_raw;
    cg::grid_group grid = cg::this_grid();
    const KP a0 = (KP)__builtin_amdgcn_kernarg_segment_ptr();
    unsigned char* ws = a0->ws;
    const int G = gridDim.x, c = blockIdx.x;
    float* X = (float*)(ws + WS_X); bf16_t* H = (bf16_t*)(ws + WS_H); bf16_t* ACT = (bf16_t*)(ws + WS_ACT); bf16_t* MIX = (bf16_t*)(ws + WS_MIX);
    const float* MOD = (const float*)(ws + WS_MOD);
    volatile LAS unsigned* misc = (volatile LAS unsigned*)(lds + MISC_OFF);
    if (threadIdx.x < 16) misc[threadIdx.x] = 0u;
    __syncthreads();
    XcdBarrier xbar = xcd_barrier_post((unsigned*)(ws + WS_CTL) + 64, misc + 8);
    const int ph_lo = a0->ph_lo, ph_hi = a0->ph_hi;
    int redo = 0;
    for (int ph = ph_lo; ph < ph_hi; ++ph) {
        const int tid = otid();
        KP a = a0; asm volatile("" : "+s"(a));
        int kbit; if (ph < 2) kbit = ph; else { const int k_ = (ph - 2) % 11; kbit = (k_ == 0 || k_ == 8) ? 2 : (k_ == 1 || k_ == 9 || k_ == 6) ? 3 : (k_ == 2 || k_ == 7 || k_ == 10) ? 4 : (k_ == 3) ? 5 : (k_ == 4) ? 7 : 8; }
        const int rep = redo;
        {
        if (ph == 0) { if (PHM(0)) p0_prologue(a, lds); }
        else if (ph == 1) { if (PHM(1)) p_modulate0(a); }
        else {
            const int l = (ph - 2) / 11, k = (ph - 2) % 11;
            const float* modl = MOD + (size_t)l * 3 * 9216;
            if (k == 0 || k == 8) { if (PHM(2)) {
                pg8::Gemm g{H, (const bf16_t*)(ws + (k == 0 ? WS_WGU1 : WS_WGU2)), D / 2, D / 2}; pg8::StaticOrder S; S.init(T, 2 * FF, G, c);
                pg8::EpiGU E{ACT, 1.f / (H8_SCALE * WGU8_SCALE)};
                pg8::gemm_phase<pg8::EpiGU, pg8::StaticOrder, true, true, true>(lds, g, S, E); }
            } else if (k == 1 || k == 9 || k == 6) { if (PHM(3)) {
                pg8::StaticOrder S; S.init(T, D, G, c);
                if (k == 6) { pg8::Gemm g{MIX, (const bf16_t*)(ws + WS_WOUT), D, D}; pg8::EpiRes E{X, X + (size_t)TP * D, X, modl + 5 * 1024, 1.0f};
                    pg8::gemm_phase<pg8::EpiRes, pg8::StaticOrder, true, true, false>(lds, g, S, E); }
                else { pg8::Gemm g{ACT, (const bf16_t*)(ws + (k == 1 ? WS_WD1 : WS_WD2)), FF / 2, FF / 2};
                    const bool first = (l == 0 && k == 1);
                    pg8::EpiRes E{first ? a->in[0] : X, first ? a->in[1] : X + (size_t)TP * D, X, modl + (k == 1 ? 2 : 8) * 1024, 0.5f / (ACT8_SCALE * WD8_SCALE)};
                    pg8::gemm_phase<pg8::EpiRes, pg8::StaticOrder, true, true, true>(lds, g, S, E); }
                }
            } else if (k == 2 || k == 7 || k == 10) { if (PHM(4)) {
                const int which = (k == 2) ? 0 : (k == 7 ? 1 : 2);
                const float* lg = a->in[24] + (size_t)(l * 3 + which) * D; const float* lb = a->in[25] + (size_t)(l * 3 + which) * D;
                const bool final_ = (l == 1 && k == 10);
                const float* modn = (k == 2) ? modl + 3 * 1024 : (k == 7) ? modl + 6 * 1024 : (final_ ? nullptr : MOD + (size_t)(l + 1) * 3 * 9216);
                p_layernorm(X, final_ ? a->out : X, H, lg, lb, modn, which != 0);
                if (k == 10 && l == 0) convert_layer(a, 1, lds); }
            } else if (k == 3) { if (PHM(5)) {
                pg8::Gemm g{H, (const bf16_t*)(ws + WS_WIN), D, D}; pg8::StaticOrder S; S.init(T, NIN, G, c);
                pg8::EpiIn E{l, a->in[11], a->in[12], a->out, ws};
                pg8::gemm_phase<pg8::EpiIn, pg8::StaticOrder, true, true>(lds, g, S, E); }
            } else if (k == 4) {
                if (PHM(6) && (rep == 0 || ((PROBE_MASK >> 6) & 1))) {
#pragma clang loop unroll(disable)
                    for (int pass = 0; pass < 2; ++pass) {
                        const bool sp = pass == 0;
                        pg8::Gemm g{(const bf16_t*)(ws + (sp ? WS_DFTS : WS_DFTP)), (const bf16_t*)(ws + (sp ? WS_UTS : WS_UTP)), sp ? 8192 : 512, sp ? 8192 : 512};
                        pg8::FourOrder S{G, c, sp ? 32 : 16, pass}; pg8::EpiFour E{MIX, pass};
                        pg8::gemm_phase<pg8::EpiFour, pg8::FourOrder, true, true>(lds, g, S, E);
                    }
                }
                volatile LAS int* qslot = (volatile LAS int*)(lds + MISC_OFF);
                unsigned* ctr = (unsigned*)(ws + WS_CTL) + l + 2 * rep;
                const bf16_t* QA = (const bf16_t*)(ws + WS_QA); const bf16_t* QB = (const bf16_t*)(ws + WS_QB);
                bf16_t* OBT = (bf16_t*)(ws + WS_H);
                if (PHM(7) && (rep == 0 || ((PROBE_MASK >> 7) & 1))) for (;;) {
                    __syncthreads();
                    if (tid == 0) *qslot = (int)atomicAdd(ctr, 1u);
                    __syncthreads();
                    const int idx = *qslot;
                    if (idx >= 576) break;
                    const bf16_t *Qp, *Kp, *Vp; bf16_t* Op; int qpitch, Lk; bool wide;
                    if (idx < 256) { const int b = idx >> 7, s = (idx >> 4) & 7, qb = idx & 15; const size_t tok0 = TP + b * 4096 + qb * 256; wide = true; qpitch = 512; Lk = LKS;
                        Qp = QB + tok0 * 512 + s * 64; Kp = (const bf16_t*)(ws + WS_KBS) + (size_t)(b * 8 + s) * LKS * 64; Vp = (const bf16_t*)(ws + WS_VBS) + (size_t)(b * 4 + (s >> 1)) * 128 * LKS; Op = OBT + tok0 * D + s * 128; }
                    else if (idx < 384) { const int i = idx - 256, b = i >> 6, hq = (i >> 4) & 3, qb = i & 15; const size_t tok0 = TP + b * 4096 + qb * 256; wide = false; qpitch = 256; Lk = LKS;
                        Qp = QA + tok0 * 256 + hq * 64; Kp = (const bf16_t*)(ws + WS_KAS) + (size_t)(b * 2 + (hq >> 1)) * LKS * 64; Vp = (const bf16_t*)(ws + WS_VAS) + (size_t)(b * 2 + (hq >> 1)) * 64 * LKS; Op = MIX + tok0 * D + hq * 64; }
                    else if (idx < 512) { const int i = idx - 384, b = i >> 3, s = i & 7; const size_t tok0 = b * 256; wide = true; qpitch = 512; Lk = 256;
                        Qp = QB + tok0 * 512 + s * 64; Kp = (const bf16_t*)(ws + WS_KBP) + (size_t)(b * 8 + s) * 256 * 64; Vp = (const bf16_t*)(ws + WS_VBP) + (size_t)(b * 4 + (s >> 1)) * 128 * 256; Op = OBT + tok0 * D + s * 128; }
                    else { const int i = idx - 512, b = i >> 2, hq = i & 3; const size_t tok0 = b * 256; wide = false; qpitch = 256; Lk = 256;
                        Qp = QA + tok0 * 256 + hq * 64; Kp = (const bf16_t*)(ws + WS_KAP) + (size_t)(b * 2 + (hq >> 1)) * 256 * 64; Vp = (const bf16_t*)(ws + WS_VAP) + (size_t)(b * 2 + (hq >> 1)) * 64 * 256; Op = MIX + tok0 * D + hq * 64; }
                    if (wide) attn_unit<128>(Qp, qpitch, Kp, Vp, Lk, Op, D, lds); else attn_unit<64>(Qp, qpitch, Kp, Vp, Lk, Op, D, lds);
                }
            } else if (k == 5) {
                if (PHM(8)) p_combine(a, l);
            }
        }
        }
        if (ph + 1 < ph_hi || (PROBE_MASK && redo == 0)) { if (ph == 0 && redo == 0 && !((PROBE_MASK >> 0) & 1)) grid.sync(); else if (ph == 0 && redo == 1) grid.sync(); else xcd_barrier(xbar); }
        if ((((PROBE_MASK >> kbit) & 1) || (kbit == 7 && ((PROBE_MASK >> 6) & 1))) && redo == 0) { redo = 1; --ph; } else redo = 0;
    }
}

typedef void (*kern_t)(KArgs);
extern "C" void kernel_launch(void* const* d_in, const int* in_sizes, int n_in, void* d_out, int out_size, void* d_ws, size_t ws_size, hipStream_t stream) {
    static int grid = 0;
#if MK_PER_PHASE
    static const kern_t kerns[8] = {trunk_fwd<0x1>, trunk_fwd<0x2>, trunk_fwd<0x4>, trunk_fwd<0x8>, trunk_fwd<0x10>, trunk_fwd<0x20>, trunk_fwd<0xC0>, trunk_fwd<0x100>};
    constexpr int NK = 8;
#else
    static const kern_t kerns[1] = {trunk_fwd<0x1ff>};
    constexpr int NK = 1;
#endif
    if (grid == 0) {
        if (n_in != 26 || ws_size < WS_END) { fprintf(stderr, "kernel_launch: need 26 inputs and %zu bytes of workspace; got %d, %zu\n", (size_t)WS_END, n_in, ws_size); grid = -1; return; }
        int dev = 0, cus = 0, per_cu = 0;
        if (hipGetDevice(&dev) != hipSuccess || hipDeviceGetAttribute(&cus, hipDeviceAttributeMultiprocessorCount, dev) != hipSuccess) { grid = -1; return; }
        for (int i = 0; i < NK; ++i) {
            if (hipFuncSetAttribute((const void*)kerns[i], hipFuncAttributeMaxDynamicSharedMemorySize, LDS_BYTES) != hipSuccess) { fprintf(stderr, "kernel_launch: hipFuncSetAttribute failed\n"); grid = -1; return; }
            if (hipOccupancyMaxActiveBlocksPerMultiprocessor(&per_cu, (const void*)kerns[i], 512, LDS_BYTES) != hipSuccess || per_cu < 1) { fprintf(stderr, "kernel_launch: occupancy query says %d\n", per_cu); (void)hipGetLastError(); grid = -1; return; }
        }
        grid = cus * 1;
    }
    if (grid < 0) return;
    if (hipMemsetAsync((char*)d_ws + WS_CTL, 0, 16384, stream) != hipSuccess) { fprintf(stderr, "kernel_launch: memset failed\n"); return; }
    KArgs a{};
    for (int i = 0; i < 26; ++i) a.in[i] = (const float*)d_in[i];
    a.out = (float*)d_out; a.ws = (unsigned char*)d_ws;
#if MK_PER_PHASE
    for (int ph = 0; ph < N_PHASES; ++ph) {
        a.ph_lo = ph; a.ph_hi = ph + 1;
        int ki;
        if (ph < 2) ki = ph;
        else { const int k = (ph - 2) % 11; ki = (k == 0 || k == 8) ? 2 : (k == 1 || k == 9 || k == 6) ? 3 : (k == 2 || k == 7 || k == 10) ? 4 : (k == 3) ? 5 : (k == 4) ? 6 : 7; }
        hipLaunchKernelGGL(kerns[ki], dim3(grid), dim3(512), LDS_BYTES, stream, a);
    }
#else
    a.ph_lo = 0; a.ph_hi = N_PHASES;
    void* args[] = {&a};
    hipError_t e = hipLaunchCooperativeKernel((const void*)kerns[0], dim3(grid), dim3(512), args, LDS_BYTES, stream);
    if (e != hipSuccess) fprintf(stderr, "cooperative launch failed: %s (grid %d)\n", hipGetErrorString(e), grid);
#endif
}
```
